# Optimizing an MI355X kernel written in HIP

```python
import math
import jax, jax.numpy as jnp
from jax import lax
import numpy as np

D_MODEL = 1024
BATCH = 4
SEQ = 4096
DEPTH = 4

HEAD_DIM = 64
N_Q_HEADS = 8
N_KV_HEADS = 2
GQA_GROUPS = N_Q_HEADS // N_KV_HEADS
ATTN_WIDTH = N_Q_HEADS * HEAD_DIM
KV_WIDTH = N_KV_HEADS * HEAD_DIM
MIX_WIDTH = D_MODEL // 2
CONV_CH = MIX_WIDTH
CONV_WIDTH = 31
SGU_CH = MIX_WIDTH
SGU_GROUPS = 4
SGU_GROUP_CH = SGU_CH // SGU_GROUPS
CHUNK = 128
WINDOW = 128
BLOCK_Q = 128
GRID_W = 64
ROPE_THETA = 10000.0
IN_WIDTH = 2 * MIX_WIDTH + ATTN_WIDTH + 2 * KV_WIDTH
OUT_WIDTH = 2 * MIX_WIDTH
PEER_HEADS = 8
PEER_NKEYS = 128
PEER_EXPERTS = PEER_NKEYS * PEER_NKEYS
PEER_DKEY = 128
PEER_TOPK = 16
PEER_TOK_CHUNK = 128
EPS = 1e-6
NEG = -1e30
N_EVEN = (DEPTH + 1) // 2
N_ODD = DEPTH // 2

kernel_name = 'hybrid_conv_swa_axial_sgu_peer_encoder'


def rmsnorm(x, g):
    xf = x.astype(jnp.float32)
    y = xf * lax.rsqrt(jnp.mean(xf * xf, axis=-1, keepdims=True) + EPS)
    return (y * g.astype(jnp.float32)).astype(x.dtype)


def layernorm(x, g, b):
    xf = x.astype(jnp.float32)
    mu = jnp.mean(xf, axis=-1, keepdims=True)
    xc = xf - mu
    var = jnp.mean(xc * xc, axis=-1, keepdims=True)
    return (xc * lax.rsqrt(var + EPS) * g.astype(jnp.float32) + b.astype(jnp.float32)).astype(x.dtype)


def rope_angles(pos, dim):
    inv = ROPE_THETA ** (-jnp.arange(0, dim, 2, dtype=jnp.float32) / dim)
    ang = pos.astype(jnp.float32)[:, None] * inv[None, :]
    ang = jnp.concatenate([ang, ang], axis=-1)
    return jnp.cos(ang), jnp.sin(ang)


def apply_rope(x, cos, sin):
    xf = x.astype(jnp.float32)
    x1, x2 = jnp.split(xf, 2, axis=-1)
    rot = jnp.concatenate([-x2, x1], axis=-1)
    return (xf * cos[:, None, :] + rot * sin[:, None, :]).astype(x.dtype)


def apply_axial_rope(x, cos_r, sin_r, cos_c, sin_c):
    half = x.shape[-1] // 2
    return jnp.concatenate([apply_rope(x[..., :half], cos_r, sin_r),
                            apply_rope(x[..., half:], cos_c, sin_c)], axis=-1)


def conformer_conv(a_in, conv_w, conv_b, ln_g, ln_b):
    a = a_in[..., :CONV_CH] * jax.nn.sigmoid(a_in[..., CONV_CH:])
    a = lax.conv_general_dilated(a, conv_w.astype(a.dtype), window_strides=(1,),
                                 padding=[(CONV_WIDTH // 2, CONV_WIDTH // 2)],
                                 dimension_numbers=('NWC', 'WIO', 'NWC'),
                                 feature_group_count=CONV_CH)
    a = a + conv_b.astype(a.dtype)
    a = layernorm(a, ln_g, ln_b)
    return jax.nn.silu(a)


def windowed_sink_attention(q, k, v, sink):
    B, S, _, Dh = q.shape
    nb = S // BLOCK_Q
    qb = q.reshape(B, nb, BLOCK_Q, N_KV_HEADS, GQA_GROUPS, Dh)
    pad = ((0, 0), (BLOCK_Q, BLOCK_Q), (0, 0), (0, 0))
    kp = jnp.pad(k, pad).reshape(B, nb + 2, BLOCK_Q, N_KV_HEADS, Dh)
    vp = jnp.pad(v, pad).reshape(B, nb + 2, BLOCK_Q, N_KV_HEADS, Dh)
    kb = jnp.concatenate([kp[:, :-2], kp[:, 1:-1], kp[:, 2:]], axis=2)
    vb = jnp.concatenate([vp[:, :-2], vp[:, 1:-1], vp[:, 2:]], axis=2)
    s = jnp.einsum('bnqhgd,bnkhd->bhgnqk', qb, kb).astype(jnp.float32) * (Dh ** -0.5)
    blk = jnp.arange(nb)[:, None, None]
    qpos = blk * BLOCK_Q + jnp.arange(BLOCK_Q)[None, :, None]
    kpos = (blk - 1) * BLOCK_Q + jnp.arange(3 * BLOCK_Q)[None, None, :]
    mask = (jnp.abs(kpos - qpos) <= WINDOW) & (kpos >= 0) & (kpos < S)
    s = jnp.where(mask, s, NEG)
    sink_b = sink.astype(jnp.float32).reshape(1, N_KV_HEADS, GQA_GROUPS, 1, 1, 1)
    m = jnp.maximum(jnp.max(s, axis=-1, keepdims=True), sink_b)
    p = jnp.exp(s - m)
    denom = jnp.sum(p, axis=-1, keepdims=True) + jnp.exp(sink_b - m)
    p = (p / denom).astype(v.dtype)
    o = jnp.einsum('bhgnqk,bnkhd->bnqhgd', p, vb)
    return o.reshape(B, S, N_Q_HEADS * Dh)


def dense_block_attention(q, k, v):
    B, S, _, Dh = q.shape
    nb = S // BLOCK_Q
    qb = q.reshape(B, nb, BLOCK_Q, N_KV_HEADS, GQA_GROUPS, Dh).transpose(1, 0, 2, 3, 4, 5)
    scale = Dh ** -0.5

    def one_block(qblk):
        s = jnp.einsum('bqhgd,bkhd->bhgqk', qblk, k).astype(jnp.float32) * scale
        p = jax.nn.softmax(s, axis=-1).astype(v.dtype)
        return jnp.einsum('bhgqk,bkhd->bqhgd', p, v)

    o = lax.map(one_block, qb)
    return o.transpose(1, 0, 2, 3, 4, 5).reshape(B, S, N_Q_HEADS * Dh)


def spatial_gating(d_in, ln_g, ln_b, w_s, b_s):
    z = jax.nn.gelu(d_in)
    u, v = z[..., :SGU_CH], z[..., SGU_CH:]
    v = layernorm(v, ln_g, ln_b)
    B, S, _ = v.shape
    nc = S // CHUNK
    vc = v.reshape(B, nc, CHUNK, SGU_GROUPS, SGU_GROUP_CH)
    mixed = jnp.einsum('gpq,bnqgc->bnpgc', w_s.astype(v.dtype), vc) + b_s.T.astype(v.dtype)[:, :, None]
    return u * mixed.reshape(B, S, SGU_CH)


def peer(h, wq, subkeys, u_tab, v_tab):
    B, S, D = h.shape
    T = B * S
    ht = h.reshape(T, D)
    q = (ht @ wq).reshape(T, PEER_HEADS, 2, PEER_DKEY // 2)
    s = jnp.einsum('thpd,hpkd->thpk', q, subkeys.astype(q.dtype)).astype(jnp.float32)
    sv, si = lax.top_k(s, PEER_TOPK)
    cand = (sv[:, :, 0, :, None] + sv[:, :, 1, None, :]).reshape(T, PEER_HEADS, PEER_TOPK * PEER_TOPK)
    fv, fi = lax.top_k(cand, PEER_TOPK)
    i1 = jnp.take_along_axis(si[:, :, 0, :], fi // PEER_TOPK, axis=-1)
    i2 = jnp.take_along_axis(si[:, :, 1, :], fi % PEER_TOPK, axis=-1)
    eidx = i1 * PEER_NKEYS + i2
    gate = jax.nn.softmax(fv, axis=-1)
    nchunk = T // PEER_TOK_CHUNK

    def chunk_fn(args):
        xc, ec, gc = args
        uc = u_tab[ec]
        a = jnp.einsum('chkd,cd->chk', uc, xc).astype(jnp.float32)
        a = (jax.nn.gelu(a) * gc).astype(xc.dtype)
        vc = v_tab[ec]
        return jnp.einsum('chk,chkd->cd', a, vc)

    out = lax.map(chunk_fn, (ht.reshape(nchunk, PEER_TOK_CHUNK, D),
                             eidx.reshape(nchunk, PEER_TOK_CHUNK, PEER_HEADS, PEER_TOPK),
                             gate.reshape(nchunk, PEER_TOK_CHUNK, PEER_HEADS, PEER_TOPK)))
    return out.reshape(B, S, D)


def setup_inputs(seed: int = 0) -> dict:
    key = jax.random.key(seed)
    ks = jax.random.split(key, 24)
    f32 = jnp.float32

    def nrm(k, shape, scale):
        return jax.random.normal(k, shape, f32) * scale

    return {
        'x': nrm(ks[0], (BATCH, SEQ, D_MODEL), 1.0),
        'mix_norm_g': 1.0 + nrm(ks[1], (DEPTH, D_MODEL), 0.02),
        'ffn_norm_g': 1.0 + nrm(ks[2], (DEPTH, D_MODEL), 0.02),
        'final_norm_g': 1.0 + nrm(ks[3], (D_MODEL,), 0.02),
        'even_w_in': nrm(ks[4], (N_EVEN, D_MODEL, IN_WIDTH), D_MODEL ** -0.5),
        'even_w_out': nrm(ks[5], (N_EVEN, OUT_WIDTH, D_MODEL), OUT_WIDTH ** -0.5),
        'conv_w': nrm(ks[6], (N_EVEN, CONV_WIDTH, 1, CONV_CH), CONV_WIDTH ** -0.5),
        'conv_b': nrm(ks[7], (N_EVEN, CONV_CH), 0.02),
        'conv_ln_g': 1.0 + nrm(ks[8], (N_EVEN, CONV_CH), 0.02),
        'conv_ln_b': nrm(ks[9], (N_EVEN, CONV_CH), 0.02),
        'sink_logits': nrm(ks[10], (N_EVEN, N_Q_HEADS), 0.5),
        'odd_w_in': nrm(ks[11], (N_ODD, D_MODEL, IN_WIDTH), D_MODEL ** -0.5),
        'odd_w_out': nrm(ks[12], (N_ODD, OUT_WIDTH, D_MODEL), OUT_WIDTH ** -0.5),
        'q_norm_g': 1.0 + nrm(ks[13], (N_ODD, HEAD_DIM), 0.02),
        'k_norm_g': 1.0 + nrm(ks[14], (N_ODD, HEAD_DIM), 0.02),
        'sgu_ln_g': 1.0 + nrm(ks[15], (N_ODD, SGU_CH), 0.02),
        'sgu_ln_b': nrm(ks[16], (N_ODD, SGU_CH), 0.02),
        'sgu_w': nrm(ks[17], (N_ODD, SGU_GROUPS, CHUNK, CHUNK), CHUNK ** -0.5),
        'sgu_b': 1.0 + nrm(ks[18], (N_ODD, SGU_GROUPS, CHUNK), 0.02),
        'peer_wq': nrm(ks[19], (DEPTH, D_MODEL, PEER_HEADS * PEER_DKEY), D_MODEL ** -0.5),
        'peer_subkeys': nrm(ks[20], (DEPTH, PEER_HEADS, 2, PEER_NKEYS, PEER_DKEY // 2), (PEER_DKEY // 2) ** -0.5),
        'peer_u': nrm(ks[21], (DEPTH, PEER_EXPERTS, D_MODEL), D_MODEL ** -0.5),
        'peer_v': nrm(ks[22], (DEPTH, PEER_EXPERTS, D_MODEL), (PEER_HEADS * PEER_TOPK) ** -0.5),
    }


def reference(x, mix_norm_g, ffn_norm_g, final_norm_g, even_w_in, even_w_out, conv_w, conv_b,
              conv_ln_g, conv_ln_b, sink_logits, odd_w_in, odd_w_out, q_norm_g, k_norm_g,
              sgu_ln_g, sgu_ln_b, sgu_w, sgu_b, peer_wq, peer_subkeys, peer_u, peer_v):
    B, S, _ = x.shape
    ROWS = S // GRID_W
    pos = jnp.arange(S)
    cos1, sin1 = rope_angles(pos, HEAD_DIM)
    rows = jnp.repeat(jnp.arange(ROWS), GRID_W, total_repeat_length=S)
    cols = jnp.tile(jnp.arange(GRID_W), ROWS)
    cos_r, sin_r = rope_angles(rows, HEAD_DIM // 2)
    cos_c, sin_c = rope_angles(cols, HEAD_DIM // 2)
    o1 = 2 * MIX_WIDTH
    o2 = o1 + ATTN_WIDTH
    o3 = o2 + KV_WIDTH
    for layer in range(DEPTH):
        i = layer // 2
        h = rmsnorm(x, mix_norm_g[layer])
        if layer % 2 == 0:
            z = h @ even_w_in[i]
            a_out = conformer_conv(z[..., :o1], conv_w[i], conv_b[i], conv_ln_g[i], conv_ln_b[i])
            q = apply_rope(z[..., o1:o2].reshape(B, S, N_Q_HEADS, HEAD_DIM), cos1, sin1)
            k = apply_rope(z[..., o2:o3].reshape(B, S, N_KV_HEADS, HEAD_DIM), cos1, sin1)
            v = z[..., o3:].reshape(B, S, N_KV_HEADS, HEAD_DIM)
            b_out = windowed_sink_attention(q, k, v, sink_logits[i])
            y = jnp.concatenate([a_out, b_out], axis=-1) @ even_w_out[i]
        else:
            z = h @ odd_w_in[i]
            c1 = ATTN_WIDTH
            c2 = c1 + KV_WIDTH
            c3 = c2 + KV_WIDTH
            q = rmsnorm(z[..., :c1].reshape(B, S, N_Q_HEADS, HEAD_DIM), q_norm_g[i])
            k = rmsnorm(z[..., c1:c2].reshape(B, S, N_KV_HEADS, HEAD_DIM), k_norm_g[i])
            v = z[..., c2:c3].reshape(B, S, N_KV_HEADS, HEAD_DIM)
            q = apply_axial_rope(q, cos_r, sin_r, cos_c, sin_c)
            k = apply_axial_rope(k, cos_r, sin_r, cos_c, sin_c)
            c_out = dense_block_attention(q, k, v)
            d_out = spatial_gating(z[..., c3:], sgu_ln_g[i], sgu_ln_b[i], sgu_w[i], sgu_b[i])
            y = jnp.concatenate([c_out, d_out], axis=-1) @ odd_w_out[i]
        x = x + y
        h = rmsnorm(x, ffn_norm_g[layer])
        x = x + peer(h, peer_wq[layer], peer_subkeys[layer], peer_u[layer], peer_v[layer])
    return rmsnorm(x, final_norm_g)
```

```cpp
#include <hip/hip_runtime.h>
#include <cstdio>
#include <cstdint>

#ifndef MK_ONE_LAUNCH
#define MK_ONE_LAUNCH 1
#endif

namespace {
constexpr int D = 1024, BATCH = 4, SEQ = 4096, T = BATCH * SEQ, DEPTH = 4;
constexpr int NIN = 1792, HD = 64, NQH = 8, NKVH = 2;
constexpr int PEER_E = 16384;
constexpr float EPS = 1e-6f;
constexpr float LOG2E = 1.4426950408889634f;
constexpr int NWAVES = 8, NT = NWAVES * 64;

constexpr size_t MiB = 1u << 20;
constexpr size_t WS_CTL = 0;
constexpr size_t WS_XRES = 1 * MiB;
constexpr size_t WS_HB = WS_XRES + 64 * MiB;
constexpr size_t WS_YCAT = WS_HB + 32 * MiB;
constexpr size_t WS_Z = WS_YCAT + 32 * MiB;
constexpr size_t WS_QP = WS_Z + 128 * MiB;
constexpr size_t WS_QB = WS_QP + 32 * MiB;
constexpr size_t WS_KB = WS_QB + 16 * MiB;
constexpr size_t WS_VT = WS_KB + 4 * MiB;
constexpr size_t WS_GLU = WS_VT + 4 * MiB;
constexpr size_t WS_VN = WS_GLU + 32 * MiB;
constexpr size_t WS_EIDX = WS_VN + 16 * MiB;
constexpr size_t WS_GATE = WS_EIDX + 8 * MiB;
constexpr size_t WS_WIN = WS_GATE + 8 * MiB;
constexpr size_t WS_WOUT = WS_WIN + 14 * MiB;
constexpr size_t WS_WQ = WS_WOUT + 8 * MiB;
constexpr size_t WS_SK = WS_WQ + 8 * MiB;
constexpr size_t WS_ROPE = WS_SK + 1 * MiB;
constexpr size_t WS_UB = WS_ROPE + 2 * MiB;
constexpr size_t WS_VB = WS_UB + 128 * MiB;
constexpr size_t WS_END = WS_VB + 128 * MiB;

constexpr int LDS_BYTES = 147456;

#define LAS __attribute__((address_space(3)))
typedef unsigned short bf16;
typedef short bf16x8 __attribute__((ext_vector_type(8)));
typedef float f32x4 __attribute__((ext_vector_type(4)));
typedef float f32x16 __attribute__((ext_vector_type(16)));
typedef unsigned u32x4 __attribute__((ext_vector_type(4)));
typedef unsigned u32x2 __attribute__((ext_vector_type(2)));
#define DI __device__ __forceinline__
#define MFMA32(a, b, c) __builtin_amdgcn_mfma_f32_32x32x16_bf16((a), (b), (c), 0, 0, 0)

DI unsigned f2bf(float f) { unsigned u = __float_as_uint(f); return (u + 0x7fffu + ((u >> 16) & 1u)) >> 16; }
DI unsigned pk2(float lo, float hi) { return f2bf(lo) | (f2bf(hi) << 16); }
DI float bf_lo(unsigned w) { return __uint_as_float(w << 16); }
DI float bf_hi(unsigned w) { return __uint_as_float(w & 0xffff0000u); }
DI float wave_sum(float v) {
#pragma unroll
    for (int o = 1; o < 64; o <<= 1) v += __shfl_xor(v, o);
    return v;
}
DI float sigmoidf_(float x) { return 1.0f / (1.0f + __expf(-x)); }
DI float gelu_tanh(float x) {
    const float u = 0.7978845608028654f * (x + 0.044715f * x * x * x);
    const float e = __expf(2.0f * u);
    const float th = 1.0f - 2.0f / (e + 1.0f);
    return 0.5f * x * (1.0f + th);
}
DI int crow(int reg, int h) { return (reg & 3) + 8 * (reg >> 2) + 4 * h; }

struct Args {
    const float* in[23];
    float* out;
    unsigned char* ws;
    int ph_lo, ph_hi;
};

struct Ctx {
    LAS unsigned char* lds;
    int tid, lane, wave, vcu, G;
};
constexpr int ARGS_OFF = 147456 - 512;
DI const float* inp(const Ctx& c, int k) {
    volatile LAS unsigned* p = (volatile LAS unsigned*)(c.lds + ARGS_OFF) + 2 * k;
    const unsigned lo = __builtin_amdgcn_readfirstlane(p[0]), hi = __builtin_amdgcn_readfirstlane(p[1]);
    return (const float*)(((unsigned long long)hi << 32) | lo);
}

#define XB_TMO      128
#define XB_XCNT(j)  (256  + 64 * (j))
#define XB_XSUB(j)  (1280 + 64 * (j))
#define XB_XGEN(j)  (2304 + 64 * (j))
#define XB_TOP      3328
#define XB_TOPGEN   3392
#define XCD_BAR_WORDS 3456
#define XB_SPIN_CAP (1u << 22)
DI unsigned xb_ld(unsigned* p) { return __hip_atomic_load(p, __ATOMIC_RELAXED, __HIP_MEMORY_SCOPE_AGENT); }
DI unsigned xb_add(unsigned* p, unsigned v) { return __hip_atomic_fetch_add(p, v, __ATOMIC_RELAXED, __HIP_MEMORY_SCOPE_AGENT); }
DI unsigned xb_xcc_id() { return (unsigned)__builtin_amdgcn_s_getreg((3 << 11) | 20) & 0xFu; }
#define XB_SPIN(cond, bar) do { unsigned _sp = 0; while (cond) { __builtin_amdgcn_s_sleep(1); \
    if ((++_sp & 255u) == 0u) { if (xb_ld(&(bar)[XB_TMO])) break; if (_sp > XB_SPIN_CAP) { atomicAdd(&(bar)[XB_TMO], 1u); break; } } } } while (0)
struct XcdBarrier { unsigned* bar; unsigned x; volatile LAS unsigned* st; };
DI XcdBarrier xcd_barrier_post(unsigned* bar, volatile LAS unsigned* st) {
    XcdBarrier b; b.bar = bar; b.x = xb_xcc_id(); b.st = st;
    if (threadIdx.x == 0) (void)xb_add(&bar[XB_XCNT(b.x)], 1u);
    return b;
}
DI void xcd_barrier_complete(unsigned* bar, unsigned x, unsigned& nloc, unsigned& nx) {
    const unsigned G = gridDim.x * gridDim.y * gridDim.z;
    unsigned sum, cnt, mine, sp = 0u;
    for (;;) {
        sum = 0u; cnt = 0u; mine = 0u;
#pragma unroll
        for (unsigned j = 0; j < 16; ++j) { const unsigned c = xb_ld(&bar[XB_XCNT(j)]); sum += c; cnt += (c > 0u) ? 1u : 0u; mine = (j == x) ? c : mine; }
        if (sum == G) break;
        __builtin_amdgcn_s_sleep(1);
        if ((++sp & 255u) == 0u) { if (xb_ld(&bar[XB_TMO])) break; if (sp > XB_SPIN_CAP) { atomicAdd(&bar[XB_TMO], 1u); break; } }
    }
    nloc = mine > 0u ? mine : 1u; nx = cnt > 0u ? cnt : 1u;
}
DI void xcd_barrier(const XcdBarrier& b) {
    asm volatile("s_waitcnt vmcnt(0)" ::: "memory");
    __syncthreads();
    if (threadIdx.x == 0) {
        unsigned* bar = b.bar;
        __builtin_amdgcn_s_waitcnt(0);
        unsigned nloc = b.st[0], nx = b.st[1];
        if (nloc == 0u) { xcd_barrier_complete(bar, b.x, nloc, nx); b.st[0] = nloc; b.st[1] = nx; }
        const unsigned old = xb_add(&bar[XB_XSUB(b.x)], 1u);
        const unsigned gen = old / nloc;
        if (old + 1u == (gen + 1u) * nloc) {
            __builtin_amdgcn_fence(__ATOMIC_RELEASE, "agent");
            asm volatile("s_waitcnt vmcnt(0)" ::: "memory");
            const unsigned og = xb_add(&bar[XB_TOP], 1u);
            const unsigned tg = og / nx;
            if (og + 1u == (tg + 1u) * nx) xb_add(&bar[XB_TOPGEN], 1u);
            else XB_SPIN(xb_ld(&bar[XB_TOPGEN]) == tg, bar);
            __builtin_amdgcn_fence(__ATOMIC_ACQUIRE, "agent");
            xb_add(&bar[XB_XGEN(b.x)], 1u);
            asm volatile("s_waitcnt vmcnt(0)" ::: "memory");
        } else {
            XB_SPIN(xb_ld(&bar[XB_XGEN(b.x)]) == gen, bar);
            __builtin_amdgcn_fence(__ATOMIC_ACQUIRE, "agent");
            asm volatile("s_waitcnt vmcnt(0)" ::: "memory");
        }
    }
    __syncthreads();
}

DI void transpose_item(const float* W, int K, int N, bf16* WT, LAS float* scr, int item, int lane) {
    const int nblk = N / 32, kb = item / nblk, nb = item % nblk, k0 = 64 * kb, n0 = 32 * nb;
#pragma unroll 8
    for (int i = 0; i < 32; ++i) { const int kk = 2 * i + (lane >> 5); scr[kk * 33 + (lane & 31)] = W[(size_t)(k0 + kk) * N + n0 + (lane & 31)]; }
    asm volatile("s_waitcnt lgkmcnt(0)" ::: "memory");
    const int c = lane & 7;
#pragma unroll
    for (int j = 0; j < 4; ++j) { const int n = (lane >> 3) + 8 * j; const LAS float* s = scr + (8 * c) * 33 + n;
        u32x4 o; o.x = pk2(s[0 * 33], s[1 * 33]); o.y = pk2(s[2 * 33], s[3 * 33]); o.z = pk2(s[4 * 33], s[5 * 33]); o.w = pk2(s[6 * 33], s[7 * 33]);
        *(u32x4*)(WT + (size_t)(n0 + n) * K + k0 + 8 * c) = o; }
    asm volatile("s_waitcnt lgkmcnt(0)" ::: "memory");
}
DI void cvt_stream(const float* src, bf16* dst, size_t n8, size_t gtid, size_t gthreads) {
    for (size_t i = gtid; i < n8; i += gthreads) {
        const f32x4 a = *(const f32x4*)(src + i * 8), b = *(const f32x4*)(src + i * 8 + 4);
        u32x4 o; o.x = pk2(a.x, a.y); o.y = pk2(a.z, a.w); o.z = pk2(b.x, b.y); o.w = pk2(b.z, b.w);
        *(u32x4*)(dst + i * 8) = o;
    }
}

DI void phase_prologue(const Ctx& c, unsigned char* ws) {
    LAS float* scr = (LAS float*)(c.lds + c.wave * 8704);
    const int gw = c.vcu * NWAVES + c.wave, NGW = c.G * NWAVES;
    constexpr int I_IN = (D / 64) * (NIN / 32), I_SQ = (D / 64) * (D / 32), I_L = I_IN + 2 * I_SQ;
    for (int it = gw; it < DEPTH * I_L; it += NGW) {
        const int l = it / I_L; int r = it % I_L; const int i = l >> 1;
        if (r < I_IN) { const float* W = inp(c, (l & 1) ? 11 : 4) + (size_t)i * D * NIN;
            transpose_item(W, D, NIN, (bf16*)(ws + WS_WIN) + (size_t)l * NIN * D, scr, r, c.lane); continue; }
        r -= I_IN;
        if (r < I_SQ) { const float* W = inp(c, (l & 1) ? 12 : 5) + (size_t)i * D * D;
            transpose_item(W, D, D, (bf16*)(ws + WS_WOUT) + (size_t)l * D * D, scr, r, c.lane); continue; }
        r -= I_SQ;
        transpose_item(inp(c, 19) + (size_t)l * D * D, D, D, (bf16*)(ws + WS_WQ) + (size_t)l * D * D, scr, r, c.lane);
    }
    const size_t gtid = (size_t)c.vcu * NT + c.tid, gth = (size_t)c.G * NT;
    cvt_stream(inp(c, 20), (bf16*)(ws + WS_SK), (size_t)DEPTH * 16 * 128 * 64 / 8, gtid, gth);
    cvt_stream(inp(c, 21), (bf16*)(ws + WS_UB), (size_t)DEPTH * PEER_E * D / 8, gtid, gth);
    cvt_stream(inp(c, 22), (bf16*)(ws + WS_VB), (size_t)DEPTH * PEER_E * D / 8, gtid, gth);
    const f32x4* xin = (const f32x4*)inp(c, 0);
    for (size_t i = gtid; i < (size_t)T * D / 4; i += gth) ((f32x4*)(ws + WS_XRES))[i] = xin[i];
    float* rope = (float*)(ws + WS_ROPE);
    for (size_t i = gtid; i < (size_t)SEQ * 32; i += gth) {
        const int pos = (int)(i >> 5), fi = (int)(i & 31);
        const float inv = (float)exp2(-(double)(2 * fi) / 64.0 * 13.287712379549449);
        const float ang = (float)pos * inv;
        const double rev = (double)ang * 0.15915494309189535; const float fr = (float)(rev - rint(rev));
        rope[i] = __builtin_amdgcn_cosf(fr); rope[(size_t)SEQ * 32 + i] = __builtin_amdgcn_sinf(fr);
    }
    for (size_t i = gtid; i < 64 * 16; i += gth) {
        const int pos = (int)(i >> 4), fi = (int)(i & 15);
        const float inv = (float)exp2(-(double)(2 * fi) / 32.0 * 13.287712379549449);
        const float ang = (float)pos * inv;
        const double rev = (double)ang * 0.15915494309189535; const float fr = (float)(rev - rint(rev));
        rope[(size_t)2 * SEQ * 32 + i] = __builtin_amdgcn_cosf(fr); rope[(size_t)2 * SEQ * 32 + 1024 + i] = __builtin_amdgcn_sinf(fr);
    }
}

DI void phase_norm(const Ctx& c, const float* x, const float* g, bf16* out) {
    const int gw = c.vcu * NWAVES + c.wave, NGW = c.G * NWAVES;
    for (int m = gw; m < T; m += NGW) {
        const f32x4* xr = (const f32x4*)(x + (size_t)m * D) + c.lane;
        f32x4 v[4]; float s = 0.f;
#pragma unroll
        for (int j = 0; j < 4; ++j) { v[j] = xr[64 * j]; s += (v[j].x * v[j].x + v[j].y * v[j].y) + (v[j].z * v[j].z + v[j].w * v[j].w); }
        const float r = 1.0f / sqrtf(wave_sum(s) * (1.0f / D) + EPS);
        u32x2* o8 = (u32x2*)(out + (size_t)m * D) + c.lane;
#pragma unroll
        for (int j = 0; j < 4; ++j) { const f32x4 gg = ((const f32x4*)g)[c.lane + 64 * j];
            u32x2 o; o.x = pk2(v[j].x * r * gg.x, v[j].y * r * gg.y); o.y = pk2(v[j].z * r * gg.z, v[j].w * r * gg.w); o8[64 * j] = o; }
    }
}
DI void phase_final(const Ctx& c, const float* x, const float* g, float* out) {
    const int gw = c.vcu * NWAVES + c.wave, NGW = c.G * NWAVES;
    for (int m = gw; m < T; m += NGW) {
        const f32x4* xr = (const f32x4*)(x + (size_t)m * D) + c.lane;
        f32x4 v[4]; float s = 0.f;
#pragma unroll
        for (int j = 0; j < 4; ++j) { v[j] = xr[64 * j]; s += (v[j].x * v[j].x + v[j].y * v[j].y) + (v[j].z * v[j].z + v[j].w * v[j].w); }
        const float r = 1.0f / sqrtf(wave_sum(s) * (1.0f / D) + EPS);
        f32x4* o = (f32x4*)(out + (size_t)m * D) + c.lane;
#pragma unroll
        for (int j = 0; j < 4; ++j) { const f32x4 gg = ((const f32x4*)g)[c.lane + 64 * j]; o[64 * j] = v[j] * r * gg; }
    }
}

template <int MODE>
DI void gemm_tile(const Ctx& c, const bf16* A, int lda, const bf16* Bt, int ldb, int K, void* Cout, int ldc) {
    LAS unsigned char* sA = c.lds; LAS unsigned char* sB = c.lds + 128 * 144;
    const int tid = c.tid, lane = c.lane, wr = c.wave >> 1, wc = c.wave & 1, l31 = lane & 31, h = lane >> 5;
    f32x16 acc[2];
#pragma unroll
    for (int j = 0; j < 2; ++j)
#pragma unroll
        for (int i = 0; i < 16; ++i) acc[j][i] = 0.f;
    for (int k0 = 0; k0 < K; k0 += 64) {
        u32x4 ra[2], rb[2];
#pragma unroll
        for (int i = 0; i < 2; ++i) { const int idx = tid + NT * i, row = idx >> 3, ch = idx & 7;
            ra[i] = *(const u32x4*)(A + (size_t)row * lda + k0 + ch * 8);
            rb[i] = *(const u32x4*)(Bt + (size_t)row * ldb + k0 + ch * 8); }
        __syncthreads();
#pragma unroll
        for (int i = 0; i < 2; ++i) { const int idx = tid + NT * i, row = idx >> 3, ch = idx & 7;
            *(LAS u32x4*)(sA + row * 144 + ch * 16) = ra[i];
            *(LAS u32x4*)(sB + row * 144 + ch * 16) = rb[i]; }
        __syncthreads();
#pragma unroll
        for (int kk = 0; kk < 4; ++kk) {
            const bf16x8 af = *(const LAS bf16x8*)(sA + (32 * wr + l31) * 144 + (16 * kk + 8 * h) * 2);
#pragma unroll
            for (int j = 0; j < 2; ++j) {
                const bf16x8 bfr = *(const LAS bf16x8*)(sB + (64 * wc + 32 * j + l31) * 144 + (16 * kk + 8 * h) * 2);
                acc[j] = MFMA32(af, bfr, acc[j]);
            }
        }
    }
#pragma unroll
    for (int j = 0; j < 2; ++j)
#pragma unroll
        for (int r = 0; r < 16; ++r) {
            const int row = 32 * wr + crow(r, h), col = 64 * wc + 32 * j + l31;
            if (MODE == 0) ((float*)Cout)[(size_t)row * ldc + col] = acc[j][r];
            else if (MODE == 1) { float* p = (float*)Cout + (size_t)row * ldc + col; *p = *p + acc[j][r]; }
            else ((bf16*)Cout)[(size_t)row * ldc + col] = (bf16)f2bf(acc[j][r]);
        }
}
template <int MODE>
DI void phase_gemm(const Ctx& c, const bf16* A, const bf16* Bt, int N, void* Cout) {
    const int nN = N / 128, ntiles = (T / 128) * nN;
    for (int it = c.vcu; it < ntiles; it += c.G) {
        const int tm = it / nN, tn = it % nN;
        if (MODE == 2) gemm_tile<MODE>(c, A + (size_t)tm * 128 * D, D, Bt + (size_t)tn * 128 * D, D, D, (bf16*)Cout + (size_t)tm * 128 * N + tn * 128, N);
        else gemm_tile<MODE>(c, A + (size_t)tm * 128 * D, D, Bt + (size_t)tn * 128 * D, D, D, (float*)Cout + (size_t)tm * 128 * N + tn * 128, N);
    }
}
DI void phase_scores(const Ctx& c, const bf16* qp, const bf16* sk, float* sc) {
    const int ntiles = (T / 128) * 16;
    for (int it = c.vcu; it < ntiles; it += c.G) {
        const int tm = it >> 4, hp = it & 15;
        gemm_tile<0>(c, qp + (size_t)tm * 128 * D + hp * 64, D, sk + (size_t)hp * 128 * 64, 64, 64, sc + (size_t)tm * 128 * 2048 + hp * 128, 2048);
    }
}

DI void phase_epi_even(const Ctx& c, const float* z, const float* rope, float* glu, bf16* qb, bf16* kb, bf16* vt) {
    const int gw = c.vcu * NWAVES + c.wave, NGW = c.G * NWAVES, lane = c.lane;
    for (int t = gw; t < T; t += NGW) {
        const float* zr = z + (size_t)t * NIN; const int b = t / SEQ, s = t % SEQ;
#pragma unroll
        for (int m = 0; m < 8; ++m) { const int ch = lane + 64 * m; glu[(size_t)t * 512 + ch] = zr[ch] * sigmoidf_(zr[512 + ch]); }
        const float cs = rope[(size_t)s * 32 + (lane & 31)], sn = rope[(size_t)SEQ * 32 + (size_t)s * 32 + (lane & 31)];
#pragma unroll
        for (int hh = 0; hh < 10; ++hh) {
            const float x = zr[1024 + hh * 64 + lane]; const float p = __shfl_xor(x, 32);
            float o = (lane < 32) ? (x * cs - p * sn) : (x * cs + p * sn);
            if (hh < 8) { o *= 0.125f * LOG2E; qb[((size_t)(b * 8 + hh) * SEQ + s) * 64 + lane] = (bf16)f2bf(o); }
            else kb[((size_t)(b * 2 + (hh - 8)) * SEQ + s) * 64 + lane] = (bf16)f2bf(o);
        }
#pragma unroll
        for (int kv = 0; kv < 2; ++kv) vt[((size_t)(b * 2 + kv) * 64 + lane) * SEQ + s] = (bf16)f2bf(zr[1664 + kv * 64 + lane]);
    }
}
DI void phase_epi_odd(const Ctx& c, const float* z, const float* rope, const float* qg, const float* kg, const float* lng, const float* lnb,
                      float* ug, bf16* vn, bf16* qb, bf16* kb, bf16* vt) {
    const int gw = c.vcu * NWAVES + c.wave, NGW = c.G * NWAVES, lane = c.lane;
    const float* axc = rope + (size_t)2 * SEQ * 32; const float* axs = axc + 1024;
    for (int t = gw; t < T; t += NGW) {
        const float* zr = z + (size_t)t * NIN; const int b = t / SEQ, s = t % SEQ;
        const int half = lane >> 5, dd = lane & 31, fi = dd & 15, pos = half ? (s & 63) : (s >> 6);
        const float cs = axc[pos * 16 + fi], sn = axs[pos * 16 + fi];
        const float gq = qg[lane], gk = kg[lane];
#pragma unroll
        for (int hh = 0; hh < 10; ++hh) {
            const float x = zr[hh * 64 + lane];
            const float r = 1.0f / sqrtf(wave_sum(x * x) * (1.0f / 64.0f) + EPS);
            const float xn = x * r * (hh < 8 ? gq : gk);
            const float p = __shfl_xor(xn, 16);
            float o = (dd < 16) ? (xn * cs - p * sn) : (xn * cs + p * sn);
            if (hh < 8) { o *= 0.125f * LOG2E; qb[((size_t)(b * 8 + hh) * SEQ + s) * 64 + lane] = (bf16)f2bf(o); }
            else kb[((size_t)(b * 2 + (hh - 8)) * SEQ + s) * 64 + lane] = (bf16)f2bf(o);
        }
#pragma unroll
        for (int kv = 0; kv < 2; ++kv) vt[((size_t)(b * 2 + kv) * 64 + lane) * SEQ + s] = (bf16)f2bf(zr[640 + kv * 64 + lane]);
        float gv[8]; float sm = 0.f;
#pragma unroll
        for (int m = 0; m < 8; ++m) { const int ch = lane + 64 * m; ug[(size_t)t * 512 + ch] = gelu_tanh(zr[768 + ch]); gv[m] = gelu_tanh(zr[1280 + ch]); sm += gv[m]; }
        const float mean = wave_sum(sm) * (1.0f / 512.0f); float sq = 0.f;
#pragma unroll
        for (int m = 0; m < 8; ++m) { gv[m] -= mean; sq += gv[m] * gv[m]; }
        const float rstd = 1.0f / sqrtf(wave_sum(sq) * (1.0f / 512.0f) + EPS);
#pragma unroll
        for (int m = 0; m < 8; ++m) { const int ch = lane + 64 * m; vn[(size_t)t * 512 + ch] = (bf16)f2bf(gv[m] * rstd * lng[ch] + lnb[ch]); }
    }
}

DI void conv_item(const Ctx& c, int item, const float* glu, const float* cw, const float* cb, const float* lng, const float* lnb, bf16* ycat) {
    const int t0 = item * 32, b = t0 / SEQ, s0 = t0 % SEQ, ch = c.tid;
    LAS float* sc = (LAS float*)c.lds;
    float v[62], w[31];
#pragma unroll
    for (int i = 0; i < 62; ++i) { const int s = s0 + i - 15; v[i] = (s >= 0 && s < SEQ) ? glu[((size_t)b * SEQ + s) * 512 + ch] : 0.f; }
#pragma unroll
    for (int j = 0; j < 31; ++j) w[j] = cw[j * 512 + ch];
    const float bias = cb[ch];
    __syncthreads();
#pragma unroll
    for (int i = 0; i < 32; ++i) { float acc = bias;
#pragma unroll
        for (int j = 0; j < 31; ++j) acc += w[j] * v[i + j];
        sc[i * 512 + ch] = acc; }
    __syncthreads();
#pragma unroll
    for (int q = 0; q < 4; ++q) {
        const int i = c.wave * 4 + q; float x[8]; float sm = 0.f;
#pragma unroll
        for (int m = 0; m < 8; ++m) { x[m] = sc[i * 512 + c.lane + 64 * m]; sm += x[m]; }
        const float mean = wave_sum(sm) * (1.0f / 512.0f); float sq = 0.f;
#pragma unroll
        for (int m = 0; m < 8; ++m) { x[m] -= mean; sq += x[m] * x[m]; }
        const float rstd = 1.0f / sqrtf(wave_sum(sq) * (1.0f / 512.0f) + EPS);
#pragma unroll
        for (int m = 0; m < 8; ++m) { const int cc = c.lane + 64 * m; const float y = x[m] * rstd * lng[cc] + lnb[cc];
            ycat[(size_t)(t0 + i) * D + cc] = (bf16)f2bf(y * sigmoidf_(y)); }
    }
}

template <bool WIN>
DI void attn_item(const Ctx& c, int item, const bf16* qb, const bf16* kb, const bf16* vt, bf16* ycat, int ycol0, const float* sink) {
    const int qblk = item & 63, kvh = (item >> 6) & 1, b = item >> 7;
    const int tid = c.tid, lane = c.lane, l31 = lane & 31, h = lane >> 5;
    const int head = kvh * 4 + (c.wave & 3), q0 = qblk * 64 + (c.wave >> 2) * 32;
    const bf16* qrow = qb + ((size_t)(b * 8 + head) * SEQ + q0 + l31) * 64;
    bf16x8 qf[4];
#pragma unroll
    for (int kk = 0; kk < 4; ++kk) qf[kk] = *(const bf16x8*)(qrow + 16 * kk + 8 * h);
    f32x16 o0, o1;
#pragma unroll
    for (int i = 0; i < 16; ++i) { o0[i] = 0.f; o1[i] = 0.f; }
    float m, l;
    if (WIN) { m = sink[head] * LOG2E; l = (h == 0) ? 1.f : 0.f; } else { m = -1e30f; l = 0.f; }
    const bf16* kbase = kb + (size_t)(b * 2 + kvh) * SEQ * 64;
    const bf16* vbase = vt + (size_t)(b * 2 + kvh) * 64 * SEQ;
    int t_lo = 0, t_hi = 63;
    if (WIN) { t_lo = qblk - 2 < 0 ? 0 : qblk - 2; t_hi = qblk + 2 > 63 ? 63 : qblk + 2; }
    LAS unsigned char* sK = c.lds; LAS unsigned char* sV = c.lds + 64 * 144;
    const int qpos = q0 + l31;
    for (int kt = t_lo; kt <= t_hi; ++kt) {
        const u32x4 rk = *(const u32x4*)(kbase + (size_t)(kt * 64 + (tid >> 3)) * 64 + (tid & 7) * 8);
        const u32x4 rv = *(const u32x4*)(vbase + (size_t)(tid >> 3) * SEQ + kt * 64 + (tid & 7) * 8);
        __syncthreads();
        *(LAS u32x4*)(sK + (tid >> 3) * 144 + (tid & 7) * 16) = rk;
        { u32x2 a; a.x = rv.x; a.y = rv.y; u32x2 bb; bb.x = rv.z; bb.y = rv.w;
          *(LAS u32x2*)(sV + (tid >> 3) * 136 + (tid & 7) * 16) = a; *(LAS u32x2*)(sV + (tid >> 3) * 136 + (tid & 7) * 16 + 8) = bb; }
        __syncthreads();
        f32x16 s0, s1;
#pragma unroll
        for (int i = 0; i < 16; ++i) { s0[i] = 0.f; s1[i] = 0.f; }
#pragma unroll
        for (int kk = 0; kk < 4; ++kk) {
            const bf16x8 k0 = *(const LAS bf16x8*)(sK + l31 * 144 + (16 * kk + 8 * h) * 2);
            const bf16x8 k1 = *(const LAS bf16x8*)(sK + (32 + l31) * 144 + (16 * kk + 8 * h) * 2);
            s0 = MFMA32(k0, qf[kk], s0); s1 = MFMA32(k1, qf[kk], s1);
        }
        if (WIN) {
#pragma unroll
            for (int r = 0; r < 16; ++r) {
                const int kp0 = kt * 64 + crow(r, h), kp1 = kp0 + 32;
                const int d0 = kp0 - qpos, d1 = kp1 - qpos;
                if (d0 > 128 || d0 < -128) s0[r] = -1e30f;
                if (d1 > 128 || d1 < -128) s1[r] = -1e30f;
            }
        }
        float mx = s0[0];
#pragma unroll
        for (int r = 1; r < 16; ++r) mx = fmaxf(mx, s0[r]);
#pragma unroll
        for (int r = 0; r < 16; ++r) mx = fmaxf(mx, s1[r]);
        mx = fmaxf(mx, __shfl_xor(mx, 32));
        const float mn = fmaxf(m, mx), alpha = __builtin_amdgcn_exp2f(m - mn); m = mn;
        float ls = 0.f;
#pragma unroll
        for (int r = 0; r < 16; ++r) { s0[r] = __builtin_amdgcn_exp2f(s0[r] - mn); s1[r] = __builtin_amdgcn_exp2f(s1[r] - mn); ls += s0[r] + s1[r]; }
        l = l * alpha + ls;
#pragma unroll
        for (int i = 0; i < 16; ++i) { o0[i] *= alpha; o1[i] *= alpha; }
#pragma unroll
        for (int tl = 0; tl < 2; ++tl)
#pragma unroll
            for (int st = 0; st < 2; ++st) {
                u32x4 pp;
                if (tl == 0) { pp.x = pk2(s0[8 * st], s0[8 * st + 1]); pp.y = pk2(s0[8 * st + 2], s0[8 * st + 3]); pp.z = pk2(s0[8 * st + 4], s0[8 * st + 5]); pp.w = pk2(s0[8 * st + 6], s0[8 * st + 7]); }
                else         { pp.x = pk2(s1[8 * st], s1[8 * st + 1]); pp.y = pk2(s1[8 * st + 2], s1[8 * st + 3]); pp.z = pk2(s1[8 * st + 4], s1[8 * st + 5]); pp.w = pk2(s1[8 * st + 6], s1[8 * st + 7]); }
                const bf16x8 pf = __builtin_bit_cast(bf16x8, pp);
                const int koff = (tl * 32 + 16 * st + 4 * h) * 2;
                {
                    const u32x2 lo = *(const LAS u32x2*)(sV + l31 * 136 + koff), hi = *(const LAS u32x2*)(sV + l31 * 136 + koff + 16);
                    u32x4 vv; vv.x = lo.x; vv.y = lo.y; vv.z = hi.x; vv.w = hi.y;
                    o0 = MFMA32(__builtin_bit_cast(bf16x8, vv), pf, o0);
                }
                {
                    const u32x2 lo = *(const LAS u32x2*)(sV + (32 + l31) * 136 + koff), hi = *(const LAS u32x2*)(sV + (32 + l31) * 136 + koff + 16);
                    u32x4 vv; vv.x = lo.x; vv.y = lo.y; vv.z = hi.x; vv.w = hi.y;
                    o1 = MFMA32(__builtin_bit_cast(bf16x8, vv), pf, o1);
                }
            }
    }
    const float lt = l + __shfl_xor(l, 32), inv = 1.0f / lt;
    bf16* orow = ycat + (size_t)(b * SEQ + q0 + l31) * D + ycol0 + head * 64;
#pragma unroll
    for (int g = 0; g < 4; ++g) {
        u32x2 w0; w0.x = pk2(o0[4 * g] * inv, o0[4 * g + 1] * inv); w0.y = pk2(o0[4 * g + 2] * inv, o0[4 * g + 3] * inv);
        u32x2 w1; w1.x = pk2(o1[4 * g] * inv, o1[4 * g + 1] * inv); w1.y = pk2(o1[4 * g + 2] * inv, o1[4 * g + 3] * inv);
        *(u32x2*)(orow + 8 * g + 4 * h) = w0; *(u32x2*)(orow + 32 + 8 * g + 4 * h) = w1;
    }
    __syncthreads();
}

DI void sgu_item(const Ctx& c, int item, const float* sw, const float* sb, const bf16* vn, const float* ug, bf16* ycat) {
    const int g = item & 3, n = (item >> 2) & 31, b = item >> 7;
    const int tid = c.tid, lane = c.lane, l31 = lane & 31, h = lane >> 5;
    LAS unsigned char* sW = c.lds; LAS unsigned char* sV = c.lds + 128 * 272;
    const float* wg = sw + (size_t)g * 128 * 128;
    __syncthreads();
#pragma unroll
    for (int i = 0; i < 4; ++i) { const int idx = tid + NT * i, row = idx >> 4, ch = idx & 15;
        const f32x4 a = *(const f32x4*)(wg + row * 128 + ch * 8), bq = *(const f32x4*)(wg + row * 128 + ch * 8 + 4);
        u32x4 o; o.x = pk2(a.x, a.y); o.y = pk2(a.z, a.w); o.z = pk2(bq.x, bq.y); o.w = pk2(bq.z, bq.w);
        *(LAS u32x4*)(sW + row * 272 + ch * 16) = o;
        const u32x4 vv = *(const u32x4*)(vn + ((size_t)b * SEQ + n * 128 + row) * 512 + g * 128 + ch * 8);
        *(LAS u32x4*)(sV + row * 272 + ch * 16) = vv; }
    __syncthreads();
    const int ct = c.wave & 3, pt0 = (c.wave >> 2) * 2;
    f32x16 acc[2];
#pragma unroll
    for (int j = 0; j < 2; ++j)
#pragma unroll
        for (int i = 0; i < 16; ++i) acc[j][i] = 0.f;
#pragma unroll
    for (int kk = 0; kk < 8; ++kk) {
        bf16x8 bfr;
#pragma unroll
        for (int j = 0; j < 8; ++j) bfr[j] = *(const LAS short*)(sV + (16 * kk + 8 * h + j) * 272 + (ct * 32 + l31) * 2);
#pragma unroll
        for (int j = 0; j < 2; ++j) {
            const bf16x8 af = *(const LAS bf16x8*)(sW + ((pt0 + j) * 32 + l31) * 272 + (16 * kk + 8 * h) * 2);
            acc[j] = MFMA32(af, bfr, acc[j]);
        }
    }
#pragma unroll
    for (int j = 0; j < 2; ++j)
#pragma unroll
        for (int r = 0; r < 16; ++r) {
            const int p = (pt0 + j) * 32 + crow(r, h), cc = ct * 32 + l31; const size_t t = (size_t)b * SEQ + n * 128 + p;
            const float mixed = acc[j][r] + sb[g * 128 + p];
            ycat[t * D + 512 + g * 128 + cc] = (bf16)f2bf(ug[t * 512 + g * 128 + cc] * mixed);
        }
}

DI void wave_argmax(float& v, int& i) {
#pragma unroll
    for (int o = 1; o < 64; o <<= 1) { const float ov = __shfl_xor(v, o); const int oi = __shfl_xor(i, o);
        if (ov > v || (ov == v && oi < i)) { v = ov; i = oi; } }
}
DI void phase_topk(const Ctx& c, const float* sc, int* eidx, float* gate) {
    const int gw = c.vcu * NWAVES + c.wave, NGW = c.G * NWAVES, lane = c.lane;
    for (int it = gw; it < T * 8; it += NGW) {
        const int t = it >> 3, hd = it & 7;
        const float* s = sc + (size_t)t * 2048 + hd * 256;
        float sv[2]; int si[2];
#pragma unroll
        for (int p = 0; p < 2; ++p) {
            float v0 = s[p * 128 + lane], v1 = s[p * 128 + 64 + lane]; float rsv = 0.f; int rsi = 0;
            for (int r = 0; r < 16; ++r) {
                float bv; int bi; if (v1 > v0) { bv = v1; bi = lane + 64; } else { bv = v0; bi = lane; }
                wave_argmax(bv, bi);
                if (lane == r) { rsv = bv; rsi = bi; }
                if (bi == lane) v0 = -3.0e38f; if (bi == lane + 64) v1 = -3.0e38f;
            }
            sv[p] = rsv; si[p] = rsi;
        }
        float cv[4];
#pragma unroll
        for (int m = 0; m < 4; ++m) cv[m] = __shfl(sv[0], (lane >> 4) + 4 * m) + __shfl(sv[1], lane & 15);
        float fv = 0.f; int fi = 0;
        for (int r = 0; r < 16; ++r) {
            float bv = cv[0]; int bi = lane;
#pragma unroll
            for (int m = 1; m < 4; ++m) if (cv[m] > bv) { bv = cv[m]; bi = lane + 64 * m; }
            wave_argmax(bv, bi);
            if (lane == r) { fv = bv; fi = bi; }
#pragma unroll
            for (int m = 0; m < 4; ++m) if (bi == lane + 64 * m) cv[m] = -3.0e38f;
        }
        const int i1 = __shfl(si[0], fi >> 4), i2 = __shfl(si[1], fi & 15);
        const float mx = __shfl(fv, 0);
        const float e = (lane < 16) ? __expf(fv - mx) : 0.f;
        const float sum = wave_sum(e);
        if (lane < 16) { eidx[(size_t)t * 128 + hd * 16 + lane] = i1 * 128 + i2; gate[(size_t)t * 128 + hd * 16 + lane] = e / sum; }
    }
}

DI void phase_gather(const Ctx& c, const bf16* hb, const int* eidx, const float* gate, const bf16* ub, const bf16* vb, float* x) {
    const int gw = c.vcu * NWAVES + c.wave, NGW = c.G * NWAVES, lane = c.lane;
    for (int t = gw; t < T; t += NGW) {
        const u32x4 h0 = *((const u32x4*)(hb + (size_t)t * D) + lane), h1 = *((const u32x4*)(hb + (size_t)t * D) + 64 + lane);
        float hf[16];
        hf[0] = bf_lo(h0.x); hf[1] = bf_hi(h0.x); hf[2] = bf_lo(h0.y); hf[3] = bf_hi(h0.y); hf[4] = bf_lo(h0.z); hf[5] = bf_hi(h0.z); hf[6] = bf_lo(h0.w); hf[7] = bf_hi(h0.w);
        hf[8] = bf_lo(h1.x); hf[9] = bf_hi(h1.x); hf[10] = bf_lo(h1.y); hf[11] = bf_hi(h1.y); hf[12] = bf_lo(h1.z); hf[13] = bf_hi(h1.z); hf[14] = bf_lo(h1.w); hf[15] = bf_hi(h1.w);
        const int e0 = eidx[(size_t)t * 128 + lane], e1 = eidx[(size_t)t * 128 + 64 + lane];
        const float g0 = gate[(size_t)t * 128 + lane], g1 = gate[(size_t)t * 128 + 64 + lane];
        float acc[16];
#pragma unroll
        for (int i = 0; i < 16; ++i) acc[i] = 0.f;
        for (int k = 0; k < 128; k += 4) {
            u32x4 u0[4], u1[4], v0[4], v1[4]; float gk[4];
#pragma unroll
            for (int j = 0; j < 4; ++j) {
                const int kk = k + j; const int e = __shfl(kk < 64 ? e0 : e1, kk & 63); gk[j] = __shfl(kk < 64 ? g0 : g1, kk & 63);
                const u32x4* ur = (const u32x4*)(ub + (size_t)e * D); const u32x4* vr = (const u32x4*)(vb + (size_t)e * D);
                u0[j] = ur[lane]; u1[j] = ur[64 + lane]; v0[j] = vr[lane]; v1[j] = vr[64 + lane];
            }
#pragma unroll
            for (int j = 0; j < 4; ++j) {
                float d = bf_lo(u0[j].x) * hf[0] + bf_hi(u0[j].x) * hf[1] + bf_lo(u0[j].y) * hf[2] + bf_hi(u0[j].y) * hf[3]
                        + bf_lo(u0[j].z) * hf[4] + bf_hi(u0[j].z) * hf[5] + bf_lo(u0[j].w) * hf[6] + bf_hi(u0[j].w) * hf[7]
                        + bf_lo(u1[j].x) * hf[8] + bf_hi(u1[j].x) * hf[9] + bf_lo(u1[j].y) * hf[10] + bf_hi(u1[j].y) * hf[11]
                        + bf_lo(u1[j].z) * hf[12] + bf_hi(u1[j].z) * hf[13] + bf_lo(u1[j].w) * hf[14] + bf_hi(u1[j].w) * hf[15];
                d = wave_sum(d);
                const float w = gelu_tanh(d) * gk[j];
                acc[0] += w * bf_lo(v0[j].x); acc[1] += w * bf_hi(v0[j].x); acc[2] += w * bf_lo(v0[j].y); acc[3] += w * bf_hi(v0[j].y);
                acc[4] += w * bf_lo(v0[j].z); acc[5] += w * bf_hi(v0[j].z); acc[6] += w * bf_lo(v0[j].w); acc[7] += w * bf_hi(v0[j].w);
                acc[8] += w * bf_lo(v1[j].x); acc[9] += w * bf_hi(v1[j].x); acc[10] += w * bf_lo(v1[j].y); acc[11] += w * bf_hi(v1[j].y);
                acc[12] += w * bf_lo(v1[j].z); acc[13] += w * bf_hi(v1[j].z); acc[14] += w * bf_lo(v1[j].w); acc[15] += w * bf_hi(v1[j].w);
            }
        }
        f32x4* xr = (f32x4*)(x + (size_t)t * D);
        f32x4 a = xr[2 * lane], bq = xr[2 * lane + 1], cq = xr[128 + 2 * lane], dq = xr[128 + 2 * lane + 1];
        a.x += acc[0]; a.y += acc[1]; a.z += acc[2]; a.w += acc[3]; bq.x += acc[4]; bq.y += acc[5]; bq.z += acc[6]; bq.w += acc[7];
        cq.x += acc[8]; cq.y += acc[9]; cq.z += acc[10]; cq.w += acc[11]; dq.x += acc[12]; dq.y += acc[13]; dq.z += acc[14]; dq.w += acc[15];
        xr[2 * lane] = a; xr[2 * lane + 1] = bq; xr[128 + 2 * lane] = cq; xr[128 + 2 * lane + 1] = dq;
    }
}

constexpr int STEPS_PER_LAYER = 10;
constexpr int NPHASES = 1 + DEPTH * STEPS_PER_LAYER + 1;

__global__ void __launch_bounds__(NT, 2) mk_fwd(Args args) {
    extern __shared__ __attribute__((aligned(16))) unsigned char lds_raw[];
    Ctx c0;
    c0.lds = (LAS unsigned char*)lds_raw;
    c0.tid = threadIdx.x; c0.lane = c0.tid & 63; c0.wave = __builtin_amdgcn_readfirstlane(c0.tid >> 6);
    c0.G = gridDim.x; { const int bx = blockIdx.x; c0.vcu = (c0.G % 8 == 0) ? (bx % 8) * (c0.G / 8) + bx / 8 : bx; }
    volatile LAS unsigned* misc = (volatile LAS unsigned*)(c0.lds + LDS_BYTES - 64);
    if (c0.tid < 16) misc[c0.tid] = 0u;
    if (c0.tid < 25) { const unsigned long long v = (c0.tid < 23) ? (unsigned long long)args.in[c0.tid] : (c0.tid == 23 ? (unsigned long long)args.out : (unsigned long long)args.ws);
        volatile LAS unsigned* p = (volatile LAS unsigned*)(c0.lds + ARGS_OFF) + 2 * c0.tid; p[0] = (unsigned)v; p[1] = (unsigned)(v >> 32); }
    __syncthreads();
    const int ph_lo = args.ph_lo, ph_hi = args.ph_hi;
    XcdBarrier bar; bar.bar = nullptr; bar.x = 0; bar.st = misc;
    const bool multi = (ph_hi - ph_lo) > 1;
    if (multi) bar = xcd_barrier_post((unsigned*)((unsigned char*)inp(c0, 24) + WS_CTL) + 4096, misc);

    for (int ph = ph_lo; ph < ph_hi; ++ph) {
        Ctx c = c0;
        asm volatile("" : "+v"(c.tid), "+v"(c.lane), "+s"(c.wave), "+s"(c.vcu));
        unsigned char* ws = (unsigned char*)inp(c, 24);
        float* xres = (float*)(ws + WS_XRES); bf16* hb = (bf16*)(ws + WS_HB); bf16* ycat = (bf16*)(ws + WS_YCAT);
        float* z = (float*)(ws + WS_Z); bf16* qp = (bf16*)(ws + WS_QP); bf16* qb = (bf16*)(ws + WS_QB); bf16* kb = (bf16*)(ws + WS_KB); bf16* vt = (bf16*)(ws + WS_VT);
        float* glu = (float*)(ws + WS_GLU); bf16* vn = (bf16*)(ws + WS_VN); int* eidx = (int*)(ws + WS_EIDX); float* gate = (float*)(ws + WS_GATE);
        const float* rope = (const float*)(ws + WS_ROPE);
        if (ph == 0) phase_prologue(c, ws);
        else if (ph == NPHASES - 1) phase_final(c, xres, inp(c, 3), (float*)inp(c, 23));
        else {
            const int l = (ph - 1) / STEPS_PER_LAYER, st = (ph - 1) % STEPS_PER_LAYER, i = l >> 1; const bool odd = l & 1;
            switch (st) {
            case 0: phase_norm(c, xres, inp(c, 1) + (size_t)l * D, hb); break;
            case 1: phase_gemm<0>(c, hb, (const bf16*)(ws + WS_WIN) + (size_t)l * NIN * D, NIN, z); break;
            case 2:
                if (!odd) phase_epi_even(c, z, rope, glu, qb, kb, vt);
                else phase_epi_odd(c, z, rope, inp(c, 13) + i * 64, inp(c, 14) + i * 64, inp(c, 15) + i * 512, inp(c, 16) + i * 512, glu, vn, qb, kb, vt);
                break;
            case 3:
                if (!odd) {
                    for (int it = c.vcu; it < 512; it += c.G) attn_item<true>(c, it, qb, kb, vt, ycat, 512, inp(c, 10) + i * 8);
                    for (int it = c.vcu; it < 512; it += c.G) conv_item(c, it, glu, inp(c, 6) + (size_t)i * 31 * 512, inp(c, 7) + i * 512, inp(c, 8) + i * 512, inp(c, 9) + i * 512, ycat);
                } else {
                    for (int it = c.vcu; it < 512; it += c.G) attn_item<false>(c, it, qb, kb, vt, ycat, 0, nullptr);
                    for (int it = c.vcu; it < 512; it += c.G) sgu_item(c, it, inp(c, 17) + (size_t)i * 4 * 128 * 128, inp(c, 18) + i * 512, vn, glu, ycat);
                }
                break;
            case 4: phase_gemm<1>(c, ycat, (const bf16*)(ws + WS_WOUT) + (size_t)l * D * D, D, xres); break;
            case 5: phase_norm(c, xres, inp(c, 2) + (size_t)l * D, hb); break;
            case 6: phase_gemm<2>(c, hb, (const bf16*)(ws + WS_WQ) + (size_t)l * D * D, D, qp); break;
            case 7: phase_scores(c, qp, (const bf16*)(ws + WS_SK) + (size_t)l * 16 * 128 * 64, z); break;
            case 8: phase_topk(c, z, eidx, gate); break;
            case 9: phase_gather(c, hb, eidx, gate, (const bf16*)(ws + WS_UB) + (size_t)l * PEER_E * D, (const bf16*)(ws + WS_VB) + (size_t)l * PEER_E * D, xres); break;
            }
        }
        if (ph + 1 < ph_hi) xcd_barrier(bar);
    }
}
}

extern "C" void kernel_launch(void* const* d_in, const int* in_sizes, int n_in, void* d_out, int out_size, void* d_ws, size_t ws_size, hipStream_t stream) {
    static int grid = 0;
    if (grid == 0) {
        if (n_in != 23 || out_size != T * D || ws_size < WS_END) { fprintf(stderr, "kernel_launch: unexpected shapes n_in %d out %d ws %zu (need %zu)\n", n_in, out_size, ws_size, (size_t)WS_END); grid = -1; return; }
        int dev = 0, cus = 0;
        if (hipGetDevice(&dev) != hipSuccess || hipDeviceGetAttribute(&cus, hipDeviceAttributeMultiprocessorCount, dev) != hipSuccess) { grid = -1; return; }
        if (hipFuncSetAttribute((const void*)mk_fwd, hipFuncAttributeMaxDynamicSharedMemorySize, LDS_BYTES) != hipSuccess) { fprintf(stderr, "kernel_launch: hipFuncSetAttribute failed\n"); grid = -1; return; }
        (void)hipGetLastError();
        grid = cus;
    }
    if (grid < 0) return;
    (void)hipMemsetAsync((char*)d_ws + WS_CTL, 0, 1 * MiB, stream);
    Args a{};
    for (int i = 0; i < 23; ++i) a.in[i] = (const float*)d_in[i];
    a.out = (float*)d_out; a.ws = (unsigned char*)d_ws;
#if MK_ONE_LAUNCH
    a.ph_lo = 0; a.ph_hi = NPHASES;
    hipLaunchKernelGGL(mk_fwd, dim3(grid), dim3(NT), LDS_BYTES, stream, a);
#else
    for (int p = 0; p < NPHASES; ++p) { a.ph_lo = p; a.ph_hi = p + 1; hipLaunchKernelGGL(mk_fwd, dim3(grid), dim3(NT), LDS_BYTES, stream, a); }
#endif
}
```

```cpp
#include <hip/hip_runtime.h>
#include <cstdio>
#include <cstdint>

#ifndef MK_ONE_LAUNCH
#define MK_ONE_LAUNCH 1
#endif
#ifndef PROBE_STEP
#define PROBE_STEP -1
#endif

namespace {
constexpr int D = 1024, BATCH = 4, SEQ = 4096, T = BATCH * SEQ, DEPTH = 4;
constexpr int NIN = 1792, HD = 64, NQH = 8, NKVH = 2;
constexpr int PEER_E = 16384;
constexpr float EPS = 1e-6f;
constexpr float LOG2E = 1.4426950408889634f;
constexpr int NWAVES = 8, NT = NWAVES * 64;

constexpr size_t MiB = 1u << 20;
constexpr size_t WS_CTL = 0;
constexpr size_t WS_XRES = 1 * MiB;
constexpr size_t WS_HB = WS_XRES + 64 * MiB;
constexpr size_t WS_YCAT = WS_HB + 32 * MiB;
constexpr size_t WS_Z = WS_YCAT + 32 * MiB;
constexpr size_t WS_QP = WS_Z + 128 * MiB;
constexpr size_t WS_QB = WS_QP + 32 * MiB;
constexpr size_t WS_KB = WS_QB + 16 * MiB;
constexpr size_t WS_VT = WS_KB + 4 * MiB;
constexpr size_t WS_GLU = WS_VT + 4 * MiB;
constexpr size_t WS_VN = WS_GLU + 32 * MiB;
constexpr size_t WS_EIDX = WS_VN + 16 * MiB;
constexpr size_t WS_GATE = WS_EIDX + 8 * MiB;
constexpr size_t WS_WIN = WS_GATE + 8 * MiB;
constexpr size_t WS_WOUT = WS_WIN + 14 * MiB;
constexpr size_t WS_WQ = WS_WOUT + 8 * MiB;
constexpr size_t WS_SK = WS_WQ + 8 * MiB;
constexpr size_t WS_ROPE = WS_SK + 1 * MiB;
constexpr size_t WS_UB = WS_ROPE + 2 * MiB;
constexpr size_t WS_VB = WS_UB + 128 * MiB;
constexpr size_t WS_END = WS_VB + 128 * MiB;

constexpr int LDS_BYTES = 147456;

#define LAS __attribute__((address_space(3)))
typedef unsigned short bf16;
typedef short bf16x8 __attribute__((ext_vector_type(8)));
typedef float f32x4 __attribute__((ext_vector_type(4)));
typedef float f32x16 __attribute__((ext_vector_type(16)));
typedef unsigned u32x4 __attribute__((ext_vector_type(4)));
typedef unsigned u32x2 __attribute__((ext_vector_type(2)));
#define DI __device__ __forceinline__
#define MFMA32(a, b, c) __builtin_amdgcn_mfma_f32_32x32x16_bf16((a), (b), (c), 0, 0, 0)

DI unsigned f2bf(float f) { unsigned u = __float_as_uint(f); return (u + 0x7fffu + ((u >> 16) & 1u)) >> 16; }
DI unsigned pk2(float lo, float hi) { return f2bf(lo) | (f2bf(hi) << 16); }
DI float bf_lo(unsigned w) { return __uint_as_float(w << 16); }
DI float bf_hi(unsigned w) { return __uint_as_float(w & 0xffff0000u); }
DI float wave_sum(float v) {
#pragma unroll
    for (int o = 1; o < 64; o <<= 1) v += __shfl_xor(v, o);
    return v;
}
DI float sigmoidf_(float x) { return 1.0f / (1.0f + __expf(-x)); }
DI float gelu_tanh(float x) {
    const float u = 0.7978845608028654f * (x + 0.044715f * x * x * x);
    const float e = __expf(2.0f * u);
    const float th = 1.0f - 2.0f / (e + 1.0f);
    return 0.5f * x * (1.0f + th);
}
DI int crow(int reg, int h) { return (reg & 3) + 8 * (reg >> 2) + 4 * h; }

struct Args {
    const float* in[23];
    float* out;
    unsigned char* ws;
    int ph_lo, ph_hi;
};

struct Ctx {
    LAS unsigned char* lds;
    int tid, lane, wave, vcu, G;
};
constexpr int ARGS_OFF = 147456 - 512;
DI const float* inp(const Ctx& c, int k) {
    volatile LAS unsigned* p = (volatile LAS unsigned*)(c.lds + ARGS_OFF) + 2 * k;
    const unsigned lo = __builtin_amdgcn_readfirstlane(p[0]), hi = __builtin_amdgcn_readfirstlane(p[1]);
    return (const float*)(((unsigned long long)hi << 32) | lo);
}

#define XB_TMO      128
#define XB_XCNT(j)  (256  + 64 * (j))
#define XB_XSUB(j)  (1280 + 64 * (j))
#define XB_XGEN(j)  (2304 + 64 * (j))
#define XB_TOP      3328
#define XB_TOPGEN   3392
#define XCD_BAR_WORDS 3456
#define XB_SPIN_CAP (1u << 22)
DI unsigned xb_ld(unsigned* p) { return __hip_atomic_load(p, __ATOMIC_RELAXED, __HIP_MEMORY_SCOPE_AGENT); }
DI unsigned xb_add(unsigned* p, unsigned v) { return __hip_atomic_fetch_add(p, v, __ATOMIC_RELAXED, __HIP_MEMORY_SCOPE_AGENT); }
DI unsigned xb_xcc_id() { return (unsigned)__builtin_amdgcn_s_getreg((3 << 11) | 20) & 0xFu; }
#define XB_SPIN(cond, bar) do { unsigned _sp = 0; while (cond) { __builtin_amdgcn_s_sleep(1); \
    if ((++_sp & 255u) == 0u) { if (xb_ld(&(bar)[XB_TMO])) break; if (_sp > XB_SPIN_CAP) { atomicAdd(&(bar)[XB_TMO], 1u); break; } } } } while (0)
struct XcdBarrier { unsigned* bar; unsigned x; volatile LAS unsigned* st; };
DI XcdBarrier xcd_barrier_post(unsigned* bar, volatile LAS unsigned* st) {
    XcdBarrier b; b.bar = bar; b.x = xb_xcc_id(); b.st = st;
    if (threadIdx.x == 0) (void)xb_add(&bar[XB_XCNT(b.x)], 1u);
    return b;
}
DI void xcd_barrier_complete(unsigned* bar, unsigned x, unsigned& nloc, unsigned& nx) {
    const unsigned G = gridDim.x * gridDim.y * gridDim.z;
    unsigned sum, cnt, mine, sp = 0u;
    for (;;) {
        sum = 0u; cnt = 0u; mine = 0u;
#pragma unroll
        for (unsigned j = 0; j < 16; ++j) { const unsigned c = xb_ld(&bar[XB_XCNT(j)]); sum += c; cnt += (c > 0u) ? 1u : 0u; mine = (j == x) ? c : mine; }
        if (sum == G) break;
        __builtin_amdgcn_s_sleep(1);
        if ((++sp & 255u) == 0u) { if (xb_ld(&bar[XB_TMO])) break; if (sp > XB_SPIN_CAP) { atomicAdd(&bar[XB_TMO], 1u); break; } }
    }
    nloc = mine > 0u ? mine : 1u; nx = cnt > 0u ? cnt : 1u;
}
DI void xcd_barrier(const XcdBarrier& b) {
    asm volatile("s_waitcnt vmcnt(0)" ::: "memory");
    __syncthreads();
    if (threadIdx.x == 0) {
        unsigned* bar = b.bar;
        __builtin_amdgcn_s_waitcnt(0);
        unsigned nloc = b.st[0], nx = b.st[1];
        if (nloc == 0u) { xcd_barrier_complete(bar, b.x, nloc, nx); b.st[0] = nloc; b.st[1] = nx; }
        const unsigned old = xb_add(&bar[XB_XSUB(b.x)], 1u);
        const unsigned gen = old / nloc;
        if (old + 1u == (gen + 1u) * nloc) {
            __builtin_amdgcn_fence(__ATOMIC_RELEASE, "agent");
            asm volatile("s_waitcnt vmcnt(0)" ::: "memory");
            const unsigned og = xb_add(&bar[XB_TOP], 1u);
            const unsigned tg = og / nx;
            if (og + 1u == (tg + 1u) * nx) xb_add(&bar[XB_TOPGEN], 1u);
            else XB_SPIN(xb_ld(&bar[XB_TOPGEN]) == tg, bar);
            __builtin_amdgcn_fence(__ATOMIC_ACQUIRE, "agent");
            xb_add(&bar[XB_XGEN(b.x)], 1u);
            asm volatile("s_waitcnt vmcnt(0)" ::: "memory");
        } else {
            XB_SPIN(xb_ld(&bar[XB_XGEN(b.x)]) == gen, bar);
            __builtin_amdgcn_fence(__ATOMIC_ACQUIRE, "agent");
            asm volatile("s_waitcnt vmcnt(0)" ::: "memory");
        }
    }
    __syncthreads();
}

DI void transpose_item(const float* W, int K, int N, bf16* WT, LAS float* scr, int item, int lane) {
    const int nblk = N / 32, kb = item / nblk, nb = item % nblk, k0 = 64 * kb, n0 = 32 * nb;
#pragma unroll 8
    for (int i = 0; i < 32; ++i) { const int kk = 2 * i + (lane >> 5); scr[kk * 33 + (lane & 31)] = W[(size_t)(k0 + kk) * N + n0 + (lane & 31)]; }
    asm volatile("s_waitcnt lgkmcnt(0)" ::: "memory");
    const int c = lane & 7;
#pragma unroll
    for (int j = 0; j < 4; ++j) { const int n = (lane >> 3) + 8 * j; const LAS float* s = scr + (8 * c) * 33 + n;
        u32x4 o; o.x = pk2(s[0 * 33], s[1 * 33]); o.y = pk2(s[2 * 33], s[3 * 33]); o.z = pk2(s[4 * 33], s[5 * 33]); o.w = pk2(s[6 * 33], s[7 * 33]);
        *(u32x4*)(WT + (size_t)(n0 + n) * K + k0 + 8 * c) = o; }
    asm volatile("s_waitcnt lgkmcnt(0)" ::: "memory");
}
DI void cvt_stream(const float* src, bf16* dst, size_t n8, size_t gtid, size_t gthreads) {
    for (size_t i = gtid; i < n8; i += gthreads) {
        const f32x4 a = *(const f32x4*)(src + i * 8), b = *(const f32x4*)(src + i * 8 + 4);
        u32x4 o; o.x = pk2(a.x, a.y); o.y = pk2(a.z, a.w); o.z = pk2(b.x, b.y); o.w = pk2(b.z, b.w);
        *(u32x4*)(dst + i * 8) = o;
    }
}

DI void phase_prologue(const Ctx& c, unsigned char* ws) {
    LAS float* scr = (LAS float*)(c.lds + c.wave * 8704);
    const int gw = c.vcu * NWAVES + c.wave, NGW = c.G * NWAVES;
    constexpr int I_IN = (D / 64) * (NIN / 32), I_SQ = (D / 64) * (D / 32), I_L = I_IN + 2 * I_SQ;
    for (int it = gw; it < DEPTH * I_L; it += NGW) {
        const int l = it / I_L; int r = it % I_L; const int i = l >> 1;
        if (r < I_IN) { const float* W = inp(c, (l & 1) ? 11 : 4) + (size_t)i * D * NIN;
            transpose_item(W, D, NIN, (bf16*)(ws + WS_WIN) + (size_t)l * NIN * D, scr, r, c.lane); continue; }
        r -= I_IN;
        if (r < I_SQ) { const float* W = inp(c, (l & 1) ? 12 : 5) + (size_t)i * D * D;
            transpose_item(W, D, D, (bf16*)(ws + WS_WOUT) + (size_t)l * D * D, scr, r, c.lane); continue; }
        r -= I_SQ;
        transpose_item(inp(c, 19) + (size_t)l * D * D, D, D, (bf16*)(ws + WS_WQ) + (size_t)l * D * D, scr, r, c.lane);
    }
    const size_t gtid = (size_t)c.vcu * NT + c.tid, gth = (size_t)c.G * NT;
    cvt_stream(inp(c, 20), (bf16*)(ws + WS_SK), (size_t)DEPTH * 16 * 128 * 64 / 8, gtid, gth);
    cvt_stream(inp(c, 21), (bf16*)(ws + WS_UB), (size_t)DEPTH * PEER_E * D / 8, gtid, gth);
    cvt_stream(inp(c, 22), (bf16*)(ws + WS_VB), (size_t)DEPTH * PEER_E * D / 8, gtid, gth);
    const f32x4* xin = (const f32x4*)inp(c, 0);
    for (size_t i = gtid; i < (size_t)T * D / 4; i += gth) ((f32x4*)(ws + WS_XRES))[i] = xin[i];
    float* rope = (float*)(ws + WS_ROPE);
    for (size_t i = gtid; i < (size_t)SEQ * 32; i += gth) {
        const int pos = (int)(i >> 5), fi = (int)(i & 31);
        const float inv = (float)exp2(-(double)(2 * fi) / 64.0 * 13.287712379549449);
        const float ang = (float)pos * inv;
        const double rev = (double)ang * 0.15915494309189535; const float fr = (float)(rev - rint(rev));
        rope[i] = __builtin_amdgcn_cosf(fr); rope[(size_t)SEQ * 32 + i] = __builtin_amdgcn_sinf(fr);
    }
    for (size_t i = gtid; i < 64 * 16; i += gth) {
        const int pos = (int)(i >> 4), fi = (int)(i & 15);
        const float inv = (float)exp2(-(double)(2 * fi) / 32.0 * 13.287712379549449);
        const float ang = (float)pos * inv;
        const double rev = (double)ang * 0.15915494309189535; const float fr = (float)(rev - rint(rev));
        rope[(size_t)2 * SEQ * 32 + i] = __builtin_amdgcn_cosf(fr); rope[(size_t)2 * SEQ * 32 + 1024 + i] = __builtin_amdgcn_sinf(fr);
    }
}

DI void phase_norm(const Ctx& c, const float* x, const float* g, bf16* out) {
    const int gw = c.vcu * NWAVES + c.wave, NGW = c.G * NWAVES;
    for (int m = gw; m < T; m += NGW) {
        const f32x4* xr = (const f32x4*)(x + (size_t)m * D) + c.lane;
        f32x4 v[4]; float s = 0.f;
#pragma unroll
        for (int j = 0; j < 4; ++j) { v[j] = xr[64 * j]; s += (v[j].x * v[j].x + v[j].y * v[j].y) + (v[j].z * v[j].z + v[j].w * v[j].w); }
        const float r = 1.0f / sqrtf(wave_sum(s) * (1.0f / D) + EPS);
        u32x2* o8 = (u32x2*)(out + (size_t)m * D) + c.lane;
#pragma unroll
        for (int j = 0; j < 4; ++j) { const f32x4 gg = ((const f32x4*)g)[c.lane + 64 * j];
            u32x2 o; o.x = pk2(v[j].x * r * gg.x, v[j].y * r * gg.y); o.y = pk2(v[j].z * r * gg.z, v[j].w * r * gg.w); o8[64 * j] = o; }
    }
}
DI void phase_final(const Ctx& c, const float* x, const float* g, float* out) {
    const int gw = c.vcu * NWAVES + c.wave, NGW = c.G * NWAVES;
    for (int m = gw; m < T; m += NGW) {
        const f32x4* xr = (const f32x4*)(x + (size_t)m * D) + c.lane;
        f32x4 v[4]; float s = 0.f;
#pragma unroll
        for (int j = 0; j < 4; ++j) { v[j] = xr[64 * j]; s += (v[j].x * v[j].x + v[j].y * v[j].y) + (v[j].z * v[j].z + v[j].w * v[j].w); }
        const float r = 1.0f / sqrtf(wave_sum(s) * (1.0f / D) + EPS);
        f32x4* o = (f32x4*)(out + (size_t)m * D) + c.lane;
#pragma unroll
        for (int j = 0; j < 4; ++j) { const f32x4 gg = ((const f32x4*)g)[c.lane + 64 * j]; o[64 * j] = v[j] * r * gg; }
    }
}

template <int MODE>
DI void gemm_tile(const Ctx& c, const bf16* A, int lda, const bf16* Bt, int ldb, int K, void* Cout, int ldc) {
    LAS unsigned char* sA = c.lds; LAS unsigned char* sB = c.lds + 128 * 144;
    const int tid = c.tid, lane = c.lane, wr = c.wave >> 1, wc = c.wave & 1, l31 = lane & 31, h = lane >> 5;
    f32x16 acc[2];
#pragma unroll
    for (int j = 0; j < 2; ++j)
#pragma unroll
        for (int i = 0; i < 16; ++i) acc[j][i] = 0.f;
    for (int k0 = 0; k0 < K; k0 += 64) {
        u32x4 ra[2], rb[2];
#pragma unroll
        for (int i = 0; i < 2; ++i) { const int idx = tid + NT * i, row = idx >> 3, ch = idx & 7;
            ra[i] = *(const u32x4*)(A + (size_t)row * lda + k0 + ch * 8);
            rb[i] = *(const u32x4*)(Bt + (size_t)row * ldb + k0 + ch * 8); }
        __syncthreads();
#pragma unroll
        for (int i = 0; i < 2; ++i) { const int idx = tid + NT * i, row = idx >> 3, ch = idx & 7;
            *(LAS u32x4*)(sA + row * 144 + ch * 16) = ra[i];
            *(LAS u32x4*)(sB + row * 144 + ch * 16) = rb[i]; }
        __syncthreads();
#pragma unroll
        for (int kk = 0; kk < 4; ++kk) {
            const bf16x8 af = *(const LAS bf16x8*)(sA + (32 * wr + l31) * 144 + (16 * kk + 8 * h) * 2);
#pragma unroll
            for (int j = 0; j < 2; ++j) {
                const bf16x8 bfr = *(const LAS bf16x8*)(sB + (64 * wc + 32 * j + l31) * 144 + (16 * kk + 8 * h) * 2);
                acc[j] = MFMA32(af, bfr, acc[j]);
            }
        }
    }
#pragma unroll
    for (int j = 0; j < 2; ++j)
#pragma unroll
        for (int r = 0; r < 16; ++r) {
            const int row = 32 * wr + crow(r, h), col = 64 * wc + 32 * j + l31;
            if (MODE == 0) ((float*)Cout)[(size_t)row * ldc + col] = acc[j][r];
            else if (MODE == 1) { float* p = (float*)Cout + (size_t)row * ldc + col; *p = *p + acc[j][r]; }
            else ((bf16*)Cout)[(size_t)row * ldc + col] = (bf16)f2bf(acc[j][r]);
        }
}
template <int MODE>
DI void phase_gemm(const Ctx& c, const bf16* A, const bf16* Bt, int N, void* Cout) {
    const int nN = N / 128, ntiles = (T / 128) * nN;
    for (int it = c.vcu; it < ntiles; it += c.G) {
        const int tm = it / nN, tn = it % nN;
        if (MODE == 2) gemm_tile<MODE>(c, A + (size_t)tm * 128 * D, D, Bt + (size_t)tn * 128 * D, D, D, (bf16*)Cout + (size_t)tm * 128 * N + tn * 128, N);
        else gemm_tile<MODE>(c, A + (size_t)tm * 128 * D, D, Bt + (size_t)tn * 128 * D, D, D, (float*)Cout + (size_t)tm * 128 * N + tn * 128, N);
    }
}
DI void phase_scores(const Ctx& c, const bf16* qp, const bf16* sk, float* sc) {
    const int ntiles = (T / 128) * 16;
    for (int it = c.vcu; it < ntiles; it += c.G) {
        const int tm = it >> 4, hp = it & 15;
        gemm_tile<0>(c, qp + (size_t)tm * 128 * D + hp * 64, D, sk + (size_t)hp * 128 * 64, 64, 64, sc + (size_t)tm * 128 * 2048 + hp * 128, 2048);
    }
}

DI void phase_epi_even(const Ctx& c, const float* z, const float* rope, float* glu, bf16* qb, bf16* kb, bf16* vt) {
    const int gw = c.vcu * NWAVES + c.wave, NGW = c.G * NWAVES, lane = c.lane;
    for (int t = gw; t < T; t += NGW) {
        const float* zr = z + (size_t)t * NIN; const int b = t / SEQ, s = t % SEQ;
#pragma unroll
        for (int m = 0; m < 8; ++m) { const int ch = lane + 64 * m; glu[(size_t)t * 512 + ch] = zr[ch] * sigmoidf_(zr[512 + ch]); }
        const float cs = rope[(size_t)s * 32 + (lane & 31)], sn = rope[(size_t)SEQ * 32 + (size_t)s * 32 + (lane & 31)];
#pragma unroll
        for (int hh = 0; hh < 10; ++hh) {
            const float x = zr[1024 + hh * 64 + lane]; const float p = __shfl_xor(x, 32);
            float o = (lane < 32) ? (x * cs - p * sn) : (x * cs + p * sn);
            if (hh < 8) { o *= 0.125f * LOG2E; qb[((size_t)(b * 8 + hh) * SEQ + s) * 64 + lane] = (bf16)f2bf(o); }
            else kb[((size_t)(b * 2 + (hh - 8)) * SEQ + s) * 64 + lane] = (bf16)f2bf(o);
        }
#pragma unroll
        for (int kv = 0; kv < 2; ++kv) vt[((size_t)(b * 2 + kv) * 64 + lane) * SEQ + s] = (bf16)f2bf(zr[1664 + kv * 64 + lane]);
    }
}
DI void phase_epi_odd(const Ctx& c, const float* z, const float* rope, const float* qg, const float* kg, const float* lng, const float* lnb,
                      float* ug, bf16* vn, bf16* qb, bf16* kb, bf16* vt) {
    const int gw = c.vcu * NWAVES + c.wave, NGW = c.G * NWAVES, lane = c.lane;
    const float* axc = rope + (size_t)2 * SEQ * 32; const float* axs = axc + 1024;
    for (int t = gw; t < T; t += NGW) {
        const float* zr = z + (size_t)t * NIN; const int b = t / SEQ, s = t % SEQ;
        const int half = lane >> 5, dd = lane & 31, fi = dd & 15, pos = half ? (s & 63) : (s >> 6);
        const float cs = axc[pos * 16 + fi], sn = axs[pos * 16 + fi];
        const float gq = qg[lane], gk = kg[lane];
#pragma unroll
        for (int hh = 0; hh < 10; ++hh) {
            const float x = zr[hh * 64 + lane];
            const float r = 1.0f / sqrtf(wave_sum(x * x) * (1.0f / 64.0f) + EPS);
            const float xn = x * r * (hh < 8 ? gq : gk);
            const float p = __shfl_xor(xn, 16);
            float o = (dd < 16) ? (xn * cs - p * sn) : (xn * cs + p * sn);
            if (hh < 8) { o *= 0.125f * LOG2E; qb[((size_t)(b * 8 + hh) * SEQ + s) * 64 + lane] = (bf16)f2bf(o); }
            else kb[((size_t)(b * 2 + (hh - 8)) * SEQ + s) * 64 + lane] = (bf16)f2bf(o);
        }
#pragma unroll
        for (int kv = 0; kv < 2; ++kv) vt[((size_t)(b * 2 + kv) * 64 + lane) * SEQ + s] = (bf16)f2bf(zr[640 + kv * 64 + lane]);
        float gv[8]; float sm = 0.f;
#pragma unroll
        for (int m = 0; m < 8; ++m) { const int ch = lane + 64 * m; ug[(size_t)t * 512 + ch] = gelu_tanh(zr[768 + ch]); gv[m] = gelu_tanh(zr[1280 + ch]); sm += gv[m]; }
        const float mean = wave_sum(sm) * (1.0f / 512.0f); float sq = 0.f;
#pragma unroll
        for (int m = 0; m < 8; ++m) { gv[m] -= mean; sq += gv[m] * gv[m]; }
        const float rstd = 1.0f / sqrtf(wave_sum(sq) * (1.0f / 512.0f) + EPS);
#pragma unroll
        for (int m = 0; m < 8; ++m) { const int ch = lane + 64 * m; vn[(size_t)t * 512 + ch] = (bf16)f2bf(gv[m] * rstd * lng[ch] + lnb[ch]); }
    }
}

DI void conv_item(const Ctx& c, int item, const float* glu, const float* cw, const float* cb, const float* lng, const float* lnb, bf16* ycat) {
    const int t0 = item * 32, b = t0 / SEQ, s0 = t0 % SEQ, ch = c.tid;
    LAS float* sc = (LAS float*)c.lds;
    float v[62], w[31];
#pragma unroll
    for (int i = 0; i < 62; ++i) { const int s = s0 + i - 15; v[i] = (s >= 0 && s < SEQ) ? glu[((size_t)b * SEQ + s) * 512 + ch] : 0.f; }
#pragma unroll
    for (int j = 0; j < 31; ++j) w[j] = cw[j * 512 + ch];
    const float bias = cb[ch];
    __syncthreads();
#pragma unroll
    for (int i = 0; i < 32; ++i) { float acc = bias;
#pragma unroll
        for (int j = 0; j < 31; ++j) acc += w[j] * v[i + j];
        sc[i * 512 + ch] = acc; }
    __syncthreads();
#pragma unroll
    for (int q = 0; q < 4; ++q) {
        const int i = c.wave * 4 + q; float x[8]; float sm = 0.f;
#pragma unroll
        for (int m = 0; m < 8; ++m) { x[m] = sc[i * 512 + c.lane + 64 * m]; sm += x[m]; }
        const float mean = wave_sum(sm) * (1.0f / 512.0f); float sq = 0.f;
#pragma unroll
        for (int m = 0; m < 8; ++m) { x[m] -= mean; sq += x[m] * x[m]; }
        const float rstd = 1.0f / sqrtf(wave_sum(sq) * (1.0f / 512.0f) + EPS);
#pragma unroll
        for (int m = 0; m < 8; ++m) { const int cc = c.lane + 64 * m; const float y = x[m] * rstd * lng[cc] + lnb[cc];
            ycat[(size_t)(t0 + i) * D + cc] = (bf16)f2bf(y * sigmoidf_(y)); }
    }
}

template <bool WIN>
DI void attn_item(const Ctx& c, int item, const bf16* qb, const bf16* kb, const bf16* vt, bf16* ycat, int ycol0, const float* sink) {
    const int qblk = item & 63, kvh = (item >> 6) & 1, b = item >> 7;
    const int tid = c.tid, lane = c.lane, l31 = lane & 31, h = lane >> 5;
    const int head = kvh * 4 + (c.wave & 3), q0 = qblk * 64 + (c.wave >> 2) * 32;
    const bf16* qrow = qb + ((size_t)(b * 8 + head) * SEQ + q0 + l31) * 64;
    bf16x8 qf[4];
#pragma unroll
    for (int kk = 0; kk < 4; ++kk) qf[kk] = *(const bf16x8*)(qrow + 16 * kk + 8 * h);
    f32x16 o0, o1;
#pragma unroll
    for (int i = 0; i < 16; ++i) { o0[i] = 0.f; o1[i] = 0.f; }
    float m, l;
    if (WIN) { m = sink[head] * LOG2E; l = (h == 0) ? 1.f : 0.f; } else { m = -1e30f; l = 0.f; }
    const bf16* kbase = kb + (size_t)(b * 2 + kvh) * SEQ * 64;
    const bf16* vbase = vt + (size_t)(b * 2 + kvh) * 64 * SEQ;
    int t_lo = 0, t_hi = 63;
    if (WIN) { t_lo = qblk - 2 < 0 ? 0 : qblk - 2; t_hi = qblk + 2 > 63 ? 63 : qblk + 2; }
    LAS unsigned char* sK = c.lds; LAS unsigned char* sV = c.lds + 64 * 144;
    const int qpos = q0 + l31;
    for (int kt = t_lo; kt <= t_hi; ++kt) {
        const u32x4 rk = *(const u32x4*)(kbase + (size_t)(kt * 64 + (tid >> 3)) * 64 + (tid & 7) * 8);
        const u32x4 rv = *(const u32x4*)(vbase + (size_t)(tid >> 3) * SEQ + kt * 64 + (tid & 7) * 8);
        __syncthreads();
        *(LAS u32x4*)(sK + (tid >> 3) * 144 + (tid & 7) * 16) = rk;
        { u32x2 a; a.x = rv.x; a.y = rv.y; u32x2 bb; bb.x = rv.z; bb.y = rv.w;
          *(LAS u32x2*)(sV + (tid >> 3) * 136 + (tid & 7) * 16) = a; *(LAS u32x2*)(sV + (tid >> 3) * 136 + (tid & 7) * 16 + 8) = bb; }
        __syncthreads();
        f32x16 s0, s1;
#pragma unroll
        for (int i = 0; i < 16; ++i) { s0[i] = 0.f; s1[i] = 0.f; }
#pragma unroll
        for (int kk = 0; kk < 4; ++kk) {
            const bf16x8 k0 = *(const LAS bf16x8*)(sK + l31 * 144 + (16 * kk + 8 * h) * 2);
            const bf16x8 k1 = *(const LAS bf16x8*)(sK + (32 + l31) * 144 + (16 * kk + 8 * h) * 2);
            s0 = MFMA32(k0, qf[kk], s0); s1 = MFMA32(k1, qf[kk], s1);
        }
        if (WIN) {
#pragma unroll
            for (int r = 0; r < 16; ++r) {
                const int kp0 = kt * 64 + crow(r, h), kp1 = kp0 + 32;
                const int d0 = kp0 - qpos, d1 = kp1 - qpos;
                if (d0 > 128 || d0 < -128) s0[r] = -1e30f;
                if (d1 > 128 || d1 < -128) s1[r] = -1e30f;
            }
        }
        float mx = s0[0];
#pragma unroll
        for (int r = 1; r < 16; ++r) mx = fmaxf(mx, s0[r]);
#pragma unroll
        for (int r = 0; r < 16; ++r) mx = fmaxf(mx, s1[r]);
        mx = fmaxf(mx, __shfl_xor(mx, 32));
        const float mn = fmaxf(m, mx), alpha = __builtin_amdgcn_exp2f(m - mn); m = mn;
        float ls = 0.f;
#pragma unroll
        for (int r = 0; r < 16; ++r) { s0[r] = __builtin_amdgcn_exp2f(s0[r] - mn); s1[r] = __builtin_amdgcn_exp2f(s1[r] - mn); ls += s0[r] + s1[r]; }
        l = l * alpha + ls;
#pragma unroll
        for (int i = 0; i < 16; ++i) { o0[i] *= alpha; o1[i] *= alpha; }
#pragma unroll
        for (int tl = 0; tl < 2; ++tl)
#pragma unroll
            for (int st = 0; st < 2; ++st) {
                u32x4 pp;
                if (tl == 0) { pp.x = pk2(s0[8 * st], s0[8 * st + 1]); pp.y = pk2(s0[8 * st + 2], s0[8 * st + 3]); pp.z = pk2(s0[8 * st + 4], s0[8 * st + 5]); pp.w = pk2(s0[8 * st + 6], s0[8 * st + 7]); }
                else         { pp.x = pk2(s1[8 * st], s1[8 * st + 1]); pp.y = pk2(s1[8 * st + 2], s1[8 * st + 3]); pp.z = pk2(s1[8 * st + 4], s1[8 * st + 5]); pp.w = pk2(s1[8 * st + 6], s1[8 * st + 7]); }
                const bf16x8 pf = __builtin_bit_cast(bf16x8, pp);
                const int koff = (tl * 32 + 16 * st + 4 * h) * 2;
                {
                    const u32x2 lo = *(const LAS u32x2*)(sV + l31 * 136 + koff), hi = *(const LAS u32x2*)(sV + l31 * 136 + koff + 16);
                    u32x4 vv; vv.x = lo.x; vv.y = lo.y; vv.z = hi.x; vv.w = hi.y;
                    o0 = MFMA32(__builtin_bit_cast(bf16x8, vv), pf, o0);
                }
                {
                    const u32x2 lo = *(const LAS u32x2*)(sV + (32 + l31) * 136 + koff), hi = *(const LAS u32x2*)(sV + (32 + l31) * 136 + koff + 16);
                    u32x4 vv; vv.x = lo.x; vv.y = lo.y; vv.z = hi.x; vv.w = hi.y;
                    o1 = MFMA32(__builtin_bit_cast(bf16x8, vv), pf, o1);
                }
            }
    }
    const float lt = l + __shfl_xor(l, 32), inv = 1.0f / lt;
    bf16* orow = ycat + (size_t)(b * SEQ + q0 + l31) * D + ycol0 + head * 64;
#pragma unroll
    for (int g = 0; g < 4; ++g) {
        u32x2 w0; w0.x = pk2(o0[4 * g] * inv, o0[4 * g + 1] * inv); w0.y = pk2(o0[4 * g + 2] * inv, o0[4 * g + 3] * inv);
        u32x2 w1; w1.x = pk2(o1[4 * g] * inv, o1[4 * g + 1] * inv); w1.y = pk2(o1[4 * g + 2] * inv, o1[4 * g + 3] * inv);
        *(u32x2*)(orow + 8 * g + 4 * h) = w0; *(u32x2*)(orow + 32 + 8 * g + 4 * h) = w1;
    }
    __syncthreads();
}

DI void sgu_item(const Ctx& c, int item, const float* sw, const float* sb, const bf16* vn, const float* ug, bf16* ycat) {
    const int g = item & 3, n = (item >> 2) & 31, b = item >> 7;
    const int tid = c.tid, lane = c.lane, l31 = lane & 31, h = lane >> 5;
    LAS unsigned char* sW = c.lds; LAS unsigned char* sV = c.lds + 128 * 272;
    const float* wg = sw + (size_t)g * 128 * 128;
    __syncthreads();
#pragma unroll
    for (int i = 0; i < 4; ++i) { const int idx = tid + NT * i, row = idx >> 4, ch = idx & 15;
        const f32x4 a = *(const f32x4*)(wg + row * 128 + ch * 8), bq = *(const f32x4*)(wg + row * 128 + ch * 8 + 4);
        u32x4 o; o.x = pk2(a.x, a.y); o.y = pk2(a.z, a.w); o.z = pk2(bq.x, bq.y); o.w = pk2(bq.z, bq.w);
        *(LAS u32x4*)(sW + row * 272 + ch * 16) = o;
        const u32x4 vv = *(const u32x4*)(vn + ((size_t)b * SEQ + n * 128 + row) * 512 + g * 128 + ch * 8);
        *(LAS u32x4*)(sV + row * 272 + ch * 16) = vv; }
    __syncthreads();
    const int ct = c.wave & 3, pt0 = (c.wave >> 2) * 2;
    f32x16 acc[2];
#pragma unroll
    for (int j = 0; j < 2; ++j)
#pragma unroll
        for (int i = 0; i < 16; ++i) acc[j][i] = 0.f;
#pragma unroll
    for (int kk = 0; kk < 8; ++kk) {
        bf16x8 bfr;
#pragma unroll
        for (int j = 0; j < 8; ++j) bfr[j] = *(const LAS short*)(sV + (16 * kk + 8 * h + j) * 272 + (ct * 32 + l31) * 2);
#pragma unroll
        for (int j = 0; j < 2; ++j) {
            const bf16x8 af = *(const LAS bf16x8*)(sW + ((pt0 + j) * 32 + l31) * 272 + (16 * kk + 8 * h) * 2);
            acc[j] = MFMA32(af, bfr, acc[j]);
        }
    }
#pragma unroll
    for (int j = 0; j < 2; ++j)
#pragma unroll
        for (int r = 0; r < 16; ++r) {
            const int p = (pt0 + j) * 32 + crow(r, h), cc = ct * 32 + l31; const size_t t = (size_t)b * SEQ + n * 128 + p;
            const float mixed = acc[j][r] + sb[g * 128 + p];
            ycat[t * D + 512 + g * 128 + cc] = (bf16)f2bf(ug[t * 512 + g * 128 + cc] * mixed);
        }
}

DI void wave_argmax(float& v, int& i) {
#pragma unroll
    for (int o = 1; o < 64; o <<= 1) { const float ov = __shfl_xor(v, o); const int oi = __shfl_xor(i, o);
        if (ov > v || (ov == v && oi < i)) { v = ov; i = oi; } }
}
DI void phase_topk(const Ctx& c, const float* sc, int* eidx, float* gate) {
    const int gw = c.vcu * NWAVES + c.wave, NGW = c.G * NWAVES, lane = c.lane;
    for (int it = gw; it < T * 8; it += NGW) {
        const int t = it >> 3, hd = it & 7;
        const float* s = sc + (size_t)t * 2048 + hd * 256;
        float sv[2]; int si[2];
#pragma unroll
        for (int p = 0; p < 2; ++p) {
            float v0 = s[p * 128 + lane], v1 = s[p * 128 + 64 + lane]; float rsv = 0.f; int rsi = 0;
            for (int r = 0; r < 16; ++r) {
                float bv; int bi; if (v1 > v0) { bv = v1; bi = lane + 64; } else { bv = v0; bi = lane; }
                wave_argmax(bv, bi);
                if (lane == r) { rsv = bv; rsi = bi; }
                if (bi == lane) v0 = -3.0e38f; if (bi == lane + 64) v1 = -3.0e38f;
            }
            sv[p] = rsv; si[p] = rsi;
        }
        float cv[4];
#pragma unroll
        for (int m = 0; m < 4; ++m) cv[m] = __shfl(sv[0], (lane >> 4) + 4 * m) + __shfl(sv[1], lane & 15);
        float fv = 0.f; int fi = 0;
        for (int r = 0; r < 16; ++r) {
            float bv = cv[0]; int bi = lane;
#pragma unroll
            for (int m = 1; m < 4; ++m) if (cv[m] > bv) { bv = cv[m]; bi = lane + 64 * m; }
            wave_argmax(bv, bi);
            if (lane == r) { fv = bv; fi = bi; }
#pragma unroll
            for (int m = 0; m < 4; ++m) if (bi == lane + 64 * m) cv[m] = -3.0e38f;
        }
        const int i1 = __shfl(si[0], fi >> 4), i2 = __shfl(si[1], fi & 15);
        const float mx = __shfl(fv, 0);
        const float e = (lane < 16) ? __expf(fv - mx) : 0.f;
        const float sum = wave_sum(e);
        if (lane < 16) { eidx[(size_t)t * 128 + hd * 16 + lane] = i1 * 128 + i2; gate[(size_t)t * 128 + hd * 16 + lane] = e / sum; }
    }
}

DI unsigned fkey(float f, unsigned code, unsigned mask) { const unsigned b = __float_as_uint(f); const unsigned s = b ^ ((unsigned)((int)b >> 31) | 0x80000000u); return (s & ~mask) | code; }
DI float keyval(unsigned k, unsigned mask, unsigned mid) { const unsigned s = (k & ~mask) | mid; const unsigned b = (s & 0x80000000u) ? (s ^ 0x80000000u) : ~s; return __uint_as_float(b); }
#define CE_DESC(x, y) do { const unsigned mx_ = (x) > (y) ? (x) : (y), mn_ = (x) > (y) ? (y) : (x); (x) = mx_; (y) = mn_; } while (0)
DI void sort16_desc(unsigned (&a)[16]) {
#pragma unroll
    for (int k = 2; k <= 16; k <<= 1)
#pragma unroll
        for (int j = k >> 1; j > 0; j >>= 1)
#pragma unroll
            for (int i = 0; i < 16; ++i) { const int l = i ^ j; if (l > i) { if ((i & k) == 0 || k == 16) CE_DESC(a[i], a[l]); else CE_DESC(a[l], a[i]); } }
}
DI void merge16_desc(unsigned (&a)[16], const unsigned (&b)[16]) {
#pragma unroll
    for (int i = 0; i < 16; ++i) a[i] = a[i] > b[15 - i] ? a[i] : b[15 - i];
#pragma unroll
    for (int j = 8; j > 0; j >>= 1)
#pragma unroll
        for (int i = 0; i < 16; ++i) { const int l = i ^ j; if (l > i) CE_DESC(a[i], a[l]); }
}
DI void pair_merge16(unsigned (&a)[16]) {
    unsigned lo[16], hi[16];
#pragma unroll
    for (int i = 0; i < 16; ++i) { const auto r = __builtin_amdgcn_permlane32_swap(a[i], a[i], false, false); lo[i] = r[0]; hi[i] = r[1]; }
    merge16_desc(lo, hi);
#pragma unroll
    for (int i = 0; i < 16; ++i) a[i] = lo[i];
}
struct CandTab { int ci[64], cj[64]; constexpr CandTab() : ci(), cj() { int n = 0; for (int i = 0; i < 16; ++i) for (int j = 0; j < 16; ++j) if ((i + 1) * (j + 1) <= 16) { ci[n] = i; cj[n] = j; ++n; } for (; n < 64; ++n) { ci[n] = -1; cj[n] = -1; } } };
constexpr CandTab CAND{};
DI unsigned pick_byte(unsigned w0, unsigned w1, unsigned w2, unsigned w3, unsigned i) {
    const unsigned w = (i & 8u) ? ((i & 4u) ? w3 : w2) : ((i & 4u) ? w1 : w0);
    return (w >> ((i & 3u) * 8u)) & 0xFFu;
}
DI void route_item(const Ctx& c, int item, const bf16* qp, const bf16* sk, int* eidx, float* gate) {
    const int hd = item & 7, tb = item >> 3;
    const int tid = c.tid, lane = c.lane, l31 = lane & 31, h = lane >> 5;
    LAS unsigned char* sS = c.lds;
    __syncthreads();
#pragma unroll
    for (int i = 0; i < 4; ++i) { const int idx = tid + NT * i, row = idx >> 3, ch = idx & 7;
        *(LAS u32x4*)(sS + row * 144 + ch * 16) = *(const u32x4*)(sk + (size_t)hd * 2 * 128 * 64 + (size_t)row * 64 + ch * 8); }
    const int t = tb * 256 + c.wave * 32 + l31;
    const bf16* qrow = qp + (size_t)t * D + hd * 128;
    bf16x8 qf[8];
#pragma unroll
    for (int kk = 0; kk < 8; ++kk) qf[kk] = *(const bf16x8*)(qrow + 16 * kk + 8 * h);
    __syncthreads();
    unsigned sv[2][16];
#pragma unroll
    for (int p = 0; p < 2; ++p) {
        unsigned top[16];
#pragma unroll
        for (int tl = 0; tl < 4; ++tl) {
            f32x16 acc;
#pragma unroll
            for (int i = 0; i < 16; ++i) acc[i] = 0.f;
#pragma unroll
            for (int kk = 0; kk < 4; ++kk) {
                const bf16x8 af = *(const LAS bf16x8*)(sS + (p * 128 + tl * 32 + l31) * 144 + (16 * kk + 8 * h) * 2);
                acc = MFMA32(af, qf[p * 4 + kk], acc);
            }
            unsigned g[16];
#pragma unroll
            for (int r = 0; r < 16; ++r) g[r] = fkey(acc[r], (unsigned)(127 - (tl * 32 + (r & 3) + 8 * (r >> 2))) - 4u * (unsigned)h, 127u);
            sort16_desc(g);
            if (tl == 0) {
#pragma unroll
                for (int i = 0; i < 16; ++i) top[i] = g[i];
            } else merge16_desc(top, g);
        }
        pair_merge16(top);
#pragma unroll
        for (int i = 0; i < 16; ++i) sv[p][i] = top[i];
    }
    float v0[16], v1[16];
#pragma unroll
    for (int i = 0; i < 16; ++i) { v0[i] = keyval(sv[0][i], 127u, 64u); v1[i] = keyval(sv[1][i], 127u, 64u); }
    unsigned ca[16], cb[16];
#pragma unroll
    for (int m = 0; m < 32; ++m) {
        constexpr int dummy = 0; (void)dummy;
        const int ia = CAND.ci[m], ja = CAND.cj[m], ib = CAND.ci[32 + m], jb = CAND.cj[32 + m];
        const unsigned ka = fkey(v0[ia] + v1[ja], (unsigned)(255 - (ia * 16 + ja)), 255u);
        const int ibc = ib >= 0 ? ib : 0, jbc = jb >= 0 ? jb : 0;
        const unsigned kb2 = (ib >= 0) ? fkey(v0[ibc] + v1[jbc], (unsigned)(255 - (ibc * 16 + jbc)), 255u) : 0u;
        const unsigned kx = h ? kb2 : ka;
        if (m < 16) ca[m] = kx; else cb[m - 16] = kx;
    }
    sort16_desc(ca); sort16_desc(cb); merge16_desc(ca, cb);
    pair_merge16(ca);
    unsigned p0[4], p1[4];
#pragma unroll
    for (int w = 0; w < 4; ++w) { p0[w] = 0u; p1[w] = 0u;
#pragma unroll
        for (int q = 0; q < 4; ++q) { p0[w] |= (127u - (sv[0][4 * w + q] & 127u)) << (8 * q); p1[w] |= (127u - (sv[1][4 * w + q] & 127u)) << (8 * q); } }
    float fv[16]; int ex[16];
#pragma unroll
    for (int r = 0; r < 16; ++r) { const unsigned code = 255u - (ca[r] & 255u); fv[r] = keyval(ca[r], 255u, 128u);
        ex[r] = (int)(pick_byte(p0[0], p0[1], p0[2], p0[3], code >> 4) * 128u + pick_byte(p1[0], p1[1], p1[2], p1[3], code & 15u)); }
    float sum = 0.f; const float mxv = fv[0];
#pragma unroll
    for (int r = 0; r < 16; ++r) { fv[r] = __expf(fv[r] - mxv); sum += fv[r]; }
    const float inv = 1.0f / sum;
    int eo[8]; float go[8];
#pragma unroll
    for (int r = 0; r < 8; ++r) { eo[r] = h ? ex[8 + r] : ex[r]; go[r] = (h ? fv[8 + r] : fv[r]) * inv; }
    int* ep = eidx + (size_t)t * 128 + hd * 16 + 8 * h; float* gp = gate + (size_t)t * 128 + hd * 16 + 8 * h;
    typedef int i32x4 __attribute__((ext_vector_type(4)));
    i32x4 e0, e1; e0.x = eo[0]; e0.y = eo[1]; e0.z = eo[2]; e0.w = eo[3]; e1.x = eo[4]; e1.y = eo[5]; e1.z = eo[6]; e1.w = eo[7];
    f32x4 g0, g1; g0.x = go[0]; g0.y = go[1]; g0.z = go[2]; g0.w = go[3]; g1.x = go[4]; g1.y = go[5]; g1.z = go[6]; g1.w = go[7];
    *(i32x4*)ep = e0; *(i32x4*)(ep + 4) = e1; *(f32x4*)gp = g0; *(f32x4*)(gp + 4) = g1;
}

DI void phase_gather(const Ctx& c, const bf16* hb, const int* eidx, const float* gate, const bf16* ub, const bf16* vb, const float* x, float* xo) {
    const int gw = c.vcu * NWAVES + c.wave, NGW = c.G * NWAVES, lane = c.lane;
    for (int t = gw; t < T; t += NGW) {
        const u32x4 h0 = *((const u32x4*)(hb + (size_t)t * D) + lane), h1 = *((const u32x4*)(hb + (size_t)t * D) + 64 + lane);
        float hf[16];
        hf[0] = bf_lo(h0.x); hf[1] = bf_hi(h0.x); hf[2] = bf_lo(h0.y); hf[3] = bf_hi(h0.y); hf[4] = bf_lo(h0.z); hf[5] = bf_hi(h0.z); hf[6] = bf_lo(h0.w); hf[7] = bf_hi(h0.w);
        hf[8] = bf_lo(h1.x); hf[9] = bf_hi(h1.x); hf[10] = bf_lo(h1.y); hf[11] = bf_hi(h1.y); hf[12] = bf_lo(h1.z); hf[13] = bf_hi(h1.z); hf[14] = bf_lo(h1.w); hf[15] = bf_hi(h1.w);
        const int e0 = eidx[(size_t)t * 128 + lane], e1 = eidx[(size_t)t * 128 + 64 + lane];
        const float g0 = gate[(size_t)t * 128 + lane], g1 = gate[(size_t)t * 128 + 64 + lane];
        float acc[16];
#pragma unroll
        for (int i = 0; i < 16; ++i) acc[i] = 0.f;
        for (int k = 0; k < 128; k += 4) {
            u32x4 u0[4], u1[4], v0[4], v1[4]; float gk[4];
#pragma unroll
            for (int j = 0; j < 4; ++j) {
                const int kk = k + j; const int e = __shfl(kk < 64 ? e0 : e1, kk & 63); gk[j] = __shfl(kk < 64 ? g0 : g1, kk & 63);
                const u32x4* ur = (const u32x4*)(ub + (size_t)e * D); const u32x4* vr = (const u32x4*)(vb + (size_t)e * D);
                u0[j] = ur[lane]; u1[j] = ur[64 + lane]; v0[j] = vr[lane]; v1[j] = vr[64 + lane];
            }
#pragma unroll
            for (int j = 0; j < 4; ++j) {
                float d = bf_lo(u0[j].x) * hf[0] + bf_hi(u0[j].x) * hf[1] + bf_lo(u0[j].y) * hf[2] + bf_hi(u0[j].y) * hf[3]
                        + bf_lo(u0[j].z) * hf[4] + bf_hi(u0[j].z) * hf[5] + bf_lo(u0[j].w) * hf[6] + bf_hi(u0[j].w) * hf[7]
                        + bf_lo(u1[j].x) * hf[8] + bf_hi(u1[j].x) * hf[9] + bf_lo(u1[j].y) * hf[10] + bf_hi(u1[j].y) * hf[11]
                        + bf_lo(u1[j].z) * hf[12] + bf_hi(u1[j].z) * hf[13] + bf_lo(u1[j].w) * hf[14] + bf_hi(u1[j].w) * hf[15];
                d = wave_sum(d);
                const float w = gelu_tanh(d) * gk[j];
                acc[0] += w * bf_lo(v0[j].x); acc[1] += w * bf_hi(v0[j].x); acc[2] += w * bf_lo(v0[j].y); acc[3] += w * bf_hi(v0[j].y);
                acc[4] += w * bf_lo(v0[j].z); acc[5] += w * bf_hi(v0[j].z); acc[6] += w * bf_lo(v0[j].w); acc[7] += w * bf_hi(v0[j].w);
                acc[8] += w * bf_lo(v1[j].x); acc[9] += w * bf_hi(v1[j].x); acc[10] += w * bf_lo(v1[j].y); acc[11] += w * bf_hi(v1[j].y);
                acc[12] += w * bf_lo(v1[j].z); acc[13] += w * bf_hi(v1[j].z); acc[14] += w * bf_lo(v1[j].w); acc[15] += w * bf_hi(v1[j].w);
            }
        }
        const f32x4* xr = (const f32x4*)(x + (size_t)t * D); f32x4* xw = (f32x4*)(xo + (size_t)t * D);
        f32x4 a = xr[2 * lane], bq = xr[2 * lane + 1], cq = xr[128 + 2 * lane], dq = xr[128 + 2 * lane + 1];
        a.x += acc[0]; a.y += acc[1]; a.z += acc[2]; a.w += acc[3]; bq.x += acc[4]; bq.y += acc[5]; bq.z += acc[6]; bq.w += acc[7];
        cq.x += acc[8]; cq.y += acc[9]; cq.z += acc[10]; cq.w += acc[11]; dq.x += acc[12]; dq.y += acc[13]; dq.z += acc[14]; dq.w += acc[15];
        xw[2 * lane] = a; xw[2 * lane + 1] = bq; xw[128 + 2 * lane] = cq; xw[128 + 2 * lane + 1] = dq;
    }
}

constexpr int STEPS_PER_LAYER = 9;
constexpr int NPHASES = 1 + DEPTH * STEPS_PER_LAYER + 1;

__global__ void __launch_bounds__(NT, 2) mk_fwd(Args args) {
    extern __shared__ __attribute__((aligned(16))) unsigned char lds_raw[];
    Ctx c0;
    c0.lds = (LAS unsigned char*)lds_raw;
    c0.tid = threadIdx.x; c0.lane = c0.tid & 63; c0.wave = __builtin_amdgcn_readfirstlane(c0.tid >> 6);
    c0.G = gridDim.x; { const int bx = blockIdx.x; c0.vcu = (c0.G % 8 == 0) ? (bx % 8) * (c0.G / 8) + bx / 8 : bx; }
    volatile LAS unsigned* misc = (volatile LAS unsigned*)(c0.lds + LDS_BYTES - 64);
    if (c0.tid < 16) misc[c0.tid] = 0u;
    if (c0.tid < 25) { const unsigned long long v = (c0.tid < 23) ? (unsigned long long)args.in[c0.tid] : (c0.tid == 23 ? (unsigned long long)args.out : (unsigned long long)args.ws);
        volatile LAS unsigned* p = (volatile LAS unsigned*)(c0.lds + ARGS_OFF) + 2 * c0.tid; p[0] = (unsigned)v; p[1] = (unsigned)(v >> 32); }
    __syncthreads();
    const int ph_lo = args.ph_lo, ph_hi = args.ph_hi;
    XcdBarrier bar; bar.bar = nullptr; bar.x = 0; bar.st = misc;
    const bool multi = (ph_hi - ph_lo) > 1;
    if (multi) bar = xcd_barrier_post((unsigned*)((unsigned char*)inp(c0, 24) + WS_CTL) + 4096, misc);

    for (int pc = 2 * ph_lo; pc < 2 * ph_hi; ++pc) {
        const int ph = pc >> 1, rep = pc & 1;
        const int st_ = (ph == 0) ? 10 : ((ph == NPHASES - 1) ? 11 : (ph - 1) % STEPS_PER_LAYER);
        if (rep && st_ != PROBE_STEP) continue;
        if (pc > 2 * ph_lo) xcd_barrier(bar);
        Ctx c = c0;
        asm volatile("" : "+v"(c.tid), "+v"(c.lane), "+s"(c.wave), "+s"(c.vcu));
        unsigned char* ws = (unsigned char*)inp(c, 24);
        float* xres = (float*)(ws + WS_XRES); bf16* hb = (bf16*)(ws + WS_HB); bf16* ycat = (bf16*)(ws + WS_YCAT);
        float* z = (float*)(ws + WS_Z); bf16* qp = (bf16*)(ws + WS_QP); bf16* qb = (bf16*)(ws + WS_QB); bf16* kb = (bf16*)(ws + WS_KB); bf16* vt = (bf16*)(ws + WS_VT);
        float* glu = (float*)(ws + WS_GLU); bf16* vn = (bf16*)(ws + WS_VN); int* eidx = (int*)(ws + WS_EIDX); float* gate = (float*)(ws + WS_GATE);
        const float* rope = (const float*)(ws + WS_ROPE);
        if (ph == 0) phase_prologue(c, ws);
        else if (ph == NPHASES - 1) phase_final(c, xres, inp(c, 3), (float*)inp(c, 23));
        else {
            const int l = (ph - 1) / STEPS_PER_LAYER, st = (ph - 1) % STEPS_PER_LAYER, i = l >> 1; const bool odd = l & 1;
            switch (st) {
            case 0: phase_norm(c, xres, inp(c, 1) + (size_t)l * D, hb); break;
            case 1: phase_gemm<0>(c, hb, (const bf16*)(ws + WS_WIN) + (size_t)l * NIN * D, NIN, z); break;
            case 2:
                if (!odd) phase_epi_even(c, z, rope, glu, qb, kb, vt);
                else phase_epi_odd(c, z, rope, inp(c, 13) + i * 64, inp(c, 14) + i * 64, inp(c, 15) + i * 512, inp(c, 16) + i * 512, glu, vn, qb, kb, vt);
                break;
            case 3:
                if (!odd) {
                    for (int it = c.vcu; it < 512; it += c.G) attn_item<true>(c, it, qb, kb, vt, ycat, 512, inp(c, 10) + i * 8);
                    for (int it = c.vcu; it < 512; it += c.G) conv_item(c, it, glu, inp(c, 6) + (size_t)i * 31 * 512, inp(c, 7) + i * 512, inp(c, 8) + i * 512, inp(c, 9) + i * 512, ycat);
                } else {
                    for (int it = c.vcu; it < 512; it += c.G) attn_item<false>(c, it, qb, kb, vt, ycat, 0, nullptr);
                    for (int it = c.vcu; it < 512; it += c.G) sgu_item(c, it, inp(c, 17) + (size_t)i * 4 * 128 * 128, inp(c, 18) + i * 512, vn, glu, ycat);
                }
                break;
            case 4: if (rep) phase_gemm<0>(c, ycat, (const bf16*)(ws + WS_WOUT) + (size_t)l * D * D, D, z); else phase_gemm<1>(c, ycat, (const bf16*)(ws + WS_WOUT) + (size_t)l * D * D, D, xres); break;
            case 5: phase_norm(c, xres, inp(c, 2) + (size_t)l * D, hb); break;
            case 6: phase_gemm<2>(c, hb, (const bf16*)(ws + WS_WQ) + (size_t)l * D * D, D, qp); break;
            case 7: for (int it = c.vcu; it < 512; it += c.G) route_item(c, it, qp, (const bf16*)(ws + WS_SK) + (size_t)l * 16 * 128 * 64, eidx, gate); break;
            case 8: phase_gather(c, hb, eidx, gate, (const bf16*)(ws + WS_UB) + (size_t)l * PEER_E * D, (const bf16*)(ws + WS_VB) + (size_t)l * PEER_E * D, xres, rep ? z : xres); break;
            }
        }
    }
}
}

extern "C" void kernel_launch(void* const* d_in, const int* in_sizes, int n_in, void* d_out, int out_size, void* d_ws, size_t ws_size, hipStream_t stream) {
    static int grid = 0;
    if (grid == 0) {
        if (n_in != 23 || out_size != T * D || ws_size < WS_END) { fprintf(stderr, "kernel_launch: unexpected shapes n_in %d out %d ws %zu (need %zu)\n", n_in, out_size, ws_size, (size_t)WS_END); grid = -1; return; }
        int dev = 0, cus = 0;
        if (hipGetDevice(&dev) != hipSuccess || hipDeviceGetAttribute(&cus, hipDeviceAttributeMultiprocessorCount, dev) != hipSuccess) { grid = -1; return; }
        if (hipFuncSetAttribute((const void*)mk_fwd, hipFuncAttributeMaxDynamicSharedMemorySize, LDS_BYTES) != hipSuccess) { fprintf(stderr, "kernel_launch: hipFuncSetAttribute failed\n"); grid = -1; return; }
        (void)hipGetLastError();
        grid = cus;
    }
    if (grid < 0) return;
    (void)hipMemsetAsync((char*)d_ws + WS_CTL, 0, 1 * MiB, stream);
    Args a{};
    for (int i = 0; i < 23; ++i) a.in[i] = (const float*)d_in[i];
    a.out = (float*)d_out; a.ws = (unsigned char*)d_ws;
#if MK_ONE_LAUNCH
    a.ph_lo = 0; a.ph_hi = NPHASES;
    hipLaunchKernelGGL(mk_fwd, dim3(grid), dim3(NT), LDS_BYTES, stream, a);
#else
    for (int p = 0; p < NPHASES; ++p) { a.ph_lo = p; a.ph_hi = p + 1; hipLaunchKernelGGL(mk_fwd, dim3(grid), dim3(NT), LDS_BYTES, stream, a); }
#endif
}
```

```cpp
#include <hip/hip_runtime.h>
#include <cstdio>
#include <cstdint>

#ifndef MK_ONE_LAUNCH
#define MK_ONE_LAUNCH 1
#endif
#ifndef PROBE_STEP
#define PROBE_STEP -1
#endif

namespace {
constexpr int D = 1024, BATCH = 4, SEQ = 4096, T = BATCH * SEQ, DEPTH = 4;
constexpr int NIN = 1792, HD = 64, NQH = 8, NKVH = 2;
constexpr int PEER_E = 16384;
constexpr float EPS = 1e-6f;
constexpr float LOG2E = 1.4426950408889634f;
constexpr int NWAVES = 8, NT = NWAVES * 64;

constexpr size_t MiB = 1u << 20;
constexpr size_t WS_CTL = 0;
constexpr size_t WS_XRES = 1 * MiB;
constexpr size_t WS_HB = WS_XRES + 64 * MiB;
constexpr size_t WS_YCAT = WS_HB + 32 * MiB;
constexpr size_t WS_Z = WS_YCAT + 32 * MiB;
constexpr size_t WS_QP = WS_Z + 128 * MiB;
constexpr size_t WS_QB = WS_QP + 32 * MiB;
constexpr size_t WS_KB = WS_QB + 16 * MiB;
constexpr size_t WS_VT = WS_KB + 4 * MiB;
constexpr size_t WS_GLU = WS_VT + 4 * MiB;
constexpr size_t WS_VN = WS_GLU + 32 * MiB;
constexpr size_t WS_EIDX = WS_VN + 16 * MiB;
constexpr size_t WS_GATE = WS_EIDX + 8 * MiB;
constexpr size_t WS_WIN = WS_GATE + 8 * MiB;
constexpr size_t WS_WOUT = WS_WIN + 14 * MiB;
constexpr size_t WS_WQ = WS_WOUT + 8 * MiB;
constexpr size_t WS_SK = WS_WQ + 8 * MiB;
constexpr size_t WS_ROPE = WS_SK + 1 * MiB;
constexpr size_t WS_SCL = WS_ROPE + 2 * MiB;
constexpr size_t WS_UB = WS_SCL + 1 * MiB;
constexpr size_t WS_VB = WS_UB + 128 * MiB;
constexpr size_t WS_END = WS_VB + 128 * MiB;

constexpr int LDS_BYTES = 147456;

#define LAS __attribute__((address_space(3)))
typedef unsigned short bf16;
typedef short bf16x8 __attribute__((ext_vector_type(8)));
typedef float f32x4 __attribute__((ext_vector_type(4)));
typedef float f32x16 __attribute__((ext_vector_type(16)));
typedef unsigned u32x4 __attribute__((ext_vector_type(4)));
typedef unsigned u32x2 __attribute__((ext_vector_type(2)));
#define DI __device__ __forceinline__
#define MFMA32(a, b, c) __builtin_amdgcn_mfma_f32_32x32x16_bf16((a), (b), (c), 0, 0, 0)

DI unsigned f2bf(float f) { unsigned u = __float_as_uint(f); return (u + 0x7fffu + ((u >> 16) & 1u)) >> 16; }
DI unsigned pk2(float lo, float hi) { return f2bf(lo) | (f2bf(hi) << 16); }
DI float bf_lo(unsigned w) { return __uint_as_float(w << 16); }
DI float bf_hi(unsigned w) { return __uint_as_float(w & 0xffff0000u); }
DI float wave_sum(float v) {
#pragma unroll
    for (int o = 1; o < 64; o <<= 1) v += __shfl_xor(v, o);
    return v;
}
DI float sigmoidf_(float x) { return 1.0f / (1.0f + __expf(-x)); }
DI float gelu_tanh(float x) {
    const float u = 0.7978845608028654f * (x + 0.044715f * x * x * x);
    const float e = __expf(2.0f * u);
    const float th = 1.0f - 2.0f / (e + 1.0f);
    return 0.5f * x * (1.0f + th);
}
DI int crow(int reg, int h) { return (reg & 3) + 8 * (reg >> 2) + 4 * h; }

struct Args {
    const float* in[23];
    float* out;
    unsigned char* ws;
    int ph_lo, ph_hi;
};

struct Ctx {
    LAS unsigned char* lds;
    int tid, lane, wave, vcu, G;
};
constexpr int ARGS_OFF = 147456 - 512;
DI const float* inp(const Ctx& c, int k) {
    volatile LAS unsigned* p = (volatile LAS unsigned*)(c.lds + ARGS_OFF) + 2 * k;
    const unsigned lo = __builtin_amdgcn_readfirstlane(p[0]), hi = __builtin_amdgcn_readfirstlane(p[1]);
    return (const float*)(((unsigned long long)hi << 32) | lo);
}

#define XB_TMO      128
#define XB_XCNT(j)  (256  + 64 * (j))
#define XB_XSUB(j)  (1280 + 64 * (j))
#define XB_XGEN(j)  (2304 + 64 * (j))
#define XB_TOP      3328
#define XB_TOPGEN   3392
#define XCD_BAR_WORDS 3456
#define XB_SPIN_CAP (1u << 22)
DI unsigned xb_ld(unsigned* p) { return __hip_atomic_load(p, __ATOMIC_RELAXED, __HIP_MEMORY_SCOPE_AGENT); }
DI unsigned xb_add(unsigned* p, unsigned v) { return __hip_atomic_fetch_add(p, v, __ATOMIC_RELAXED, __HIP_MEMORY_SCOPE_AGENT); }
DI unsigned xb_xcc_id() { return (unsigned)__builtin_amdgcn_s_getreg((3 << 11) | 20) & 0xFu; }
#define XB_SPIN(cond, bar) do { unsigned _sp = 0; while (cond) { __builtin_amdgcn_s_sleep(1); \
    if ((++_sp & 255u) == 0u) { if (xb_ld(&(bar)[XB_TMO])) break; if (_sp > XB_SPIN_CAP) { atomicAdd(&(bar)[XB_TMO], 1u); break; } } } } while (0)
struct XcdBarrier { unsigned* bar; unsigned x; volatile LAS unsigned* st; };
DI XcdBarrier xcd_barrier_post(unsigned* bar, volatile LAS unsigned* st) {
    XcdBarrier b; b.bar = bar; b.x = xb_xcc_id(); b.st = st;
    if (threadIdx.x == 0) (void)xb_add(&bar[XB_XCNT(b.x)], 1u);
    return b;
}
DI void xcd_barrier_complete(unsigned* bar, unsigned x, unsigned& nloc, unsigned& nx) {
    const unsigned G = gridDim.x * gridDim.y * gridDim.z;
    unsigned sum, cnt, mine, sp = 0u;
    for (;;) {
        sum = 0u; cnt = 0u; mine = 0u;
#pragma unroll
        for (unsigned j = 0; j < 16; ++j) { const unsigned c = xb_ld(&bar[XB_XCNT(j)]); sum += c; cnt += (c > 0u) ? 1u : 0u; mine = (j == x) ? c : mine; }
        if (sum == G) break;
        __builtin_amdgcn_s_sleep(1);
        if ((++sp & 255u) == 0u) { if (xb_ld(&bar[XB_TMO])) break; if (sp > XB_SPIN_CAP) { atomicAdd(&bar[XB_TMO], 1u); break; } }
    }
    nloc = mine > 0u ? mine : 1u; nx = cnt > 0u ? cnt : 1u;
}
DI void xcd_barrier(const XcdBarrier& b) {
    asm volatile("s_waitcnt vmcnt(0)" ::: "memory");
    __syncthreads();
    if (threadIdx.x == 0) {
        unsigned* bar = b.bar;
        __builtin_amdgcn_s_waitcnt(0);
        unsigned nloc = b.st[0], nx = b.st[1];
        if (nloc == 0u) { xcd_barrier_complete(bar, b.x, nloc, nx); b.st[0] = nloc; b.st[1] = nx; }
        const unsigned old = xb_add(&bar[XB_XSUB(b.x)], 1u);
        const unsigned gen = old / nloc;
        if (old + 1u == (gen + 1u) * nloc) {
            __builtin_amdgcn_fence(__ATOMIC_RELEASE, "agent");
            asm volatile("s_waitcnt vmcnt(0)" ::: "memory");
            const unsigned og = xb_add(&bar[XB_TOP], 1u);
            const unsigned tg = og / nx;
            if (og + 1u == (tg + 1u) * nx) xb_add(&bar[XB_TOPGEN], 1u);
            else XB_SPIN(xb_ld(&bar[XB_TOPGEN]) == tg, bar);
            __builtin_amdgcn_fence(__ATOMIC_ACQUIRE, "agent");
            xb_add(&bar[XB_XGEN(b.x)], 1u);
            asm volatile("s_waitcnt vmcnt(0)" ::: "memory");
        } else {
            XB_SPIN(xb_ld(&bar[XB_XGEN(b.x)]) == gen, bar);
            __builtin_amdgcn_fence(__ATOMIC_ACQUIRE, "agent");
            asm volatile("s_waitcnt vmcnt(0)" ::: "memory");
        }
    }
    __syncthreads();
}

DI void transpose_item(const float* W, int K, int N, bf16* WT, LAS float* scr, int item, int lane) {
    const int nblk = N / 32, kb = item / nblk, nb = item % nblk, k0 = 64 * kb, n0 = 32 * nb;
#pragma unroll 8
    for (int i = 0; i < 32; ++i) { const int kk = 2 * i + (lane >> 5); scr[kk * 33 + (lane & 31)] = W[(size_t)(k0 + kk) * N + n0 + (lane & 31)]; }
    asm volatile("s_waitcnt lgkmcnt(0)" ::: "memory");
    const int c = lane & 7;
#pragma unroll
    for (int j = 0; j < 4; ++j) { const int n = (lane >> 3) + 8 * j; const LAS float* s = scr + (8 * c) * 33 + n;
        u32x4 o; o.x = pk2(s[0 * 33], s[1 * 33]); o.y = pk2(s[2 * 33], s[3 * 33]); o.z = pk2(s[4 * 33], s[5 * 33]); o.w = pk2(s[6 * 33], s[7 * 33]);
        *(u32x4*)(WT + (size_t)(n0 + n) * K + k0 + 8 * c) = o; }
    asm volatile("s_waitcnt lgkmcnt(0)" ::: "memory");
}
DI void cvt_stream(const float* src, bf16* dst, size_t n8, size_t gtid, size_t gthreads) {
    for (size_t i = gtid; i < n8; i += gthreads) {
        const f32x4 a = *(const f32x4*)(src + i * 8), b = *(const f32x4*)(src + i * 8 + 4);
        u32x4 o; o.x = pk2(a.x, a.y); o.y = pk2(a.z, a.w); o.z = pk2(b.x, b.y); o.w = pk2(b.z, b.w);
        *(u32x4*)(dst + i * 8) = o;
    }
}

DI void phase_prologue(const Ctx& c, unsigned char* ws) {
    LAS float* scr = (LAS float*)(c.lds + c.wave * 8704);
    const int gw = c.vcu * NWAVES + c.wave, NGW = c.G * NWAVES;
    constexpr int I_IN = (D / 64) * (NIN / 32), I_SQ = (D / 64) * (D / 32), I_L = I_IN + 2 * I_SQ;
    for (int it = gw; it < DEPTH * I_L; it += NGW) {
        const int l = it / I_L; int r = it % I_L; const int i = l >> 1;
        if (r < I_IN) { const float* W = inp(c, (l & 1) ? 11 : 4) + (size_t)i * D * NIN;
            transpose_item(W, D, NIN, (bf16*)(ws + WS_WIN) + (size_t)l * NIN * D, scr, r, c.lane); continue; }
        r -= I_IN;
        if (r < I_SQ) { const float* W = inp(c, (l & 1) ? 12 : 5) + (size_t)i * D * D;
            transpose_item(W, D, D, (bf16*)(ws + WS_WOUT) + (size_t)l * D * D, scr, r, c.lane); continue; }
        r -= I_SQ;
        transpose_item(inp(c, 19) + (size_t)l * D * D, D, D, (bf16*)(ws + WS_WQ) + (size_t)l * D * D, scr, r, c.lane);
    }
    const size_t gtid = (size_t)c.vcu * NT + c.tid, gth = (size_t)c.G * NT;
    cvt_stream(inp(c, 20), (bf16*)(ws + WS_SK), (size_t)DEPTH * 16 * 128 * 64 / 8, gtid, gth);
    {
        const float* usrc = inp(c, 21); const float* vsrc = inp(c, 22); float* scl = (float*)(ws + WS_SCL);
        for (int r = gw; r < 2 * DEPTH * PEER_E; r += NGW) {
            const int tab = r >= DEPTH * PEER_E, row = tab ? r - DEPTH * PEER_E : r;
            const f32x4* src = (const f32x4*)((tab ? vsrc : usrc) + (size_t)row * D) + 4 * c.lane;
            f32x4 v[4]; float am = 0.f;
#pragma unroll
            for (int j = 0; j < 4; ++j) { v[j] = src[j]; am = fmaxf(am, fmaxf(fmaxf(fabsf(v[j].x), fabsf(v[j].y)), fmaxf(fabsf(v[j].z), fabsf(v[j].w)))); }
#pragma unroll
            for (int o = 1; o < 64; o <<= 1) am = fmaxf(am, __shfl_xor(am, o));
            float sc = 1.f;
            if (am > 0.f) sc = __uint_as_float(__float_as_uint(448.0f / am) & 0x7F800000u);
            u32x4 o;
            { int p = __builtin_amdgcn_cvt_pk_fp8_f32(v[0].x * sc, v[0].y * sc, 0, false); p = __builtin_amdgcn_cvt_pk_fp8_f32(v[0].z * sc, v[0].w * sc, p, true); o.x = (unsigned)p; }
            { int p = __builtin_amdgcn_cvt_pk_fp8_f32(v[1].x * sc, v[1].y * sc, 0, false); p = __builtin_amdgcn_cvt_pk_fp8_f32(v[1].z * sc, v[1].w * sc, p, true); o.y = (unsigned)p; }
            { int p = __builtin_amdgcn_cvt_pk_fp8_f32(v[2].x * sc, v[2].y * sc, 0, false); p = __builtin_amdgcn_cvt_pk_fp8_f32(v[2].z * sc, v[2].w * sc, p, true); o.z = (unsigned)p; }
            { int p = __builtin_amdgcn_cvt_pk_fp8_f32(v[3].x * sc, v[3].y * sc, 0, false); p = __builtin_amdgcn_cvt_pk_fp8_f32(v[3].z * sc, v[3].w * sc, p, true); o.w = (unsigned)p; }
            *((u32x4*)(ws + (tab ? WS_VB : WS_UB) + (size_t)row * D) + c.lane) = o;
            if (c.lane == 0) scl[r] = 1.0f / sc;
        }
    }
    const f32x4* xin = (const f32x4*)inp(c, 0);
    for (size_t i = gtid; i < (size_t)T * D / 4; i += gth) ((f32x4*)(ws + WS_XRES))[i] = xin[i];
    float* rope = (float*)(ws + WS_ROPE);
    for (size_t i = gtid; i < (size_t)SEQ * 32; i += gth) {
        const int pos = (int)(i >> 5), fi = (int)(i & 31);
        const float inv = (float)exp2(-(double)(2 * fi) / 64.0 * 13.287712379549449);
        const float ang = (float)pos * inv;
        const double rev = (double)ang * 0.15915494309189535; const float fr = (float)(rev - rint(rev));
        rope[i] = __builtin_amdgcn_cosf(fr); rope[(size_t)SEQ * 32 + i] = __builtin_amdgcn_sinf(fr);
    }
    for (size_t i = gtid; i < 64 * 16; i += gth) {
        const int pos = (int)(i >> 4), fi = (int)(i & 15);
        const float inv = (float)exp2(-(double)(2 * fi) / 32.0 * 13.287712379549449);
        const float ang = (float)pos * inv;
        const double rev = (double)ang * 0.15915494309189535; const float fr = (float)(rev - rint(rev));
        rope[(size_t)2 * SEQ * 32 + i] = __builtin_amdgcn_cosf(fr); rope[(size_t)2 * SEQ * 32 + 1024 + i] = __builtin_amdgcn_sinf(fr);
    }
}

DI void phase_norm(const Ctx& c, const float* x, const float* g, bf16* out) {
    const int gw = c.vcu * NWAVES + c.wave, NGW = c.G * NWAVES;
    for (int m = gw; m < T; m += NGW) {
        const f32x4* xr = (const f32x4*)(x + (size_t)m * D) + c.lane;
        f32x4 v[4]; float s = 0.f;
#pragma unroll
        for (int j = 0; j < 4; ++j) { v[j] = xr[64 * j]; s += (v[j].x * v[j].x + v[j].y * v[j].y) + (v[j].z * v[j].z + v[j].w * v[j].w); }
        const float r = 1.0f / sqrtf(wave_sum(s) * (1.0f / D) + EPS);
        u32x2* o8 = (u32x2*)(out + (size_t)m * D) + c.lane;
#pragma unroll
        for (int j = 0; j < 4; ++j) { const f32x4 gg = ((const f32x4*)g)[c.lane + 64 * j];
            u32x2 o; o.x = pk2(v[j].x * r * gg.x, v[j].y * r * gg.y); o.y = pk2(v[j].z * r * gg.z, v[j].w * r * gg.w); o8[64 * j] = o; }
    }
}
DI void phase_final(const Ctx& c, const float* x, const float* g, float* out) {
    const int gw = c.vcu * NWAVES + c.wave, NGW = c.G * NWAVES;
    for (int m = gw; m < T; m += NGW) {
        const f32x4* xr = (const f32x4*)(x + (size_t)m * D) + c.lane;
        f32x4 v[4]; float s = 0.f;
#pragma unroll
        for (int j = 0; j < 4; ++j) { v[j] = xr[64 * j]; s += (v[j].x * v[j].x + v[j].y * v[j].y) + (v[j].z * v[j].z + v[j].w * v[j].w); }
        const float r = 1.0f / sqrtf(wave_sum(s) * (1.0f / D) + EPS);
        f32x4* o = (f32x4*)(out + (size_t)m * D) + c.lane;
#pragma unroll
        for (int j = 0; j < 4; ++j) { const f32x4 gg = ((const f32x4*)g)[c.lane + 64 * j]; o[64 * j] = v[j] * r * gg; }
    }
}

template <int MODE>
DI void gemm_tile(const Ctx& c, const bf16* A, int lda, const bf16* Bt, int ldb, int K, void* Cout, int ldc) {
    LAS unsigned char* sA = c.lds; LAS unsigned char* sB = c.lds + 128 * 144;
    const int tid = c.tid, lane = c.lane, wr = c.wave >> 1, wc = c.wave & 1, l31 = lane & 31, h = lane >> 5;
    f32x16 acc[2];
#pragma unroll
    for (int j = 0; j < 2; ++j)
#pragma unroll
        for (int i = 0; i < 16; ++i) acc[j][i] = 0.f;
    for (int k0 = 0; k0 < K; k0 += 64) {
        u32x4 ra[2], rb[2];
#pragma unroll
        for (int i = 0; i < 2; ++i) { const int idx = tid + NT * i, row = idx >> 3, ch = idx & 7;
            ra[i] = *(const u32x4*)(A + (size_t)row * lda + k0 + ch * 8);
            rb[i] = *(const u32x4*)(Bt + (size_t)row * ldb + k0 + ch * 8); }
        __syncthreads();
#pragma unroll
        for (int i = 0; i < 2; ++i) { const int idx = tid + NT * i, row = idx >> 3, ch = idx & 7;
            *(LAS u32x4*)(sA + row * 144 + ch * 16) = ra[i];
            *(LAS u32x4*)(sB + row * 144 + ch * 16) = rb[i]; }
        __syncthreads();
#pragma unroll
        for (int kk = 0; kk < 4; ++kk) {
            const bf16x8 af = *(const LAS bf16x8*)(sA + (32 * wr + l31) * 144 + (16 * kk + 8 * h) * 2);
#pragma unroll
            for (int j = 0; j < 2; ++j) {
                const bf16x8 bfr = *(const LAS bf16x8*)(sB + (64 * wc + 32 * j + l31) * 144 + (16 * kk + 8 * h) * 2);
                acc[j] = MFMA32(af, bfr, acc[j]);
            }
        }
    }
#pragma unroll
    for (int j = 0; j < 2; ++j)
#pragma unroll
        for (int r = 0; r < 16; ++r) {
            const int row = 32 * wr + crow(r, h), col = 64 * wc + 32 * j + l31;
            if (MODE == 0) ((float*)Cout)[(size_t)row * ldc + col] = acc[j][r];
            else if (MODE == 1) { float* p = (float*)Cout + (size_t)row * ldc + col; *p = *p + acc[j][r]; }
            else ((bf16*)Cout)[(size_t)row * ldc + col] = (bf16)f2bf(acc[j][r]);
        }
}
template <int MODE>
DI void phase_gemm(const Ctx& c, const bf16* A, const bf16* Bt, int N, void* Cout) {
    const int nN = N / 128, ntiles = (T / 128) * nN;
    for (int it = c.vcu; it < ntiles; it += c.G) {
        const int tm = it / nN, tn = it % nN;
        if (MODE == 2) gemm_tile<MODE>(c, A + (size_t)tm * 128 * D, D, Bt + (size_t)tn * 128 * D, D, D, (bf16*)Cout + (size_t)tm * 128 * N + tn * 128, N);
        else gemm_tile<MODE>(c, A + (size_t)tm * 128 * D, D, Bt + (size_t)tn * 128 * D, D, D, (float*)Cout + (size_t)tm * 128 * N + tn * 128, N);
    }
}
DI void phase_scores(const Ctx& c, const bf16* qp, const bf16* sk, float* sc) {
    const int ntiles = (T / 128) * 16;
    for (int it = c.vcu; it < ntiles; it += c.G) {
        const int tm = it >> 4, hp = it & 15;
        gemm_tile<0>(c, qp + (size_t)tm * 128 * D + hp * 64, D, sk + (size_t)hp * 128 * 64, 64, 64, sc + (size_t)tm * 128 * 2048 + hp * 128, 2048);
    }
}

DI void phase_epi_even(const Ctx& c, const float* z, const float* rope, float* glu, bf16* qb, bf16* kb, bf16* vt) {
    const int gw = c.vcu * NWAVES + c.wave, NGW = c.G * NWAVES, lane = c.lane;
    for (int t = gw; t < T; t += NGW) {
        const float* zr = z + (size_t)t * NIN; const int b = t / SEQ, s = t % SEQ;
#pragma unroll
        for (int m = 0; m < 8; ++m) { const int ch = lane + 64 * m; glu[(size_t)t * 512 + ch] = zr[ch] * sigmoidf_(zr[512 + ch]); }
        const float cs = rope[(size_t)s * 32 + (lane & 31)], sn = rope[(size_t)SEQ * 32 + (size_t)s * 32 + (lane & 31)];
#pragma unroll
        for (int hh = 0; hh < 10; ++hh) {
            const float x = zr[1024 + hh * 64 + lane]; const float p = __shfl_xor(x, 32);
            float o = (lane < 32) ? (x * cs - p * sn) : (x * cs + p * sn);
            if (hh < 8) { o *= 0.125f * LOG2E; qb[((size_t)(b * 8 + hh) * SEQ + s) * 64 + lane] = (bf16)f2bf(o); }
            else kb[((size_t)(b * 2 + (hh - 8)) * SEQ + s) * 64 + lane] = (bf16)f2bf(o);
        }
#pragma unroll
        for (int kv = 0; kv < 2; ++kv) vt[((size_t)(b * 2 + kv) * 64 + lane) * SEQ + s] = (bf16)f2bf(zr[1664 + kv * 64 + lane]);
    }
}
DI void phase_epi_odd(const Ctx& c, const float* z, const float* rope, const float* qg, const float* kg, const float* lng, const float* lnb,
                      float* ug, bf16* vn, bf16* qb, bf16* kb, bf16* vt) {
    const int gw = c.vcu * NWAVES + c.wave, NGW = c.G * NWAVES, lane = c.lane;
    const float* axc = rope + (size_t)2 * SEQ * 32; const float* axs = axc + 1024;
    for (int t = gw; t < T; t += NGW) {
        const float* zr = z + (size_t)t * NIN; const int b = t / SEQ, s = t % SEQ;
        const int half = lane >> 5, dd = lane & 31, fi = dd & 15, pos = half ? (s & 63) : (s >> 6);
        const float cs = axc[pos * 16 + fi], sn = axs[pos * 16 + fi];
        const float gq = qg[lane], gk = kg[lane];
#pragma unroll
        for (int hh = 0; hh < 10; ++hh) {
            const float x = zr[hh * 64 + lane];
            const float r = 1.0f / sqrtf(wave_sum(x * x) * (1.0f / 64.0f) + EPS);
            const float xn = x * r * (hh < 8 ? gq : gk);
            const float p = __shfl_xor(xn, 16);
            float o = (dd < 16) ? (xn * cs - p * sn) : (xn * cs + p * sn);
            if (hh < 8) { o *= 0.125f * LOG2E; qb[((size_t)(b * 8 + hh) * SEQ + s) * 64 + lane] = (bf16)f2bf(o); }
            else kb[((size_t)(b * 2 + (hh - 8)) * SEQ + s) * 64 + lane] = (bf16)f2bf(o);
        }
#pragma unroll
        for (int kv = 0; kv < 2; ++kv) vt[((size_t)(b * 2 + kv) * 64 + lane) * SEQ + s] = (bf16)f2bf(zr[640 + kv * 64 + lane]);
        float gv[8]; float sm = 0.f;
#pragma unroll
        for (int m = 0; m < 8; ++m) { const int ch = lane + 64 * m; ug[(size_t)t * 512 + ch] = gelu_tanh(zr[768 + ch]); gv[m] = gelu_tanh(zr[1280 + ch]); sm += gv[m]; }
        const float mean = wave_sum(sm) * (1.0f / 512.0f); float sq = 0.f;
#pragma unroll
        for (int m = 0; m < 8; ++m) { gv[m] -= mean; sq += gv[m] * gv[m]; }
        const float rstd = 1.0f / sqrtf(wave_sum(sq) * (1.0f / 512.0f) + EPS);
#pragma unroll
        for (int m = 0; m < 8; ++m) { const int ch = lane + 64 * m; vn[(size_t)t * 512 + ch] = (bf16)f2bf(gv[m] * rstd * lng[ch] + lnb[ch]); }
    }
}

DI void conv_item(const Ctx& c, int item, const float* glu, const float* cw, const float* cb, const float* lng, const float* lnb, bf16* ycat) {
    const int t0 = item * 32, b = t0 / SEQ, s0 = t0 % SEQ, ch = c.tid;
    LAS float* sc = (LAS float*)c.lds;
    float v[62], w[31];
#pragma unroll
    for (int i = 0; i < 62; ++i) { const int s = s0 + i - 15; v[i] = (s >= 0 && s < SEQ) ? glu[((size_t)b * SEQ + s) * 512 + ch] : 0.f; }
#pragma unroll
    for (int j = 0; j < 31; ++j) w[j] = cw[j * 512 + ch];
    const float bias = cb[ch];
    __syncthreads();
#pragma unroll
    for (int i = 0; i < 32; ++i) { float acc = bias;
#pragma unroll
        for (int j = 0; j < 31; ++j) acc += w[j] * v[i + j];
        sc[i * 512 + ch] = acc; }
    __syncthreads();
#pragma unroll
    for (int q = 0; q < 4; ++q) {
        const int i = c.wave * 4 + q; float x[8]; float sm = 0.f;
#pragma unroll
        for (int m = 0; m < 8; ++m) { x[m] = sc[i * 512 + c.lane + 64 * m]; sm += x[m]; }
        const float mean = wave_sum(sm) * (1.0f / 512.0f); float sq = 0.f;
#pragma unroll
        for (int m = 0; m < 8; ++m) { x[m] -= mean; sq += x[m] * x[m]; }
        const float rstd = 1.0f / sqrtf(wave_sum(sq) * (1.0f / 512.0f) + EPS);
#pragma unroll
        for (int m = 0; m < 8; ++m) { const int cc = c.lane + 64 * m; const float y = x[m] * rstd * lng[cc] + lnb[cc];
            ycat[(size_t)(t0 + i) * D + cc] = (bf16)f2bf(y * sigmoidf_(y)); }
    }
}

template <bool WIN>
DI void attn_item(const Ctx& c, int item, const bf16* qb, const bf16* kb, const bf16* vt, bf16* ycat, int ycol0, const float* sink) {
    const int qblk = item & 63, kvh = (item >> 6) & 1, b = item >> 7;
    const int tid = c.tid, lane = c.lane, l31 = lane & 31, h = lane >> 5;
    const int head = kvh * 4 + (c.wave & 3), q0 = qblk * 64 + (c.wave >> 2) * 32;
    const bf16* qrow = qb + ((size_t)(b * 8 + head) * SEQ + q0 + l31) * 64;
    bf16x8 qf[4];
#pragma unroll
    for (int kk = 0; kk < 4; ++kk) qf[kk] = *(const bf16x8*)(qrow + 16 * kk + 8 * h);
    f32x16 o0, o1;
#pragma unroll
    for (int i = 0; i < 16; ++i) { o0[i] = 0.f; o1[i] = 0.f; }
    float m, l;
    if (WIN) { m = sink[head] * LOG2E; l = (h == 0) ? 1.f : 0.f; } else { m = -1e30f; l = 0.f; }
    const bf16* kbase = kb + (size_t)(b * 2 + kvh) * SEQ * 64;
    const bf16* vbase = vt + (size_t)(b * 2 + kvh) * 64 * SEQ;
    int t_lo = 0, t_hi = 63;
    if (WIN) { t_lo = qblk - 2 < 0 ? 0 : qblk - 2; t_hi = qblk + 2 > 63 ? 63 : qblk + 2; }
    LAS unsigned char* sK = c.lds; LAS unsigned char* sV = c.lds + 64 * 144;
    const int qpos = q0 + l31;
    for (int kt = t_lo; kt <= t_hi; ++kt) {
        const u32x4 rk = *(const u32x4*)(kbase + (size_t)(kt * 64 + (tid >> 3)) * 64 + (tid & 7) * 8);
        const u32x4 rv = *(const u32x4*)(vbase + (size_t)(tid >> 3) * SEQ + kt * 64 + (tid & 7) * 8);
        __syncthreads();
        *(LAS u32x4*)(sK + (tid >> 3) * 144 + (tid & 7) * 16) = rk;
        { u32x2 a; a.x = rv.x; a.y = rv.y; u32x2 bb; bb.x = rv.z; bb.y = rv.w;
          *(LAS u32x2*)(sV + (tid >> 3) * 136 + (tid & 7) * 16) = a; *(LAS u32x2*)(sV + (tid >> 3) * 136 + (tid & 7) * 16 + 8) = bb; }
        __syncthreads();
        f32x16 s0, s1;
#pragma unroll
        for (int i = 0; i < 16; ++i) { s0[i] = 0.f; s1[i] = 0.f; }
#pragma unroll
        for (int kk = 0; kk < 4; ++kk) {
            const bf16x8 k0 = *(const LAS bf16x8*)(sK + l31 * 144 + (16 * kk + 8 * h) * 2);
            const bf16x8 k1 = *(const LAS bf16x8*)(sK + (32 + l31) * 144 + (16 * kk + 8 * h) * 2);
            s0 = MFMA32(k0, qf[kk], s0); s1 = MFMA32(k1, qf[kk], s1);
        }
        if (WIN) {
#pragma unroll
            for (int r = 0; r < 16; ++r) {
                const int kp0 = kt * 64 + crow(r, h), kp1 = kp0 + 32;
                const int d0 = kp0 - qpos, d1 = kp1 - qpos;
                if (d0 > 128 || d0 < -128) s0[r] = -1e30f;
                if (d1 > 128 || d1 < -128) s1[r] = -1e30f;
            }
        }
        float mx = s0[0];
#pragma unroll
        for (int r = 1; r < 16; ++r) mx = fmaxf(mx, s0[r]);
#pragma unroll
        for (int r = 0; r < 16; ++r) mx = fmaxf(mx, s1[r]);
        mx = fmaxf(mx, __shfl_xor(mx, 32));
        const float mn = fmaxf(m, mx), alpha = __builtin_amdgcn_exp2f(m - mn); m = mn;
        float ls = 0.f;
#pragma unroll
        for (int r = 0; r < 16; ++r) { s0[r] = __builtin_amdgcn_exp2f(s0[r] - mn); s1[r] = __builtin_amdgcn_exp2f(s1[r] - mn); ls += s0[r] + s1[r]; }
        l = l * alpha + ls;
#pragma unroll
        for (int i = 0; i < 16; ++i) { o0[i] *= alpha; o1[i] *= alpha; }
#pragma unroll
        for (int tl = 0; tl < 2; ++tl)
#pragma unroll
            for (int st = 0; st < 2; ++st) {
                u32x4 pp;
                if (tl == 0) { pp.x = pk2(s0[8 * st], s0[8 * st + 1]); pp.y = pk2(s0[8 * st + 2], s0[8 * st + 3]); pp.z = pk2(s0[8 * st + 4], s0[8 * st + 5]); pp.w = pk2(s0[8 * st + 6], s0[8 * st + 7]); }
                else         { pp.x = pk2(s1[8 * st], s1[8 * st + 1]); pp.y = pk2(s1[8 * st + 2], s1[8 * st + 3]); pp.z = pk2(s1[8 * st + 4], s1[8 * st + 5]); pp.w = pk2(s1[8 * st + 6], s1[8 * st + 7]); }
                const bf16x8 pf = __builtin_bit_cast(bf16x8, pp);
                const int koff = (tl * 32 + 16 * st + 4 * h) * 2;
                {
                    const u32x2 lo = *(const LAS u32x2*)(sV + l31 * 136 + koff), hi = *(const LAS u32x2*)(sV + l31 * 136 + koff + 16);
                    u32x4 vv; vv.x = lo.x; vv.y = lo.y; vv.z = hi.x; vv.w = hi.y;
                    o0 = MFMA32(__builtin_bit_cast(bf16x8, vv), pf, o0);
                }
                {
                    const u32x2 lo = *(const LAS u32x2*)(sV + (32 + l31) * 136 + koff), hi = *(const LAS u32x2*)(sV + (32 + l31) * 136 + koff + 16);
                    u32x4 vv; vv.x = lo.x; vv.y = lo.y; vv.z = hi.x; vv.w = hi.y;
                    o1 = MFMA32(__builtin_bit_cast(bf16x8, vv), pf, o1);
                }
            }
    }
    const float lt = l + __shfl_xor(l, 32), inv = 1.0f / lt;
    bf16* orow = ycat + (size_t)(b * SEQ + q0 + l31) * D + ycol0 + head * 64;
#pragma unroll
    for (int g = 0; g < 4; ++g) {
        u32x2 w0; w0.x = pk2(o0[4 * g] * inv, o0[4 * g + 1] * inv); w0.y = pk2(o0[4 * g + 2] * inv, o0[4 * g + 3] * inv);
        u32x2 w1; w1.x = pk2(o1[4 * g] * inv, o1[4 * g + 1] * inv); w1.y = pk2(o1[4 * g + 2] * inv, o1[4 * g + 3] * inv);
        *(u32x2*)(orow + 8 * g + 4 * h) = w0; *(u32x2*)(orow + 32 + 8 * g + 4 * h) = w1;
    }
    __syncthreads();
}

DI void sgu_item(const Ctx& c, int item, const float* sw, const float* sb, const bf16* vn, const float* ug, bf16* ycat) {
    const int g = item & 3, n = (item >> 2) & 31, b = item >> 7;
    const int tid = c.tid, lane = c.lane, l31 = lane & 31, h = lane >> 5;
    LAS unsigned char* sW = c.lds; LAS unsigned char* sV = c.lds + 128 * 272;
    const float* wg = sw + (size_t)g * 128 * 128;
    __syncthreads();
#pragma unroll
    for (int i = 0; i < 4; ++i) { const int idx = tid + NT * i, row = idx >> 4, ch = idx & 15;
        const f32x4 a = *(const f32x4*)(wg + row * 128 + ch * 8), bq = *(const f32x4*)(wg + row * 128 + ch * 8 + 4);
        u32x4 o; o.x = pk2(a.x, a.y); o.y = pk2(a.z, a.w); o.z = pk2(bq.x, bq.y); o.w = pk2(bq.z, bq.w);
        *(LAS u32x4*)(sW + row * 272 + ch * 16) = o;
        const u32x4 vv = *(const u32x4*)(vn + ((size_t)b * SEQ + n * 128 + row) * 512 + g * 128 + ch * 8);
        *(LAS u32x4*)(sV + row * 272 + ch * 16) = vv; }
    __syncthreads();
    const int ct = c.wave & 3, pt0 = (c.wave >> 2) * 2;
    f32x16 acc[2];
#pragma unroll
    for (int j = 0; j < 2; ++j)
#pragma unroll
        for (int i = 0; i < 16; ++i) acc[j][i] = 0.f;
#pragma unroll
    for (int kk = 0; kk < 8; ++kk) {
        bf16x8 bfr;
#pragma unroll
        for (int j = 0; j < 8; ++j) bfr[j] = *(const LAS short*)(sV + (16 * kk + 8 * h + j) * 272 + (ct * 32 + l31) * 2);
#pragma unroll
        for (int j = 0; j < 2; ++j) {
            const bf16x8 af = *(const LAS bf16x8*)(sW + ((pt0 + j) * 32 + l31) * 272 + (16 * kk + 8 * h) * 2);
            acc[j] = MFMA32(af, bfr, acc[j]);
        }
    }
#pragma unroll
    for (int j = 0; j < 2; ++j)
#pragma unroll
        for (int r = 0; r < 16; ++r) {
            const int p = (pt0 + j) * 32 + crow(r, h), cc = ct * 32 + l31; const size_t t = (size_t)b * SEQ + n * 128 + p;
            const float mixed = acc[j][r] + sb[g * 128 + p];
            ycat[t * D + 512 + g * 128 + cc] = (bf16)f2bf(ug[t * 512 + g * 128 + cc] * mixed);
        }
}

DI void wave_argmax(float& v, int& i) {
#pragma unroll
    for (int o = 1; o < 64; o <<= 1) { const float ov = __shfl_xor(v, o); const int oi = __shfl_xor(i, o);
        if (ov > v || (ov == v && oi < i)) { v = ov; i = oi; } }
}
DI void phase_topk(const Ctx& c, const float* sc, int* eidx, float* gate) {
    const int gw = c.vcu * NWAVES + c.wave, NGW = c.G * NWAVES, lane = c.lane;
    for (int it = gw; it < T * 8; it += NGW) {
        const int t = it >> 3, hd = it & 7;
        const float* s = sc + (size_t)t * 2048 + hd * 256;
        float sv[2]; int si[2];
#pragma unroll
        for (int p = 0; p < 2; ++p) {
            float v0 = s[p * 128 + lane], v1 = s[p * 128 + 64 + lane]; float rsv = 0.f; int rsi = 0;
            for (int r = 0; r < 16; ++r) {
                float bv; int bi; if (v1 > v0) { bv = v1; bi = lane + 64; } else { bv = v0; bi = lane; }
                wave_argmax(bv, bi);
                if (lane == r) { rsv = bv; rsi = bi; }
                if (bi == lane) v0 = -3.0e38f; if (bi == lane + 64) v1 = -3.0e38f;
            }
            sv[p] = rsv; si[p] = rsi;
        }
        float cv[4];
#pragma unroll
        for (int m = 0; m < 4; ++m) cv[m] = __shfl(sv[0], (lane >> 4) + 4 * m) + __shfl(sv[1], lane & 15);
        float fv = 0.f; int fi = 0;
        for (int r = 0; r < 16; ++r) {
            float bv = cv[0]; int bi = lane;
#pragma unroll
            for (int m = 1; m < 4; ++m) if (cv[m] > bv) { bv = cv[m]; bi = lane + 64 * m; }
            wave_argmax(bv, bi);
            if (lane == r) { fv = bv; fi = bi; }
#pragma unroll
            for (int m = 0; m < 4; ++m) if (bi == lane + 64 * m) cv[m] = -3.0e38f;
        }
        const int i1 = __shfl(si[0], fi >> 4), i2 = __shfl(si[1], fi & 15);
        const float mx = __shfl(fv, 0);
        const float e = (lane < 16) ? __expf(fv - mx) : 0.f;
        const float sum = wave_sum(e);
        if (lane < 16) { eidx[(size_t)t * 128 + hd * 16 + lane] = i1 * 128 + i2; gate[(size_t)t * 128 + hd * 16 + lane] = e / sum; }
    }
}

DI unsigned fkey(float f, unsigned code, unsigned mask) { const unsigned b = __float_as_uint(f); const unsigned s = b ^ ((unsigned)((int)b >> 31) | 0x80000000u); return (s & ~mask) | code; }
DI float keyval(unsigned k, unsigned mask, unsigned mid) { const unsigned s = (k & ~mask) | mid; const unsigned b = (s & 0x80000000u) ? (s ^ 0x80000000u) : ~s; return __uint_as_float(b); }
#define CE_DESC(x, y) do { const unsigned mx_ = (x) > (y) ? (x) : (y), mn_ = (x) > (y) ? (y) : (x); (x) = mx_; (y) = mn_; } while (0)
DI void sort16_desc(unsigned (&a)[16]) {
#pragma unroll
    for (int k = 2; k <= 16; k <<= 1)
#pragma unroll
        for (int j = k >> 1; j > 0; j >>= 1)
#pragma unroll
            for (int i = 0; i < 16; ++i) { const int l = i ^ j; if (l > i) { if ((i & k) == 0 || k == 16) CE_DESC(a[i], a[l]); else CE_DESC(a[l], a[i]); } }
}
DI void merge16_desc(unsigned (&a)[16], const unsigned (&b)[16]) {
#pragma unroll
    for (int i = 0; i < 16; ++i) a[i] = a[i] > b[15 - i] ? a[i] : b[15 - i];
#pragma unroll
    for (int j = 8; j > 0; j >>= 1)
#pragma unroll
        for (int i = 0; i < 16; ++i) { const int l = i ^ j; if (l > i) CE_DESC(a[i], a[l]); }
}
DI void pair_merge16(unsigned (&a)[16]) {
    unsigned lo[16], hi[16];
#pragma unroll
    for (int i = 0; i < 16; ++i) { const auto r = __builtin_amdgcn_permlane32_swap(a[i], a[i], false, false); lo[i] = r[0]; hi[i] = r[1]; }
    merge16_desc(lo, hi);
#pragma unroll
    for (int i = 0; i < 16; ++i) a[i] = lo[i];
}
struct CandTab { int ci[64], cj[64]; constexpr CandTab() : ci(), cj() { int n = 0; for (int i = 0; i < 16; ++i) for (int j = 0; j < 16; ++j) if ((i + 1) * (j + 1) <= 16) { ci[n] = i; cj[n] = j; ++n; } for (; n < 64; ++n) { ci[n] = -1; cj[n] = -1; } } };
constexpr CandTab CAND{};
DI unsigned pick_byte(unsigned w0, unsigned w1, unsigned w2, unsigned w3, unsigned i) {
    const unsigned w = (i & 8u) ? ((i & 4u) ? w3 : w2) : ((i & 4u) ? w1 : w0);
    return (w >> ((i & 3u) * 8u)) & 0xFFu;
}
DI void route_item(const Ctx& c, int item, const bf16* qp, const bf16* sk, int* eidx, float* gate) {
    const int hd = item & 7, tb = item >> 3;
    const int tid = c.tid, lane = c.lane, l31 = lane & 31, h = lane >> 5;
    LAS unsigned char* sS = c.lds;
    __syncthreads();
#pragma unroll
    for (int i = 0; i < 4; ++i) { const int idx = tid + NT * i, row = idx >> 3, ch = idx & 7;
        *(LAS u32x4*)(sS + row * 144 + ch * 16) = *(const u32x4*)(sk + (size_t)hd * 2 * 128 * 64 + (size_t)row * 64 + ch * 8); }
    const int t = tb * 256 + c.wave * 32 + l31;
    const bf16* qrow = qp + (size_t)t * D + hd * 128;
    bf16x8 qf[8];
#pragma unroll
    for (int kk = 0; kk < 8; ++kk) qf[kk] = *(const bf16x8*)(qrow + 16 * kk + 8 * h);
    __syncthreads();
    unsigned sv[2][16];
#pragma unroll
    for (int p = 0; p < 2; ++p) {
        unsigned top[16];
#pragma unroll
        for (int tl = 0; tl < 4; ++tl) {
            f32x16 acc;
#pragma unroll
            for (int i = 0; i < 16; ++i) acc[i] = 0.f;
#pragma unroll
            for (int kk = 0; kk < 4; ++kk) {
                const bf16x8 af = *(const LAS bf16x8*)(sS + (p * 128 + tl * 32 + l31) * 144 + (16 * kk + 8 * h) * 2);
                acc = MFMA32(af, qf[p * 4 + kk], acc);
            }
            unsigned g[16];
#pragma unroll
            for (int r = 0; r < 16; ++r) g[r] = fkey(acc[r], (unsigned)(127 - (tl * 32 + (r & 3) + 8 * (r >> 2))) - 4u * (unsigned)h, 127u);
            sort16_desc(g);
            if (tl == 0) {
#pragma unroll
                for (int i = 0; i < 16; ++i) top[i] = g[i];
            } else merge16_desc(top, g);
        }
        pair_merge16(top);
#pragma unroll
        for (int i = 0; i < 16; ++i) sv[p][i] = top[i];
    }
    float v0[16], v1[16];
#pragma unroll
    for (int i = 0; i < 16; ++i) { v0[i] = keyval(sv[0][i], 127u, 64u); v1[i] = keyval(sv[1][i], 127u, 64u); }
    unsigned ca[16], cb[16];
#pragma unroll
    for (int m = 0; m < 32; ++m) {
        constexpr int dummy = 0; (void)dummy;
        const int ia = CAND.ci[m], ja = CAND.cj[m], ib = CAND.ci[32 + m], jb = CAND.cj[32 + m];
        const unsigned ka = fkey(v0[ia] + v1[ja], (unsigned)(255 - (ia * 16 + ja)), 255u);
        const int ibc = ib >= 0 ? ib : 0, jbc = jb >= 0 ? jb : 0;
        const unsigned kb2 = (ib >= 0) ? fkey(v0[ibc] + v1[jbc], (unsigned)(255 - (ibc * 16 + jbc)), 255u) : 0u;
        const unsigned kx = h ? kb2 : ka;
        if (m < 16) ca[m] = kx; else cb[m - 16] = kx;
    }
    sort16_desc(ca); sort16_desc(cb); merge16_desc(ca, cb);
    pair_merge16(ca);
    unsigned p0[4], p1[4];
#pragma unroll
    for (int w = 0; w < 4; ++w) { p0[w] = 0u; p1[w] = 0u;
#pragma unroll
        for (int q = 0; q < 4; ++q) { p0[w] |= (127u - (sv[0][4 * w + q] & 127u)) << (8 * q); p1[w] |= (127u - (sv[1][4 * w + q] & 127u)) << (8 * q); } }
    float fv[16]; int ex[16];
#pragma unroll
    for (int r = 0; r < 16; ++r) { const unsigned code = 255u - (ca[r] & 255u); fv[r] = keyval(ca[r], 255u, 128u);
        ex[r] = (int)(pick_byte(p0[0], p0[1], p0[2], p0[3], code >> 4) * 128u + pick_byte(p1[0], p1[1], p1[2], p1[3], code & 15u)); }
    float sum = 0.f; const float mxv = fv[0];
#pragma unroll
    for (int r = 0; r < 16; ++r) { fv[r] = __expf(fv[r] - mxv); sum += fv[r]; }
    const float inv = 1.0f / sum;
    int eo[8]; float go[8];
#pragma unroll
    for (int r = 0; r < 8; ++r) { eo[r] = h ? ex[8 + r] : ex[r]; go[r] = (h ? fv[8 + r] : fv[r]) * inv; }
    int* ep = eidx + (size_t)t * 128 + hd * 16 + 8 * h; float* gp = gate + (size_t)t * 128 + hd * 16 + 8 * h;
    typedef int i32x4 __attribute__((ext_vector_type(4)));
    i32x4 e0, e1; e0.x = eo[0]; e0.y = eo[1]; e0.z = eo[2]; e0.w = eo[3]; e1.x = eo[4]; e1.y = eo[5]; e1.z = eo[6]; e1.w = eo[7];
    f32x4 g0, g1; g0.x = go[0]; g0.y = go[1]; g0.z = go[2]; g0.w = go[3]; g1.x = go[4]; g1.y = go[5]; g1.z = go[6]; g1.w = go[7];
    *(i32x4*)ep = e0; *(i32x4*)(ep + 4) = e1; *(f32x4*)gp = g0; *(f32x4*)(gp + 4) = g1;
}

DI void fp8x16_to_f32(const u32x4 w, float (&f)[16]) {
    typedef float f32x2 __attribute__((ext_vector_type(2)));
    f32x2 t;
    t = __builtin_amdgcn_cvt_pk_f32_fp8((int)w.x, false); f[0] = t.x; f[1] = t.y; t = __builtin_amdgcn_cvt_pk_f32_fp8((int)w.x, true); f[2] = t.x; f[3] = t.y;
    t = __builtin_amdgcn_cvt_pk_f32_fp8((int)w.y, false); f[4] = t.x; f[5] = t.y; t = __builtin_amdgcn_cvt_pk_f32_fp8((int)w.y, true); f[6] = t.x; f[7] = t.y;
    t = __builtin_amdgcn_cvt_pk_f32_fp8((int)w.z, false); f[8] = t.x; f[9] = t.y; t = __builtin_amdgcn_cvt_pk_f32_fp8((int)w.z, true); f[10] = t.x; f[11] = t.y;
    t = __builtin_amdgcn_cvt_pk_f32_fp8((int)w.w, false); f[12] = t.x; f[13] = t.y; t = __builtin_amdgcn_cvt_pk_f32_fp8((int)w.w, true); f[14] = t.x; f[15] = t.y;
}
DI void phase_gather(const Ctx& c, const bf16* hb, const int* eidx, const float* gate, const unsigned char* ub, const unsigned char* vb,
                     const float* uinv, const float* vinv, const float* x, float* xo) {
    const int gw = c.vcu * NWAVES + c.wave, NGW = c.G * NWAVES, lane = c.lane;
    for (int t = gw; t < T; t += NGW) {
        const u32x4 h0 = *((const u32x4*)(hb + (size_t)t * D) + 2 * lane), h1 = *((const u32x4*)(hb + (size_t)t * D) + 2 * lane + 1);
        float hf[16];
        hf[0] = bf_lo(h0.x); hf[1] = bf_hi(h0.x); hf[2] = bf_lo(h0.y); hf[3] = bf_hi(h0.y); hf[4] = bf_lo(h0.z); hf[5] = bf_hi(h0.z); hf[6] = bf_lo(h0.w); hf[7] = bf_hi(h0.w);
        hf[8] = bf_lo(h1.x); hf[9] = bf_hi(h1.x); hf[10] = bf_lo(h1.y); hf[11] = bf_hi(h1.y); hf[12] = bf_lo(h1.z); hf[13] = bf_hi(h1.z); hf[14] = bf_lo(h1.w); hf[15] = bf_hi(h1.w);
        const int e0 = eidx[(size_t)t * 128 + lane], e1 = eidx[(size_t)t * 128 + 64 + lane];
        const float g0 = gate[(size_t)t * 128 + lane] * vinv[e0], g1 = gate[(size_t)t * 128 + 64 + lane] * vinv[e1];
        const float ui0 = uinv[e0], ui1 = uinv[e1];
        float acc[16];
#pragma unroll
        for (int i = 0; i < 16; ++i) acc[i] = 0.f;
        for (int k = 0; k < 128; k += 8) {
            u32x4 uu[8], vv[8]; float gk[8], uk[8];
#pragma unroll
            for (int j = 0; j < 8; ++j) {
                const int kk = k + j; const int e = __shfl(kk < 64 ? e0 : e1, kk & 63); gk[j] = __shfl(kk < 64 ? g0 : g1, kk & 63); uk[j] = __shfl(kk < 64 ? ui0 : ui1, kk & 63);
                uu[j] = *((const u32x4*)(ub + (size_t)e * D) + lane); vv[j] = *((const u32x4*)(vb + (size_t)e * D) + lane);
            }
#pragma unroll
            for (int j = 0; j < 8; ++j) {
                float f[16]; fp8x16_to_f32(uu[j], f);
                float d = 0.f;
#pragma unroll
                for (int i = 0; i < 16; ++i) d += f[i] * hf[i];
                d = wave_sum(d) * uk[j];
                const float w = gelu_tanh(d) * gk[j];
                fp8x16_to_f32(vv[j], f);
#pragma unroll
                for (int i = 0; i < 16; ++i) acc[i] += w * f[i];
            }
        }
        const f32x4* xr = (const f32x4*)(x + (size_t)t * D) + 4 * lane; f32x4* xw = (f32x4*)(xo + (size_t)t * D) + 4 * lane;
#pragma unroll
        for (int q = 0; q < 4; ++q) { f32x4 a = xr[q]; a.x += acc[4 * q]; a.y += acc[4 * q + 1]; a.z += acc[4 * q + 2]; a.w += acc[4 * q + 3]; xw[q] = a; }
    }
}

constexpr int STEPS_PER_LAYER = 9;
constexpr int NPHASES = 1 + DEPTH * STEPS_PER_LAYER + 1;

__global__ void __launch_bounds__(NT, 2) mk_fwd(Args args) {
    extern __shared__ __attribute__((aligned(16))) unsigned char lds_raw[];
    Ctx c0;
    c0.lds = (LAS unsigned char*)lds_raw;
    c0.tid = threadIdx.x; c0.lane = c0.tid & 63; c0.wave = __builtin_amdgcn_readfirstlane(c0.tid >> 6);
    c0.G = gridDim.x; { const int bx = blockIdx.x; c0.vcu = (c0.G % 8 == 0) ? (bx % 8) * (c0.G / 8) + bx / 8 : bx; }
    volatile LAS unsigned* misc = (volatile LAS unsigned*)(c0.lds + LDS_BYTES - 64);
    if (c0.tid < 16) misc[c0.tid] = 0u;
    if (c0.tid < 25) { const unsigned long long v = (c0.tid < 23) ? (unsigned long long)args.in[c0.tid] : (c0.tid == 23 ? (unsigned long long)args.out : (unsigned long long)args.ws);
        volatile LAS unsigned* p = (volatile LAS unsigned*)(c0.lds + ARGS_OFF) + 2 * c0.tid; p[0] = (unsigned)v; p[1] = (unsigned)(v >> 32); }
    __syncthreads();
    const int ph_lo = args.ph_lo, ph_hi = args.ph_hi;
    XcdBarrier bar; bar.bar = nullptr; bar.x = 0; bar.st = misc;
    const bool multi = (ph_hi - ph_lo) > 1;
    if (multi) bar = xcd_barrier_post((unsigned*)((unsigned char*)inp(c0, 24) + WS_CTL) + 4096, misc);

    for (int pc = 2 * ph_lo; pc < 2 * ph_hi; ++pc) {
        const int ph = pc >> 1, rep = pc & 1;
        const int st_ = (ph == 0) ? 10 : ((ph == NPHASES - 1) ? 11 : (ph - 1) % STEPS_PER_LAYER);
        if (rep && st_ != PROBE_STEP) continue;
        if (pc > 2 * ph_lo) xcd_barrier(bar);
        Ctx c = c0;
        asm volatile("" : "+v"(c.tid), "+v"(c.lane), "+s"(c.wave), "+s"(c.vcu));
        unsigned char* ws = (unsigned char*)inp(c, 24);
        float* xres = (float*)(ws + WS_XRES); bf16* hb = (bf16*)(ws + WS_HB); bf16* ycat = (bf16*)(ws + WS_YCAT);
        float* z = (float*)(ws + WS_Z); bf16* qp = (bf16*)(ws + WS_QP); bf16* qb = (bf16*)(ws + WS_QB); bf16* kb = (bf16*)(ws + WS_KB); bf16* vt = (bf16*)(ws + WS_VT);
        float* glu = (float*)(ws + WS_GLU); bf16* vn = (bf16*)(ws + WS_VN); int* eidx = (int*)(ws + WS_EIDX); float* gate = (float*)(ws + WS_GATE);
        const float* rope = (const float*)(ws + WS_ROPE);
        if (ph == 0) phase_prologue(c, ws);
        else if (ph == NPHASES - 1) phase_final(c, xres, inp(c, 3), (float*)inp(c, 23));
        else {
            const int l = (ph - 1) / STEPS_PER_LAYER, st = (ph - 1) % STEPS_PER_LAYER, i = l >> 1; const bool odd = l & 1;
            switch (st) {
            case 0: phase_norm(c, xres, inp(c, 1) + (size_t)l * D, hb); break;
            case 1: phase_gemm<0>(c, hb, (const bf16*)(ws + WS_WIN) + (size_t)l * NIN * D, NIN, z); break;
            case 2:
                if (!odd) phase_epi_even(c, z, rope, glu, qb, kb, vt);
                else phase_epi_odd(c, z, rope, inp(c, 13) + i * 64, inp(c, 14) + i * 64, inp(c, 15) + i * 512, inp(c, 16) + i * 512, glu, vn, qb, kb, vt);
                break;
            case 3:
                if (!odd) {
                    for (int it = c.vcu; it < 512; it += c.G) attn_item<true>(c, it, qb, kb, vt, ycat, 512, inp(c, 10) + i * 8);
                    for (int it = c.vcu; it < 512; it += c.G) conv_item(c, it, glu, inp(c, 6) + (size_t)i * 31 * 512, inp(c, 7) + i * 512, inp(c, 8) + i * 512, inp(c, 9) + i * 512, ycat);
                } else {
                    for (int it = c.vcu; it < 512; it += c.G) attn_item<false>(c, it, qb, kb, vt, ycat, 0, nullptr);
                    for (int it = c.vcu; it < 512; it += c.G) sgu_item(c, it, inp(c, 17) + (size_t)i * 4 * 128 * 128, inp(c, 18) + i * 512, vn, glu, ycat);
                }
                break;
            case 4: if (rep) phase_gemm<0>(c, ycat, (const bf16*)(ws + WS_WOUT) + (size_t)l * D * D, D, z); else phase_gemm<1>(c, ycat, (const bf16*)(ws + WS_WOUT) + (size_t)l * D * D, D, xres); break;
            case 5: phase_norm(c, xres, inp(c, 2) + (size_t)l * D, hb); break;
            case 6: phase_gemm<2>(c, hb, (const bf16*)(ws + WS_WQ) + (size_t)l * D * D, D, qp); break;
            case 7: for (int it = c.vcu; it < 512; it += c.G) route_item(c, it, qp, (const bf16*)(ws + WS_SK) + (size_t)l * 16 * 128 * 64, eidx, gate); break;
            case 8: phase_gather(c, hb, eidx, gate, ws + WS_UB + (size_t)l * PEER_E * D, ws + WS_VB + (size_t)l * PEER_E * D, (const float*)(ws + WS_SCL) + (size_t)l * PEER_E, (const float*)(ws + WS_SCL) + (size_t)(DEPTH + l) * PEER_E, xres, rep ? z : xres); break;
            }
        }
    }
}
}

extern "C" void kernel_launch(void* const* d_in, const int* in_sizes, int n_in, void* d_out, int out_size, void* d_ws, size_t ws_size, hipStream_t stream) {
    static int grid = 0;
    if (grid == 0) {
        if (n_in != 23 || out_size != T * D || ws_size < WS_END) { fprintf(stderr, "kernel_launch: unexpected shapes n_in %d out %d ws %zu (need %zu)\n", n_in, out_size, ws_size, (size_t)WS_END); grid = -1; return; }
        int dev = 0, cus = 0;
        if (hipGetDevice(&dev) != hipSuccess || hipDeviceGetAttribute(&cus, hipDeviceAttributeMultiprocessorCount, dev) != hipSuccess) { grid = -1; return; }
        if (hipFuncSetAttribute((const void*)mk_fwd, hipFuncAttributeMaxDynamicSharedMemorySize, LDS_BYTES) != hipSuccess) { fprintf(stderr, "kernel_launch: hipFuncSetAttribute failed\n"); grid = -1; return; }
        (void)hipGetLastError();
        grid = cus;
    }
    if (grid < 0) return;
    (void)hipMemsetAsync((char*)d_ws + WS_CTL, 0, 1 * MiB, stream);
    Args a{};
    for (int i = 0; i < 23; ++i) a.in[i] = (const float*)d_in[i];
    a.out = (float*)d_out; a.ws = (unsigned char*)d_ws;
#if MK_ONE_LAUNCH
    a.ph_lo = 0; a.ph_hi = NPHASES;
    hipLaunchKernelGGL(mk_fwd, dim3(grid), dim3(NT), LDS_BYTES, stream, a);
#else
    for (int p = 0; p < NPHASES; ++p) { a.ph_lo = p; a.ph_hi = p + 1; hipLaunchKernelGGL(mk_fwd, dim3(grid), dim3(NT), LDS_BYTES, stream, a); }
#endif
}
```

```cpp
#include <hip/hip_runtime.h>
#include <cstdio>
#include <cstdint>

#ifndef MK_ONE_LAUNCH
#define MK_ONE_LAUNCH 1
#endif
#ifndef PROBE_STEP
#define PROBE_STEP -1
#endif

namespace {
constexpr int D = 1024, BATCH = 4, SEQ = 4096, T = BATCH * SEQ, DEPTH = 4;
constexpr int NIN = 1792, HD = 64, NQH = 8, NKVH = 2;
constexpr int PEER_E = 16384;
constexpr float EPS = 1e-6f;
constexpr float LOG2E = 1.4426950408889634f;
constexpr int NWAVES = 8, NT = NWAVES * 64;

constexpr size_t MiB = 1u << 20;
constexpr size_t WS_CTL = 0;
constexpr size_t WS_XRES = 1 * MiB;
constexpr size_t WS_HB = WS_XRES + 64 * MiB;
constexpr size_t WS_YCAT = WS_HB + 32 * MiB;
constexpr size_t WS_Z = WS_YCAT + 32 * MiB;
constexpr size_t WS_QP = WS_Z + 128 * MiB;
constexpr size_t WS_QB = WS_QP + 32 * MiB;
constexpr size_t WS_KB = WS_QB + 16 * MiB;
constexpr size_t WS_VT = WS_KB + 4 * MiB;
constexpr size_t WS_GLU = WS_VT + 4 * MiB;
constexpr size_t WS_VN = WS_GLU + 32 * MiB;
constexpr size_t WS_EIDX = WS_VN + 16 * MiB;
constexpr size_t WS_GATE = WS_EIDX + 8 * MiB;
constexpr size_t WS_WIN = WS_GATE + 8 * MiB;
constexpr size_t WS_WOUT = WS_WIN + 14 * MiB;
constexpr size_t WS_WQ = WS_WOUT + 8 * MiB;
constexpr size_t WS_SK = WS_WQ + 8 * MiB;
constexpr size_t WS_ROPE = WS_SK + 1 * MiB;
constexpr size_t WS_SCL = WS_ROPE + 2 * MiB;
constexpr size_t WS_WB = WS_SCL + 1 * MiB;
constexpr size_t WS_UB = WS_WB + 8 * MiB;
constexpr size_t WS_VB = WS_UB + 128 * MiB;
constexpr size_t WS_END = WS_VB + 128 * MiB;

constexpr int LDS_BYTES = 147456;

#define LAS __attribute__((address_space(3)))
typedef unsigned short bf16;
typedef short bf16x8 __attribute__((ext_vector_type(8)));
typedef float f32x4 __attribute__((ext_vector_type(4)));
typedef float f32x16 __attribute__((ext_vector_type(16)));
typedef unsigned u32x4 __attribute__((ext_vector_type(4)));
typedef unsigned u32x2 __attribute__((ext_vector_type(2)));
#define DI __device__ __forceinline__
#define MFMA32(a, b, c) __builtin_amdgcn_mfma_f32_32x32x16_bf16((a), (b), (c), 0, 0, 0)

DI unsigned f2bf(float f) { unsigned u = __float_as_uint(f); return (u + 0x7fffu + ((u >> 16) & 1u)) >> 16; }
DI unsigned pk2(float lo, float hi) { return f2bf(lo) | (f2bf(hi) << 16); }
DI float bf_lo(unsigned w) { return __uint_as_float(w << 16); }
DI float bf_hi(unsigned w) { return __uint_as_float(w & 0xffff0000u); }
DI float wave_sum(float v) {
#pragma unroll
    for (int o = 1; o < 64; o <<= 1) v += __shfl_xor(v, o);
    return v;
}
DI float sigmoidf_(float x) { return 1.0f / (1.0f + __expf(-x)); }
DI float gelu_tanh(float x) {
    const float u = 0.7978845608028654f * (x + 0.044715f * x * x * x);
    const float e = __expf(2.0f * u);
    const float th = 1.0f - 2.0f / (e + 1.0f);
    return 0.5f * x * (1.0f + th);
}
DI int crow(int reg, int h) { return (reg & 3) + 8 * (reg >> 2) + 4 * h; }

struct Args {
    const float* in[23];
    float* out;
    unsigned char* ws;
    int ph_lo, ph_hi;
};

struct Ctx {
    LAS unsigned char* lds;
    int tid, lane, wave, vcu, G, vid;
};
constexpr int ARGS_OFF = 147456 - 512;
DI const float* inp(const Ctx& c, int k) {
    volatile LAS unsigned* p = (volatile LAS unsigned*)(c.lds + ARGS_OFF) + 2 * k;
    const unsigned lo = __builtin_amdgcn_readfirstlane(p[0]), hi = __builtin_amdgcn_readfirstlane(p[1]);
    return (const float*)(const float __attribute__((address_space(1)))*)(((unsigned long long)hi << 32) | lo);
}

#define XB_TMO      128
#define XB_XCNT(j)  (256  + 64 * (j))
#define XB_XSUB(j)  (1280 + 64 * (j))
#define XB_XGEN(j)  (2304 + 64 * (j))
#define XB_TOP      3328
#define XB_TOPGEN   3392
#define XCD_BAR_WORDS 3456
#define XB_SPIN_CAP (1u << 22)
DI unsigned xb_ld(unsigned* p) { return __hip_atomic_load(p, __ATOMIC_RELAXED, __HIP_MEMORY_SCOPE_AGENT); }
DI unsigned xb_add(unsigned* p, unsigned v) { return __hip_atomic_fetch_add(p, v, __ATOMIC_RELAXED, __HIP_MEMORY_SCOPE_AGENT); }
DI unsigned xb_xcc_id() { return (unsigned)__builtin_amdgcn_s_getreg((3 << 11) | 20) & 0xFu; }
#define XB_SPIN(cond, bar) do { unsigned _sp = 0; while (cond) { __builtin_amdgcn_s_sleep(1); \
    if ((++_sp & 255u) == 0u) { if (xb_ld(&(bar)[XB_TMO])) break; if (_sp > XB_SPIN_CAP) { atomicAdd(&(bar)[XB_TMO], 1u); break; } } } } while (0)
struct XcdBarrier { unsigned* bar; unsigned x; volatile LAS unsigned* st; };
DI XcdBarrier xcd_barrier_post(unsigned* bar, volatile LAS unsigned* st) {
    XcdBarrier b; b.bar = bar; b.x = xb_xcc_id(); b.st = st;
    if (threadIdx.x == 0) st[2] = xb_add(&bar[XB_XCNT(b.x)], 1u);
    return b;
}
DI void xcd_barrier_complete(unsigned* bar, unsigned x, unsigned& nloc, unsigned& nx) {
    const unsigned G = gridDim.x * gridDim.y * gridDim.z;
    unsigned sum, cnt, mine, sp = 0u;
    for (;;) {
        sum = 0u; cnt = 0u; mine = 0u;
#pragma unroll
        for (unsigned j = 0; j < 16; ++j) { const unsigned c = xb_ld(&bar[XB_XCNT(j)]); sum += c; cnt += (c > 0u) ? 1u : 0u; mine = (j == x) ? c : mine; }
        if (sum == G) break;
        __builtin_amdgcn_s_sleep(1);
        if ((++sp & 255u) == 0u) { if (xb_ld(&bar[XB_TMO])) break; if (sp > XB_SPIN_CAP) { atomicAdd(&bar[XB_TMO], 1u); break; } }
    }
    nloc = mine > 0u ? mine : 1u; nx = cnt > 0u ? cnt : 1u;
}
DI void xcd_barrier(const XcdBarrier& b) {
    asm volatile("s_waitcnt vmcnt(0)" ::: "memory");
    __syncthreads();
    if (threadIdx.x == 0) {
        unsigned* bar = b.bar;
        __builtin_amdgcn_s_waitcnt(0);
        unsigned nloc = b.st[0], nx = b.st[1];
        if (nloc == 0u) { xcd_barrier_complete(bar, b.x, nloc, nx); b.st[0] = nloc; b.st[1] = nx; }
        const unsigned old = xb_add(&bar[XB_XSUB(b.x)], 1u);
        const unsigned gen = old / nloc;
        if (old + 1u == (gen + 1u) * nloc) {
            __builtin_amdgcn_fence(__ATOMIC_RELEASE, "agent");
            asm volatile("s_waitcnt vmcnt(0)" ::: "memory");
            const unsigned og = xb_add(&bar[XB_TOP], 1u);
            const unsigned tg = og / nx;
            if (og + 1u == (tg + 1u) * nx) xb_add(&bar[XB_TOPGEN], 1u);
            else XB_SPIN(xb_ld(&bar[XB_TOPGEN]) == tg, bar);
            __builtin_amdgcn_fence(__ATOMIC_ACQUIRE, "agent");
            xb_add(&bar[XB_XGEN(b.x)], 1u);
            asm volatile("s_waitcnt vmcnt(0)" ::: "memory");
        } else {
            XB_SPIN(xb_ld(&bar[XB_XGEN(b.x)]) == gen, bar);
            __builtin_amdgcn_fence(__ATOMIC_ACQUIRE, "agent");
            asm volatile("s_waitcnt vmcnt(0)" ::: "memory");
        }
    }
    __syncthreads();
}

DI void transpose_item(const float* W, int K, int N, bf16* WT, LAS float* scr, int item, int lane) {
    const int nblk = N / 32, kb = item / nblk, nb = item % nblk, k0 = 64 * kb, n0 = 32 * nb;
#pragma unroll 8
    for (int i = 0; i < 32; ++i) { const int kk = 2 * i + (lane >> 5); scr[kk * 33 + (lane & 31)] = W[(size_t)(k0 + kk) * N + n0 + (lane & 31)]; }
    asm volatile("s_waitcnt lgkmcnt(0)" ::: "memory");
    const int c = lane & 7;
#pragma unroll
    for (int j = 0; j < 4; ++j) { const int n = (lane >> 3) + 8 * j; const LAS float* s = scr + (8 * c) * 33 + n;
        u32x4 o; o.x = pk2(s[0 * 33], s[1 * 33]); o.y = pk2(s[2 * 33], s[3 * 33]); o.z = pk2(s[4 * 33], s[5 * 33]); o.w = pk2(s[6 * 33], s[7 * 33]);
        *(u32x4*)(WT + (size_t)(n0 + n) * K + k0 + 8 * c) = o; }
    asm volatile("s_waitcnt lgkmcnt(0)" ::: "memory");
}
DI void cvt_stream(const float* src, bf16* dst, size_t n8, size_t gtid, size_t gthreads) {
    for (size_t i = gtid; i < n8; i += gthreads) {
        const f32x4 a = *(const f32x4*)(src + i * 8), b = *(const f32x4*)(src + i * 8 + 4);
        u32x4 o; o.x = pk2(a.x, a.y); o.y = pk2(a.z, a.w); o.z = pk2(b.x, b.y); o.w = pk2(b.z, b.w);
        *(u32x4*)(dst + i * 8) = o;
    }
}

DI void phase_prologue(const Ctx& c, unsigned char* ws) {
    LAS float* scr = (LAS float*)(c.lds + c.wave * 8704);
    const int gw = c.vcu * NWAVES + c.wave, NGW = c.G * NWAVES;
    constexpr int I_IN = (D / 64) * (NIN / 32), I_SQ = (D / 64) * (D / 32), I_L = I_IN + 2 * I_SQ;
    for (int it = gw; it < DEPTH * I_L; it += NGW) {
        const int l = it / I_L; int r = it % I_L; const int i = l >> 1;
        if (r < I_IN) { const float* W = inp(c, (l & 1) ? 11 : 4) + (size_t)i * D * NIN;
            transpose_item(W, D, NIN, (bf16*)(ws + WS_WIN) + (size_t)l * NIN * D, scr, r, c.lane); continue; }
        r -= I_IN;
        if (r < I_SQ) { const float* W = inp(c, (l & 1) ? 12 : 5) + (size_t)i * D * D;
            transpose_item(W, D, D, (bf16*)(ws + WS_WOUT) + (size_t)l * D * D, scr, r, c.lane); continue; }
        r -= I_SQ;
        transpose_item(inp(c, 19) + (size_t)l * D * D, D, D, (bf16*)(ws + WS_WQ) + (size_t)l * D * D, scr, r, c.lane);
    }
    const size_t gtid = (size_t)c.vcu * NT + c.tid, gth = (size_t)c.G * NT;
    cvt_stream(inp(c, 20), (bf16*)(ws + WS_SK), (size_t)DEPTH * 16 * 128 * 64 / 8, gtid, gth);
    {
        const float* usrc = inp(c, 21); const float* vsrc = inp(c, 22); float* scl = (float*)(ws + WS_SCL);
        for (int r = gw; r < 2 * DEPTH * PEER_E; r += NGW) {
            const int tab = r >= DEPTH * PEER_E, row = tab ? r - DEPTH * PEER_E : r;
            const f32x4* src = (const f32x4*)((tab ? vsrc : usrc) + (size_t)row * D) + 4 * c.lane;
            f32x4 v[4]; float am = 0.f;
#pragma unroll
            for (int j = 0; j < 4; ++j) { v[j] = src[j]; am = fmaxf(am, fmaxf(fmaxf(fabsf(v[j].x), fabsf(v[j].y)), fmaxf(fabsf(v[j].z), fabsf(v[j].w)))); }
#pragma unroll
            for (int o = 1; o < 64; o <<= 1) am = fmaxf(am, __shfl_xor(am, o));
            float sc = 1.f;
            if (am > 0.f) sc = __uint_as_float(__float_as_uint(448.0f / am) & 0x7F800000u);
            u32x4 o;
            { int p = __builtin_amdgcn_cvt_pk_fp8_f32(v[0].x * sc, v[0].y * sc, 0, false); p = __builtin_amdgcn_cvt_pk_fp8_f32(v[0].z * sc, v[0].w * sc, p, true); o.x = (unsigned)p; }
            { int p = __builtin_amdgcn_cvt_pk_fp8_f32(v[1].x * sc, v[1].y * sc, 0, false); p = __builtin_amdgcn_cvt_pk_fp8_f32(v[1].z * sc, v[1].w * sc, p, true); o.y = (unsigned)p; }
            { int p = __builtin_amdgcn_cvt_pk_fp8_f32(v[2].x * sc, v[2].y * sc, 0, false); p = __builtin_amdgcn_cvt_pk_fp8_f32(v[2].z * sc, v[2].w * sc, p, true); o.z = (unsigned)p; }
            { int p = __builtin_amdgcn_cvt_pk_fp8_f32(v[3].x * sc, v[3].y * sc, 0, false); p = __builtin_amdgcn_cvt_pk_fp8_f32(v[3].z * sc, v[3].w * sc, p, true); o.w = (unsigned)p; }
            *((u32x4*)(ws + (tab ? WS_VB : WS_UB) + (size_t)row * D) + c.lane) = o;
            if (c.lane == 0) scl[r] = 1.0f / sc;
        }
    }
    const f32x4* xin = (const f32x4*)inp(c, 0);
    for (size_t i = gtid; i < (size_t)T * D / 4; i += gth) ((f32x4*)(ws + WS_XRES))[i] = xin[i];
    float* rope = (float*)(ws + WS_ROPE);
    for (size_t i = gtid; i < (size_t)SEQ * 32; i += gth) {
        const int pos = (int)(i >> 5), fi = (int)(i & 31);
        const float inv = (float)exp2(-(double)(2 * fi) / 64.0 * 13.287712379549449);
        const float ang = (float)pos * inv;
        const double rev = (double)ang * 0.15915494309189535; const float fr = (float)(rev - rint(rev));
        rope[i] = __builtin_amdgcn_cosf(fr); rope[(size_t)SEQ * 32 + i] = __builtin_amdgcn_sinf(fr);
    }
    for (size_t i = gtid; i < 64 * 16; i += gth) {
        const int pos = (int)(i >> 4), fi = (int)(i & 15);
        const float inv = (float)exp2(-(double)(2 * fi) / 32.0 * 13.287712379549449);
        const float ang = (float)pos * inv;
        const double rev = (double)ang * 0.15915494309189535; const float fr = (float)(rev - rint(rev));
        rope[(size_t)2 * SEQ * 32 + i] = __builtin_amdgcn_cosf(fr); rope[(size_t)2 * SEQ * 32 + 1024 + i] = __builtin_amdgcn_sinf(fr);
    }
}

DI void phase_norm(const Ctx& c, const float* x, const float* g, bf16* out) {
    const int gw = c.vcu * NWAVES + c.wave, NGW = c.G * NWAVES;
    for (int m = gw; m < T; m += NGW) {
        const f32x4* xr = (const f32x4*)(x + (size_t)m * D) + c.lane;
        f32x4 v[4]; float s = 0.f;
#pragma unroll
        for (int j = 0; j < 4; ++j) { v[j] = xr[64 * j]; s += (v[j].x * v[j].x + v[j].y * v[j].y) + (v[j].z * v[j].z + v[j].w * v[j].w); }
        const float r = 1.0f / sqrtf(wave_sum(s) * (1.0f / D) + EPS);
        u32x2* o8 = (u32x2*)(out + (size_t)m * D) + c.lane;
#pragma unroll
        for (int j = 0; j < 4; ++j) { const f32x4 gg = ((const f32x4*)g)[c.lane + 64 * j];
            u32x2 o; o.x = pk2(v[j].x * r * gg.x, v[j].y * r * gg.y); o.y = pk2(v[j].z * r * gg.z, v[j].w * r * gg.w); o8[64 * j] = o; }
    }
}
DI void phase_final(const Ctx& c, const float* x, const float* g, float* out) {
    const int gw = c.vcu * NWAVES + c.wave, NGW = c.G * NWAVES;
    for (int m = gw; m < T; m += NGW) {
        const f32x4* xr = (const f32x4*)(x + (size_t)m * D) + c.lane;
        f32x4 v[4]; float s = 0.f;
#pragma unroll
        for (int j = 0; j < 4; ++j) { v[j] = xr[64 * j]; s += (v[j].x * v[j].x + v[j].y * v[j].y) + (v[j].z * v[j].z + v[j].w * v[j].w); }
        const float r = 1.0f / sqrtf(wave_sum(s) * (1.0f / D) + EPS);
        f32x4* o = (f32x4*)(out + (size_t)m * D) + c.lane;
#pragma unroll
        for (int j = 0; j < 4; ++j) { const f32x4 gg = ((const f32x4*)g)[c.lane + 64 * j]; o[64 * j] = v[j] * r * gg; }
    }
}

template <int MODE>
DI void gemm_tile(const Ctx& c, const bf16* A, int lda, const bf16* Bt, int ldb, int K, void* Cout, int ldc) {
    LAS unsigned char* sA = c.lds; LAS unsigned char* sB = c.lds + 128 * 144;
    const int tid = c.tid, lane = c.lane, wr = c.wave >> 1, wc = c.wave & 1, l31 = lane & 31, h = lane >> 5;
    f32x16 acc[2];
#pragma unroll
    for (int j = 0; j < 2; ++j)
#pragma unroll
        for (int i = 0; i < 16; ++i) acc[j][i] = 0.f;
    for (int k0 = 0; k0 < K; k0 += 64) {
        u32x4 ra[2], rb[2];
#pragma unroll
        for (int i = 0; i < 2; ++i) { const int idx = tid + NT * i, row = idx >> 3, ch = idx & 7;
            ra[i] = *(const u32x4*)(A + (size_t)row * lda + k0 + ch * 8);
            rb[i] = *(const u32x4*)(Bt + (size_t)row * ldb + k0 + ch * 8); }
        __syncthreads();
#pragma unroll
        for (int i = 0; i < 2; ++i) { const int idx = tid + NT * i, row = idx >> 3, ch = idx & 7;
            *(LAS u32x4*)(sA + row * 144 + ch * 16) = ra[i];
            *(LAS u32x4*)(sB + row * 144 + ch * 16) = rb[i]; }
        __syncthreads();
#pragma unroll
        for (int kk = 0; kk < 4; ++kk) {
            const bf16x8 af = *(const LAS bf16x8*)(sA + (32 * wr + l31) * 144 + (16 * kk + 8 * h) * 2);
#pragma unroll
            for (int j = 0; j < 2; ++j) {
                const bf16x8 bfr = *(const LAS bf16x8*)(sB + (64 * wc + 32 * j + l31) * 144 + (16 * kk + 8 * h) * 2);
                acc[j] = MFMA32(af, bfr, acc[j]);
            }
        }
    }
#pragma unroll
    for (int j = 0; j < 2; ++j)
#pragma unroll
        for (int r = 0; r < 16; ++r) {
            const int row = 32 * wr + crow(r, h), col = 64 * wc + 32 * j + l31;
            if (MODE == 0) ((float*)Cout)[(size_t)row * ldc + col] = acc[j][r];
            else if (MODE == 1) { float* p = (float*)Cout + (size_t)row * ldc + col; *p = *p + acc[j][r]; }
            else ((bf16*)Cout)[(size_t)row * ldc + col] = (bf16)f2bf(acc[j][r]);
        }
}
template <int MODE>
DI void phase_gemm(const Ctx& c, const bf16* A, const bf16* Bt, int N, void* Cout) {
    const int nN = N / 128, ntiles = (T / 128) * nN;
    for (int it = c.vcu; it < ntiles; it += c.G) {
        const int tm = it / nN, tn = it % nN;
        if (MODE == 2) gemm_tile<MODE>(c, A + (size_t)tm * 128 * D, D, Bt + (size_t)tn * 128 * D, D, D, (bf16*)Cout + (size_t)tm * 128 * N + tn * 128, N);
        else gemm_tile<MODE>(c, A + (size_t)tm * 128 * D, D, Bt + (size_t)tn * 128 * D, D, D, (float*)Cout + (size_t)tm * 128 * N + tn * 128, N);
    }
}
DI void phase_scores(const Ctx& c, const bf16* qp, const bf16* sk, float* sc) {
    const int ntiles = (T / 128) * 16;
    for (int it = c.vcu; it < ntiles; it += c.G) {
        const int tm = it >> 4, hp = it & 15;
        gemm_tile<0>(c, qp + (size_t)tm * 128 * D + hp * 64, D, sk + (size_t)hp * 128 * 64, 64, 64, sc + (size_t)tm * 128 * 2048 + hp * 128, 2048);
    }
}

DI void phase_epi_even(const Ctx& c, const float* z, const float* rope, float* glu, bf16* qb, bf16* kb, bf16* vt) {
    const int gw = c.vcu * NWAVES + c.wave, NGW = c.G * NWAVES, lane = c.lane;
    for (int t = gw; t < T; t += NGW) {
        const float* zr = z + (size_t)t * NIN; const int b = t / SEQ, s = t % SEQ;
#pragma unroll
        for (int m = 0; m < 8; ++m) { const int ch = lane + 64 * m; glu[(size_t)t * 512 + ch] = zr[ch] * sigmoidf_(zr[512 + ch]); }
        const float cs = rope[(size_t)s * 32 + (lane & 31)], sn = rope[(size_t)SEQ * 32 + (size_t)s * 32 + (lane & 31)];
#pragma unroll
        for (int hh = 0; hh < 10; ++hh) {
            const float x = zr[1024 + hh * 64 + lane]; const float p = __shfl_xor(x, 32);
            float o = (lane < 32) ? (x * cs - p * sn) : (x * cs + p * sn);
            if (hh < 8) { o *= 0.125f * LOG2E; qb[((size_t)(b * 8 + hh) * SEQ + s) * 64 + lane] = (bf16)f2bf(o); }
            else kb[((size_t)(b * 2 + (hh - 8)) * SEQ + s) * 64 + lane] = (bf16)f2bf(o);
        }
#pragma unroll
        for (int kv = 0; kv < 2; ++kv) vt[((size_t)(b * 2 + kv) * 64 + lane) * SEQ + s] = (bf16)f2bf(zr[1664 + kv * 64 + lane]);
    }
}
DI void phase_epi_odd(const Ctx& c, const float* z, const float* rope, const float* qg, const float* kg, const float* lng, const float* lnb,
                      float* ug, bf16* vn, bf16* qb, bf16* kb, bf16* vt) {
    const int gw = c.vcu * NWAVES + c.wave, NGW = c.G * NWAVES, lane = c.lane;
    const float* axc = rope + (size_t)2 * SEQ * 32; const float* axs = axc + 1024;
    for (int t = gw; t < T; t += NGW) {
        const float* zr = z + (size_t)t * NIN; const int b = t / SEQ, s = t % SEQ;
        const int half = lane >> 5, dd = lane & 31, fi = dd & 15, pos = half ? (s & 63) : (s >> 6);
        const float cs = axc[pos * 16 + fi], sn = axs[pos * 16 + fi];
        const float gq = qg[lane], gk = kg[lane];
#pragma unroll
        for (int hh = 0; hh < 10; ++hh) {
            const float x = zr[hh * 64 + lane];
            const float r = 1.0f / sqrtf(wave_sum(x * x) * (1.0f / 64.0f) + EPS);
            const float xn = x * r * (hh < 8 ? gq : gk);
            const float p = __shfl_xor(xn, 16);
            float o = (dd < 16) ? (xn * cs - p * sn) : (xn * cs + p * sn);
            if (hh < 8) { o *= 0.125f * LOG2E; qb[((size_t)(b * 8 + hh) * SEQ + s) * 64 + lane] = (bf16)f2bf(o); }
            else kb[((size_t)(b * 2 + (hh - 8)) * SEQ + s) * 64 + lane] = (bf16)f2bf(o);
        }
#pragma unroll
        for (int kv = 0; kv < 2; ++kv) vt[((size_t)(b * 2 + kv) * 64 + lane) * SEQ + s] = (bf16)f2bf(zr[640 + kv * 64 + lane]);
        float gv[8]; float sm = 0.f;
#pragma unroll
        for (int m = 0; m < 8; ++m) { const int ch = lane + 64 * m; ug[(size_t)t * 512 + ch] = gelu_tanh(zr[768 + ch]); gv[m] = gelu_tanh(zr[1280 + ch]); sm += gv[m]; }
        const float mean = wave_sum(sm) * (1.0f / 512.0f); float sq = 0.f;
#pragma unroll
        for (int m = 0; m < 8; ++m) { gv[m] -= mean; sq += gv[m] * gv[m]; }
        const float rstd = 1.0f / sqrtf(wave_sum(sq) * (1.0f / 512.0f) + EPS);
#pragma unroll
        for (int m = 0; m < 8; ++m) { const int ch = lane + 64 * m; vn[(size_t)t * 512 + ch] = (bf16)f2bf(gv[m] * rstd * lng[ch] + lnb[ch]); }
    }
}

DI void conv_item(const Ctx& c, int item, const float* glu, const float* cw, const float* cb, const float* lng, const float* lnb, bf16* ycat) {
    const int t0 = item * 32, b = t0 / SEQ, s0 = t0 % SEQ, ch = c.tid;
    LAS float* sc = (LAS float*)c.lds;
    float v[62], w[31];
#pragma unroll
    for (int i = 0; i < 62; ++i) { const int s = s0 + i - 15; v[i] = (s >= 0 && s < SEQ) ? glu[((size_t)b * SEQ + s) * 512 + ch] : 0.f; }
#pragma unroll
    for (int j = 0; j < 31; ++j) w[j] = cw[j * 512 + ch];
    const float bias = cb[ch];
    __syncthreads();
#pragma unroll
    for (int i = 0; i < 32; ++i) { float acc = bias;
#pragma unroll
        for (int j = 0; j < 31; ++j) acc += w[j] * v[i + j];
        sc[i * 512 + ch] = acc; }
    __syncthreads();
#pragma unroll
    for (int q = 0; q < 4; ++q) {
        const int i = c.wave * 4 + q; float x[8]; float sm = 0.f;
#pragma unroll
        for (int m = 0; m < 8; ++m) { x[m] = sc[i * 512 + c.lane + 64 * m]; sm += x[m]; }
        const float mean = wave_sum(sm) * (1.0f / 512.0f); float sq = 0.f;
#pragma unroll
        for (int m = 0; m < 8; ++m) { x[m] -= mean; sq += x[m] * x[m]; }
        const float rstd = 1.0f / sqrtf(wave_sum(sq) * (1.0f / 512.0f) + EPS);
#pragma unroll
        for (int m = 0; m < 8; ++m) { const int cc = c.lane + 64 * m; const float y = x[m] * rstd * lng[cc] + lnb[cc];
            ycat[(size_t)(t0 + i) * D + cc] = (bf16)f2bf(y * sigmoidf_(y)); }
    }
}

template <bool WIN>
DI void attn_item(const Ctx& c, int item, const bf16* qb, const bf16* kb, const bf16* vt, bf16* ycat, int ycol0, const float* sink) {
    const int qblk = item & 63, kvh = (item >> 6) & 1, b = item >> 7;
    const int tid = c.tid, lane = c.lane, l31 = lane & 31, h = lane >> 5;
    const int head = kvh * 4 + (c.wave & 3), q0 = qblk * 64 + (c.wave >> 2) * 32;
    const bf16* qrow = qb + ((size_t)(b * 8 + head) * SEQ + q0 + l31) * 64;
    bf16x8 qf[4];
#pragma unroll
    for (int kk = 0; kk < 4; ++kk) qf[kk] = *(const bf16x8*)(qrow + 16 * kk + 8 * h);
    f32x16 o0, o1;
#pragma unroll
    for (int i = 0; i < 16; ++i) { o0[i] = 0.f; o1[i] = 0.f; }
    float m, l;
    if (WIN) { m = sink[head] * LOG2E; l = (h == 0) ? 1.f : 0.f; } else { m = -1e30f; l = 0.f; }
    const bf16* kbase = kb + (size_t)(b * 2 + kvh) * SEQ * 64;
    const bf16* vbase = vt + (size_t)(b * 2 + kvh) * 64 * SEQ;
    int t_lo = 0, t_hi = 63;
    if (WIN) { t_lo = qblk - 2 < 0 ? 0 : qblk - 2; t_hi = qblk + 2 > 63 ? 63 : qblk + 2; }
    LAS unsigned char* sK = c.lds; LAS unsigned char* sV = c.lds + 64 * 144;
    const int qpos = q0 + l31;
    for (int kt = t_lo; kt <= t_hi; ++kt) {
        const u32x4 rk = *(const u32x4*)(kbase + (size_t)(kt * 64 + (tid >> 3)) * 64 + (tid & 7) * 8);
        const u32x4 rv = *(const u32x4*)(vbase + (size_t)(tid >> 3) * SEQ + kt * 64 + (tid & 7) * 8);
        __syncthreads();
        *(LAS u32x4*)(sK + (tid >> 3) * 144 + (tid & 7) * 16) = rk;
        { u32x2 a; a.x = rv.x; a.y = rv.y; u32x2 bb; bb.x = rv.z; bb.y = rv.w;
          *(LAS u32x2*)(sV + (tid >> 3) * 136 + (tid & 7) * 16) = a; *(LAS u32x2*)(sV + (tid >> 3) * 136 + (tid & 7) * 16 + 8) = bb; }
        __syncthreads();
        f32x16 s0, s1;
#pragma unroll
        for (int i = 0; i < 16; ++i) { s0[i] = 0.f; s1[i] = 0.f; }
#pragma unroll
        for (int kk = 0; kk < 4; ++kk) {
            const bf16x8 k0 = *(const LAS bf16x8*)(sK + l31 * 144 + (16 * kk + 8 * h) * 2);
            const bf16x8 k1 = *(const LAS bf16x8*)(sK + (32 + l31) * 144 + (16 * kk + 8 * h) * 2);
            s0 = MFMA32(k0, qf[kk], s0); s1 = MFMA32(k1, qf[kk], s1);
        }
        if (WIN) {
#pragma unroll
            for (int r = 0; r < 16; ++r) {
                const int kp0 = kt * 64 + crow(r, h), kp1 = kp0 + 32;
                const int d0 = kp0 - qpos, d1 = kp1 - qpos;
                if (d0 > 128 || d0 < -128) s0[r] = -1e30f;
                if (d1 > 128 || d1 < -128) s1[r] = -1e30f;
            }
        }
        float mx = s0[0];
#pragma unroll
        for (int r = 1; r < 16; ++r) mx = fmaxf(mx, s0[r]);
#pragma unroll
        for (int r = 0; r < 16; ++r) mx = fmaxf(mx, s1[r]);
        mx = fmaxf(mx, __shfl_xor(mx, 32));
        const float mn = fmaxf(m, mx), alpha = __builtin_amdgcn_exp2f(m - mn); m = mn;
        float ls = 0.f;
#pragma unroll
        for (int r = 0; r < 16; ++r) { s0[r] = __builtin_amdgcn_exp2f(s0[r] - mn); s1[r] = __builtin_amdgcn_exp2f(s1[r] - mn); ls += s0[r] + s1[r]; }
        l = l * alpha + ls;
#pragma unroll
        for (int i = 0; i < 16; ++i) { o0[i] *= alpha; o1[i] *= alpha; }
#pragma unroll
        for (int tl = 0; tl < 2; ++tl)
#pragma unroll
            for (int st = 0; st < 2; ++st) {
                u32x4 pp;
                if (tl == 0) { pp.x = pk2(s0[8 * st], s0[8 * st + 1]); pp.y = pk2(s0[8 * st + 2], s0[8 * st + 3]); pp.z = pk2(s0[8 * st + 4], s0[8 * st + 5]); pp.w = pk2(s0[8 * st + 6], s0[8 * st + 7]); }
                else         { pp.x = pk2(s1[8 * st], s1[8 * st + 1]); pp.y = pk2(s1[8 * st + 2], s1[8 * st + 3]); pp.z = pk2(s1[8 * st + 4], s1[8 * st + 5]); pp.w = pk2(s1[8 * st + 6], s1[8 * st + 7]); }
                const bf16x8 pf = __builtin_bit_cast(bf16x8, pp);
                const int koff = (tl * 32 + 16 * st + 4 * h) * 2;
                {
                    const u32x2 lo = *(const LAS u32x2*)(sV + l31 * 136 + koff), hi = *(const LAS u32x2*)(sV + l31 * 136 + koff + 16);
                    u32x4 vv; vv.x = lo.x; vv.y = lo.y; vv.z = hi.x; vv.w = hi.y;
                    o0 = MFMA32(__builtin_bit_cast(bf16x8, vv), pf, o0);
                }
                {
                    const u32x2 lo = *(const LAS u32x2*)(sV + (32 + l31) * 136 + koff), hi = *(const LAS u32x2*)(sV + (32 + l31) * 136 + koff + 16);
                    u32x4 vv; vv.x = lo.x; vv.y = lo.y; vv.z = hi.x; vv.w = hi.y;
                    o1 = MFMA32(__builtin_bit_cast(bf16x8, vv), pf, o1);
                }
            }
    }
    const float lt = l + __shfl_xor(l, 32), inv = 1.0f / lt;
    bf16* orow = ycat + (size_t)(b * SEQ + q0 + l31) * D + ycol0 + head * 64;
#pragma unroll
    for (int g = 0; g < 4; ++g) {
        u32x2 w0; w0.x = pk2(o0[4 * g] * inv, o0[4 * g + 1] * inv); w0.y = pk2(o0[4 * g + 2] * inv, o0[4 * g + 3] * inv);
        u32x2 w1; w1.x = pk2(o1[4 * g] * inv, o1[4 * g + 1] * inv); w1.y = pk2(o1[4 * g + 2] * inv, o1[4 * g + 3] * inv);
        *(u32x2*)(orow + 8 * g + 4 * h) = w0; *(u32x2*)(orow + 32 + 8 * g + 4 * h) = w1;
    }
    __syncthreads();
}

DI void sgu_item(const Ctx& c, int item, const float* sw, const float* sb, const bf16* vn, const float* ug, bf16* ycat) {
    const int g = item & 3, n = (item >> 2) & 31, b = item >> 7;
    const int tid = c.tid, lane = c.lane, l31 = lane & 31, h = lane >> 5;
    LAS unsigned char* sW = c.lds; LAS unsigned char* sV = c.lds + 128 * 272;
    const float* wg = sw + (size_t)g * 128 * 128;
    __syncthreads();
#pragma unroll
    for (int i = 0; i < 4; ++i) { const int idx = tid + NT * i, row = idx >> 4, ch = idx & 15;
        const f32x4 a = *(const f32x4*)(wg + row * 128 + ch * 8), bq = *(const f32x4*)(wg + row * 128 + ch * 8 + 4);
        u32x4 o; o.x = pk2(a.x, a.y); o.y = pk2(a.z, a.w); o.z = pk2(bq.x, bq.y); o.w = pk2(bq.z, bq.w);
        *(LAS u32x4*)(sW + row * 272 + ch * 16) = o;
        const u32x4 vv = *(const u32x4*)(vn + ((size_t)b * SEQ + n * 128 + row) * 512 + g * 128 + ch * 8);
        *(LAS u32x4*)(sV + row * 272 + ch * 16) = vv; }
    __syncthreads();
    const int ct = c.wave & 3, pt0 = (c.wave >> 2) * 2;
    f32x16 acc[2];
#pragma unroll
    for (int j = 0; j < 2; ++j)
#pragma unroll
        for (int i = 0; i < 16; ++i) acc[j][i] = 0.f;
#pragma unroll
    for (int kk = 0; kk < 8; ++kk) {
        bf16x8 bfr;
#pragma unroll
        for (int j = 0; j < 8; ++j) bfr[j] = *(const LAS short*)(sV + (16 * kk + 8 * h + j) * 272 + (ct * 32 + l31) * 2);
#pragma unroll
        for (int j = 0; j < 2; ++j) {
            const bf16x8 af = *(const LAS bf16x8*)(sW + ((pt0 + j) * 32 + l31) * 272 + (16 * kk + 8 * h) * 2);
            acc[j] = MFMA32(af, bfr, acc[j]);
        }
    }
#pragma unroll
    for (int j = 0; j < 2; ++j)
#pragma unroll
        for (int r = 0; r < 16; ++r) {
            const int p = (pt0 + j) * 32 + crow(r, h), cc = ct * 32 + l31; const size_t t = (size_t)b * SEQ + n * 128 + p;
            const float mixed = acc[j][r] + sb[g * 128 + p];
            ycat[t * D + 512 + g * 128 + cc] = (bf16)f2bf(ug[t * 512 + g * 128 + cc] * mixed);
        }
}

DI void wave_argmax(float& v, int& i) {
#pragma unroll
    for (int o = 1; o < 64; o <<= 1) { const float ov = __shfl_xor(v, o); const int oi = __shfl_xor(i, o);
        if (ov > v || (ov == v && oi < i)) { v = ov; i = oi; } }
}
DI void phase_topk(const Ctx& c, const float* sc, int* eidx, float* gate) {
    const int gw = c.vcu * NWAVES + c.wave, NGW = c.G * NWAVES, lane = c.lane;
    for (int it = gw; it < T * 8; it += NGW) {
        const int t = it >> 3, hd = it & 7;
        const float* s = sc + (size_t)t * 2048 + hd * 256;
        float sv[2]; int si[2];
#pragma unroll
        for (int p = 0; p < 2; ++p) {
            float v0 = s[p * 128 + lane], v1 = s[p * 128 + 64 + lane]; float rsv = 0.f; int rsi = 0;
            for (int r = 0; r < 16; ++r) {
                float bv; int bi; if (v1 > v0) { bv = v1; bi = lane + 64; } else { bv = v0; bi = lane; }
                wave_argmax(bv, bi);
                if (lane == r) { rsv = bv; rsi = bi; }
                if (bi == lane) v0 = -3.0e38f; if (bi == lane + 64) v1 = -3.0e38f;
            }
            sv[p] = rsv; si[p] = rsi;
        }
        float cv[4];
#pragma unroll
        for (int m = 0; m < 4; ++m) cv[m] = __shfl(sv[0], (lane >> 4) + 4 * m) + __shfl(sv[1], lane & 15);
        float fv = 0.f; int fi = 0;
        for (int r = 0; r < 16; ++r) {
            float bv = cv[0]; int bi = lane;
#pragma unroll
            for (int m = 1; m < 4; ++m) if (cv[m] > bv) { bv = cv[m]; bi = lane + 64 * m; }
            wave_argmax(bv, bi);
            if (lane == r) { fv = bv; fi = bi; }
#pragma unroll
            for (int m = 0; m < 4; ++m) if (bi == lane + 64 * m) cv[m] = -3.0e38f;
        }
        const int i1 = __shfl(si[0], fi >> 4), i2 = __shfl(si[1], fi & 15);
        const float mx = __shfl(fv, 0);
        const float e = (lane < 16) ? __expf(fv - mx) : 0.f;
        const float sum = wave_sum(e);
        if (lane < 16) { eidx[(size_t)t * 128 + hd * 16 + lane] = i1 * 128 + i2; gate[(size_t)t * 128 + hd * 16 + lane] = e / sum; }
    }
}

DI unsigned fkey(float f, unsigned code, unsigned mask) { const unsigned b = __float_as_uint(f); const unsigned s = b ^ ((unsigned)((int)b >> 31) | 0x80000000u); return (s & ~mask) | code; }
DI float keyval(unsigned k, unsigned mask, unsigned mid) { const unsigned s = (k & ~mask) | mid; const unsigned b = (s & 0x80000000u) ? (s ^ 0x80000000u) : ~s; return __uint_as_float(b); }
#define CE_DESC(x, y) do { const unsigned mx_ = (x) > (y) ? (x) : (y), mn_ = (x) > (y) ? (y) : (x); (x) = mx_; (y) = mn_; } while (0)
DI void sort16_desc(unsigned (&a)[16]) {
#pragma unroll
    for (int k = 2; k <= 16; k <<= 1)
#pragma unroll
        for (int j = k >> 1; j > 0; j >>= 1)
#pragma unroll
            for (int i = 0; i < 16; ++i) { const int l = i ^ j; if (l > i) { if ((i & k) == 0 || k == 16) CE_DESC(a[i], a[l]); else CE_DESC(a[l], a[i]); } }
}
DI void merge16_desc(unsigned (&a)[16], const unsigned (&b)[16]) {
#pragma unroll
    for (int i = 0; i < 16; ++i) a[i] = a[i] > b[15 - i] ? a[i] : b[15 - i];
#pragma unroll
    for (int j = 8; j > 0; j >>= 1)
#pragma unroll
        for (int i = 0; i < 16; ++i) { const int l = i ^ j; if (l > i) CE_DESC(a[i], a[l]); }
}
DI void pair_merge16(unsigned (&a)[16]) {
    unsigned lo[16], hi[16];
#pragma unroll
    for (int i = 0; i < 16; ++i) { const auto r = __builtin_amdgcn_permlane32_swap(a[i], a[i], false, false); lo[i] = r[0]; hi[i] = r[1]; }
    merge16_desc(lo, hi);
#pragma unroll
    for (int i = 0; i < 16; ++i) a[i] = lo[i];
}
struct CandTab { int ci[64], cj[64]; constexpr CandTab() : ci(), cj() { int n = 0; for (int i = 0; i < 16; ++i) for (int j = 0; j < 16; ++j) if ((i + 1) * (j + 1) <= 16) { ci[n] = i; cj[n] = j; ++n; } for (; n < 64; ++n) { ci[n] = -1; cj[n] = -1; } } };
constexpr CandTab CAND{};
DI unsigned pick_byte(unsigned w0, unsigned w1, unsigned w2, unsigned w3, unsigned i) {
    const unsigned w = (i & 8u) ? ((i & 4u) ? w3 : w2) : ((i & 4u) ? w1 : w0);
    return (w >> ((i & 3u) * 8u)) & 0xFFu;
}
DI void route_item(const Ctx& c, int item, const bf16* qp, const bf16* sk, int* eidx, float* gate) {
    const int hd = item & 7, tb = item >> 3;
    const int tid = c.tid, lane = c.lane, l31 = lane & 31, h = lane >> 5;
    LAS unsigned char* sS = c.lds;
    __syncthreads();
#pragma unroll
    for (int i = 0; i < 4; ++i) { const int idx = tid + NT * i, row = idx >> 3, ch = idx & 7;
        *(LAS u32x4*)(sS + row * 144 + ch * 16) = *(const u32x4*)(sk + (size_t)hd * 2 * 128 * 64 + (size_t)row * 64 + ch * 8); }
    const int t = tb * 256 + c.wave * 32 + l31;
    const bf16* qrow = qp + (size_t)t * D + hd * 128;
    bf16x8 qf[8];
#pragma unroll
    for (int kk = 0; kk < 8; ++kk) qf[kk] = *(const bf16x8*)(qrow + 16 * kk + 8 * h);
    __syncthreads();
    unsigned sv[2][16];
#pragma unroll
    for (int p = 0; p < 2; ++p) {
        unsigned top[16];
#pragma unroll
        for (int tl = 0; tl < 4; ++tl) {
            f32x16 acc;
#pragma unroll
            for (int i = 0; i < 16; ++i) acc[i] = 0.f;
#pragma unroll
            for (int kk = 0; kk < 4; ++kk) {
                const bf16x8 af = *(const LAS bf16x8*)(sS + (p * 128 + tl * 32 + l31) * 144 + (16 * kk + 8 * h) * 2);
                acc = MFMA32(af, qf[p * 4 + kk], acc);
            }
            unsigned g[16];
#pragma unroll
            for (int r = 0; r < 16; ++r) g[r] = fkey(acc[r], (unsigned)(127 - (tl * 32 + (r & 3) + 8 * (r >> 2))) - 4u * (unsigned)h, 127u);
            sort16_desc(g);
            if (tl == 0) {
#pragma unroll
                for (int i = 0; i < 16; ++i) top[i] = g[i];
            } else merge16_desc(top, g);
        }
        pair_merge16(top);
#pragma unroll
        for (int i = 0; i < 16; ++i) sv[p][i] = top[i];
    }
    float v0[16], v1[16];
#pragma unroll
    for (int i = 0; i < 16; ++i) { v0[i] = keyval(sv[0][i], 127u, 64u); v1[i] = keyval(sv[1][i], 127u, 64u); }
    unsigned ca[16], cb[16];
#pragma unroll
    for (int m = 0; m < 32; ++m) {
        constexpr int dummy = 0; (void)dummy;
        const int ia = CAND.ci[m], ja = CAND.cj[m], ib = CAND.ci[32 + m], jb = CAND.cj[32 + m];
        const unsigned ka = fkey(v0[ia] + v1[ja], (unsigned)(255 - (ia * 16 + ja)), 255u);
        const int ibc = ib >= 0 ? ib : 0, jbc = jb >= 0 ? jb : 0;
        const unsigned kb2 = (ib >= 0) ? fkey(v0[ibc] + v1[jbc], (unsigned)(255 - (ibc * 16 + jbc)), 255u) : 0u;
        const unsigned kx = h ? kb2 : ka;
        if (m < 16) ca[m] = kx; else cb[m - 16] = kx;
    }
    sort16_desc(ca); sort16_desc(cb); merge16_desc(ca, cb);
    pair_merge16(ca);
    unsigned p0[4], p1[4];
#pragma unroll
    for (int w = 0; w < 4; ++w) { p0[w] = 0u; p1[w] = 0u;
#pragma unroll
        for (int q = 0; q < 4; ++q) { p0[w] |= (127u - (sv[0][4 * w + q] & 127u)) << (8 * q); p1[w] |= (127u - (sv[1][4 * w + q] & 127u)) << (8 * q); } }
    float fv[16]; int ex[16];
#pragma unroll
    for (int r = 0; r < 16; ++r) { const unsigned code = 255u - (ca[r] & 255u); fv[r] = keyval(ca[r], 255u, 128u);
        ex[r] = (int)(pick_byte(p0[0], p0[1], p0[2], p0[3], code >> 4) * 128u + pick_byte(p1[0], p1[1], p1[2], p1[3], code & 15u)); }
    float sum = 0.f; const float mxv = fv[0];
#pragma unroll
    for (int r = 0; r < 16; ++r) { fv[r] = __expf(fv[r] - mxv); sum += fv[r]; }
    const float inv = 1.0f / sum;
    int eo[8]; float go[8];
#pragma unroll
    for (int r = 0; r < 8; ++r) { eo[r] = h ? ex[8 + r] : ex[r]; go[r] = (h ? fv[8 + r] : fv[r]) * inv; }
    int* ep = eidx + (size_t)t * 128 + hd * 16 + 8 * h; float* gp = gate + (size_t)t * 128 + hd * 16 + 8 * h;
    typedef int i32x4 __attribute__((ext_vector_type(4)));
    i32x4 e0, e1; e0.x = eo[0]; e0.y = eo[1]; e0.z = eo[2]; e0.w = eo[3]; e1.x = eo[4]; e1.y = eo[5]; e1.z = eo[6]; e1.w = eo[7];
    f32x4 g0, g1; g0.x = go[0]; g0.y = go[1]; g0.z = go[2]; g0.w = go[3]; g1.x = go[4]; g1.y = go[5]; g1.z = go[6]; g1.w = go[7];
    *(i32x4*)ep = e0; *(i32x4*)(ep + 4) = e1; *(f32x4*)gp = g0; *(f32x4*)(gp + 4) = g1;
}

DI void fp8x16_to_f32(const u32x4 w, float (&f)[16]) {
    typedef float f32x2 __attribute__((ext_vector_type(2)));
    f32x2 t;
    t = __builtin_amdgcn_cvt_pk_f32_fp8((int)w.x, false); f[0] = t.x; f[1] = t.y; t = __builtin_amdgcn_cvt_pk_f32_fp8((int)w.x, true); f[2] = t.x; f[3] = t.y;
    t = __builtin_amdgcn_cvt_pk_f32_fp8((int)w.y, false); f[4] = t.x; f[5] = t.y; t = __builtin_amdgcn_cvt_pk_f32_fp8((int)w.y, true); f[6] = t.x; f[7] = t.y;
    t = __builtin_amdgcn_cvt_pk_f32_fp8((int)w.z, false); f[8] = t.x; f[9] = t.y; t = __builtin_amdgcn_cvt_pk_f32_fp8((int)w.z, true); f[10] = t.x; f[11] = t.y;
    t = __builtin_amdgcn_cvt_pk_f32_fp8((int)w.w, false); f[12] = t.x; f[13] = t.y; t = __builtin_amdgcn_cvt_pk_f32_fp8((int)w.w, true); f[14] = t.x; f[15] = t.y;
}
DI void phase_gather(const Ctx& c, const bf16* hb, const int* eidx, const float* gate, const unsigned char* ub, const unsigned char* vb,
                     const float* uinv, const float* vinv, const float* x, float* xo) {
    const int gw = c.vcu * NWAVES + c.wave, NGW = c.G * NWAVES, lane = c.lane;
    for (int t = gw; t < T; t += NGW) {
        const u32x4 h0 = *((const u32x4*)(hb + (size_t)t * D) + 2 * lane), h1 = *((const u32x4*)(hb + (size_t)t * D) + 2 * lane + 1);
        float hf[16];
        hf[0] = bf_lo(h0.x); hf[1] = bf_hi(h0.x); hf[2] = bf_lo(h0.y); hf[3] = bf_hi(h0.y); hf[4] = bf_lo(h0.z); hf[5] = bf_hi(h0.z); hf[6] = bf_lo(h0.w); hf[7] = bf_hi(h0.w);
        hf[8] = bf_lo(h1.x); hf[9] = bf_hi(h1.x); hf[10] = bf_lo(h1.y); hf[11] = bf_hi(h1.y); hf[12] = bf_lo(h1.z); hf[13] = bf_hi(h1.z); hf[14] = bf_lo(h1.w); hf[15] = bf_hi(h1.w);
        const int e0 = eidx[(size_t)t * 128 + lane], e1 = eidx[(size_t)t * 128 + 64 + lane];
        const float g0 = gate[(size_t)t * 128 + lane] * vinv[e0], g1 = gate[(size_t)t * 128 + 64 + lane] * vinv[e1];
        const float ui0 = uinv[e0], ui1 = uinv[e1];
        float acc[16];
#pragma unroll
        for (int i = 0; i < 16; ++i) acc[i] = 0.f;
        for (int k = 0; k < 128; k += 8) {
            u32x4 uu[8], vv[8]; float gk[8], uk[8];
#pragma unroll
            for (int j = 0; j < 8; ++j) {
                const int kk = k + j; const int e = __shfl(kk < 64 ? e0 : e1, kk & 63); gk[j] = __shfl(kk < 64 ? g0 : g1, kk & 63); uk[j] = __shfl(kk < 64 ? ui0 : ui1, kk & 63);
                uu[j] = *((const u32x4*)(ub + (size_t)e * D) + lane); vv[j] = *((const u32x4*)(vb + (size_t)e * D) + lane);
            }
#pragma unroll
            for (int j = 0; j < 8; ++j) {
                float f[16]; fp8x16_to_f32(uu[j], f);
                float d = 0.f;
#pragma unroll
                for (int i = 0; i < 16; ++i) d += f[i] * hf[i];
                d = wave_sum(d) * uk[j];
                const float w = gelu_tanh(d) * gk[j];
                fp8x16_to_f32(vv[j], f);
#pragma unroll
                for (int i = 0; i < 16; ++i) acc[i] += w * f[i];
            }
        }
        const f32x4* xr = (const f32x4*)(x + (size_t)t * D) + 4 * lane; f32x4* xw = (f32x4*)(xo + (size_t)t * D) + 4 * lane;
#pragma unroll
        for (int q = 0; q < 4; ++q) { f32x4 a = xr[q]; a.x += acc[4 * q]; a.y += acc[4 * q + 1]; a.z += acc[4 * q + 2]; a.w += acc[4 * q + 3]; xw[q] = a; }
    }
}

#define DPP_ADD(v, ctrl) ((v) + __builtin_bit_cast(float, __builtin_amdgcn_update_dpp(0, __builtin_bit_cast(int, (v)), (ctrl), 0xF, 0xF, true)))
DI float swap16_sum(float v) { const auto r = __builtin_amdgcn_permlane16_swap(__float_as_uint(v), __float_as_uint(v), false, false); return __uint_as_float(r[0]) + __uint_as_float(r[1]); }
DI float swap32_sum(float v) { const auto r = __builtin_amdgcn_permlane32_swap(__float_as_uint(v), __float_as_uint(v), false, false); return __uint_as_float(r[0]) + __uint_as_float(r[1]); }
DI float wave_sum_fast(float v) {
    v = DPP_ADD(v, 0xB1); v = DPP_ADD(v, 0x4E); v = DPP_ADD(v, 0x141); v = DPP_ADD(v, 0x140);
    v = swap16_sum(v); v = swap32_sum(v);
    return v;
}
struct GuTok { u32x4 seg[16]; u32x4 h0, h1; };
DI void gu_issue(GuTok& k, int lane, int q, int t, int e0, int e1, const unsigned char* ub, const bf16* hb) {
    const int sub = lane >> 3, ch = lane & 7;
    const u32x4* hp = (const u32x4*)(hb + (size_t)t * D + q * 128 + ch * 16);
    k.h0 = hp[0]; k.h1 = hp[1];
#pragma unroll
    for (int i = 0; i < 16; ++i) { const int src = (8 * i + sub) & 63; const int e = __shfl(i < 8 ? e0 : e1, src);
        k.seg[i] = *(const u32x4*)(ub + (unsigned)(e * D + q * 128 + ch * 16)); }
}
DI void gu_finish(const GuTok& k, int lane, float* pa_t) {
    const int sub = lane >> 3, ch = lane & 7;
    float hf[16];
    hf[0] = bf_lo(k.h0.x); hf[1] = bf_hi(k.h0.x); hf[2] = bf_lo(k.h0.y); hf[3] = bf_hi(k.h0.y); hf[4] = bf_lo(k.h0.z); hf[5] = bf_hi(k.h0.z); hf[6] = bf_lo(k.h0.w); hf[7] = bf_hi(k.h0.w);
    hf[8] = bf_lo(k.h1.x); hf[9] = bf_hi(k.h1.x); hf[10] = bf_lo(k.h1.y); hf[11] = bf_hi(k.h1.y); hf[12] = bf_lo(k.h1.z); hf[13] = bf_hi(k.h1.z); hf[14] = bf_lo(k.h1.w); hf[15] = bf_hi(k.h1.w);
#pragma unroll
    for (int i = 0; i < 16; ++i) { float f[16]; fp8x16_to_f32(k.seg[i], f);
        float d = 0.f;
#pragma unroll
        for (int n = 0; n < 16; ++n) d += f[n] * hf[n];
        d = DPP_ADD(d, 0xB1); d = DPP_ADD(d, 0x4E); d = DPP_ADD(d, 0x141);
        if (ch == 0) pa_t[8 * i + sub] = d; }
}
DI void gu_wave(const Ctx& c, int q, int t_first, int t_step, const bf16* hb, const int* eidx, const unsigned char* ub, float* pa) {
    const int lane = c.lane;
    const int n = (t_first < T) ? (T - t_first + t_step - 1) / t_step : 0;
    if (n == 0) return;
#define GU_ROUTE(tt, E0, E1) do { const int t_ = (tt) < T ? (tt) : t_first; E0 = eidx[(size_t)t_ * 128 + lane]; E1 = eidx[(size_t)t_ * 128 + 64 + lane]; } while (0)
    int ea0, ea1, eb0, eb1;
    GU_ROUTE(t_first, ea0, ea1);
    GU_ROUTE(t_first + t_step, eb0, eb1);
    GuTok A, B;
    gu_issue(A, lane, q, t_first, ea0, ea1, ub, hb);
    int i = 0;
    for (; i + 1 < n; i += 2) {
        const int t = t_first + i * t_step;
        gu_issue(B, lane, q, t + t_step, eb0, eb1, ub, hb);
        GU_ROUTE(t + 2 * t_step, ea0, ea1);
        gu_finish(A, lane, pa + ((size_t)q * T + t) * 128);
        if (i + 2 < n) gu_issue(A, lane, q, t + 2 * t_step, ea0, ea1, ub, hb);
        GU_ROUTE(t + 3 * t_step, eb0, eb1);
        gu_finish(B, lane, pa + ((size_t)q * T + t + t_step) * 128);
    }
    if (i < n) gu_finish(A, lane, pa + ((size_t)q * T + t_first + i * t_step) * 128);
#undef GU_ROUTE
}
DI void phase_w(const Ctx& c, const float* pa, const int* eidx, const float* gate, const float* uinv, const float* vinv, float* wbuf) {
    const int gw = c.vcu * NWAVES + c.wave, NGW = c.G * NWAVES, lane = c.lane;
    for (int t = gw; t < T; t += NGW) {
#pragma unroll
        for (int hh = 0; hh < 2; ++hh) {
            const size_t o = (size_t)t * 128 + 64 * hh + lane;
            float a = 0.f;
#pragma unroll
            for (int q = 0; q < 8; ++q) a += pa[(size_t)q * T * 128 + o];
            const int e = eidx[o];
            wbuf[o] = gelu_tanh(a * uinv[e]) * gate[o] * vinv[e];
        }
    }
}
struct GvTok { u32x4 seg[16]; float w0, w1; };
DI void gv_issue(GvTok& k, int lane, int q, int e0, int e1, float w0, float w1, const unsigned char* vb) {
    const int sub = lane >> 3, ch = lane & 7;
    k.w0 = w0; k.w1 = w1;
#pragma unroll
    for (int i = 0; i < 16; ++i) { const int src = (8 * i + sub) & 63; const int e = __shfl(i < 8 ? e0 : e1, src);
        k.seg[i] = *(const u32x4*)(vb + (unsigned)(e * D + q * 128 + ch * 16)); }
}
DI void gv_finish(const GvTok& k, int lane, int q, int t, const float* x, float* xo) {
    const int sub = lane >> 3, ch = lane & 7;
    f32x4 xin[4];
    if (sub == 0) { const f32x4* xr = (const f32x4*)(x + (size_t)t * D + q * 128 + ch * 16);
#pragma unroll
        for (int p = 0; p < 4; ++p) xin[p] = xr[p]; }
    float acc[16];
#pragma unroll
    for (int n = 0; n < 16; ++n) acc[n] = 0.f;
#pragma unroll
    for (int i = 0; i < 16; ++i) { float f[16]; fp8x16_to_f32(k.seg[i], f);
        const float wk = __shfl(i < 8 ? k.w0 : k.w1, (8 * i + sub) & 63);
#pragma unroll
        for (int n = 0; n < 16; ++n) acc[n] += wk * f[n]; }
#pragma unroll
    for (int n = 0; n < 16; ++n) { float v = DPP_ADD(acc[n], 0x128); v = swap16_sum(v); acc[n] = swap32_sum(v); }
    if (sub == 0) { f32x4* xw = (f32x4*)(xo + (size_t)t * D + q * 128 + ch * 16);
#pragma unroll
        for (int p = 0; p < 4; ++p) { f32x4 a = xin[p]; a.x += acc[4 * p]; a.y += acc[4 * p + 1]; a.z += acc[4 * p + 2]; a.w += acc[4 * p + 3]; xw[p] = a; } }
}
DI void gv_wave(const Ctx& c, int q, int t_first, int t_step, const int* eidx, const float* wbuf, const unsigned char* vb, const float* x, float* xo) {
    const int lane = c.lane;
    const int n = (t_first < T) ? (T - t_first + t_step - 1) / t_step : 0;
    if (n == 0) return;
#define GV_ROUTE(tt, E0, E1, W0, W1) do { const int t_ = (tt) < T ? (tt) : t_first; E0 = eidx[(size_t)t_ * 128 + lane]; E1 = eidx[(size_t)t_ * 128 + 64 + lane]; W0 = wbuf[(size_t)t_ * 128 + lane]; W1 = wbuf[(size_t)t_ * 128 + 64 + lane]; } while (0)
    int ea0, ea1, eb0, eb1; float wa0, wa1, wb0, wb1;
    GV_ROUTE(t_first, ea0, ea1, wa0, wa1);
    GV_ROUTE(t_first + t_step, eb0, eb1, wb0, wb1);
    GvTok A, B;
    gv_issue(A, lane, q, ea0, ea1, wa0, wa1, vb);
    int i = 0;
    for (; i + 1 < n; i += 2) {
        const int t = t_first + i * t_step;
        gv_issue(B, lane, q, eb0, eb1, wb0, wb1, vb);
        GV_ROUTE(t + 2 * t_step, ea0, ea1, wa0, wa1);
        gv_finish(A, lane, q, t, x, xo);
        if (i + 2 < n) gv_issue(A, lane, q, ea0, ea1, wa0, wa1, vb);
        GV_ROUTE(t + 3 * t_step, eb0, eb1, wb0, wb1);
        gv_finish(B, lane, q, t + t_step, x, xo);
    }
    if (i < n) gv_finish(A, lane, q, t_first + i * t_step, x, xo);
#undef GV_ROUTE
}

constexpr int STEPS_PER_LAYER = 11;
constexpr int NPHASES = 1 + DEPTH * STEPS_PER_LAYER + 1;

__global__ void __launch_bounds__(NT, 2) mk_fwd(Args args) {
    extern __shared__ __attribute__((aligned(16))) unsigned char lds_raw[];
    Ctx c0;
    c0.lds = (LAS unsigned char*)lds_raw;
    c0.tid = threadIdx.x; c0.lane = c0.tid & 63; c0.wave = __builtin_amdgcn_readfirstlane(c0.tid >> 6);
    c0.G = gridDim.x; { const int bx = blockIdx.x; c0.vcu = (c0.G % 8 == 0) ? (bx % 8) * (c0.G / 8) + bx / 8 : bx; }
    volatile LAS unsigned* misc = (volatile LAS unsigned*)(c0.lds + LDS_BYTES - 64);
    if (c0.tid < 16) misc[c0.tid] = 0u;
    if (c0.tid < 25) { const unsigned long long v = (c0.tid < 23) ? (unsigned long long)args.in[c0.tid] : (c0.tid == 23 ? (unsigned long long)args.out : (unsigned long long)args.ws);
        volatile LAS unsigned* p = (volatile LAS unsigned*)(c0.lds + ARGS_OFF) + 2 * c0.tid; p[0] = (unsigned)v; p[1] = (unsigned)(v >> 32); }
    __syncthreads();
    const int ph_lo = args.ph_lo, ph_hi = args.ph_hi;
    XcdBarrier bar; bar.bar = nullptr; bar.x = 0; bar.st = misc;
    const bool multi = (ph_hi - ph_lo) > 1;
    bool vid_done = false; c0.vid = c0.vcu;
    if (multi) bar = xcd_barrier_post((unsigned*)((unsigned char*)inp(c0, 24) + WS_CTL) + 4096, misc);

    for (int pc = 2 * ph_lo; pc < 2 * ph_hi; ++pc) {
        const int ph = pc >> 1, rep = pc & 1;
        const int st_ = (ph == 0) ? 20 : ((ph == NPHASES - 1) ? 21 : (ph - 1) % STEPS_PER_LAYER);
        if (rep && st_ != PROBE_STEP) continue;
        if (pc > 2 * ph_lo) {
            xcd_barrier(bar);
            if (!vid_done) {
                if (c0.tid == 0) { unsigned before = 0u;
#pragma unroll
                    for (unsigned j = 0; j < 16; ++j) { const unsigned n = xb_ld(&bar.bar[XB_XCNT(j)]); before += (j < bar.x) ? n : 0u; }
                    misc[3] = before + misc[2]; }
                __syncthreads();
                c0.vid = __builtin_amdgcn_readfirstlane((int)misc[3]); vid_done = true;
            }
        }
        Ctx c = c0;
        asm volatile("" : "+v"(c.tid), "+v"(c.lane), "+s"(c.wave), "+s"(c.vcu), "+s"(c.vid));
        unsigned char* ws = (unsigned char*)inp(c, 24);
        float* xres = (float*)(ws + WS_XRES); bf16* hb = (bf16*)(ws + WS_HB); bf16* ycat = (bf16*)(ws + WS_YCAT);
        float* z = (float*)(ws + WS_Z); bf16* qp = (bf16*)(ws + WS_QP); bf16* qb = (bf16*)(ws + WS_QB); bf16* kb = (bf16*)(ws + WS_KB); bf16* vt = (bf16*)(ws + WS_VT);
        float* glu = (float*)(ws + WS_GLU); bf16* vn = (bf16*)(ws + WS_VN); int* eidx = (int*)(ws + WS_EIDX); float* gate = (float*)(ws + WS_GATE);
        const float* rope = (const float*)(ws + WS_ROPE);
        if (ph == 0) phase_prologue(c, ws);
        else if (ph == NPHASES - 1) phase_final(c, xres, inp(c, 3), (float*)inp(c, 23));
        else {
            const int l = (ph - 1) / STEPS_PER_LAYER, st = (ph - 1) % STEPS_PER_LAYER, i = l >> 1; const bool odd = l & 1;
            switch (st) {
            case 0: phase_norm(c, xres, inp(c, 1) + (size_t)l * D, hb); break;
            case 1: phase_gemm<0>(c, hb, (const bf16*)(ws + WS_WIN) + (size_t)l * NIN * D, NIN, z); break;
            case 2:
                if (!odd) phase_epi_even(c, z, rope, glu, qb, kb, vt);
                else phase_epi_odd(c, z, rope, inp(c, 13) + i * 64, inp(c, 14) + i * 64, inp(c, 15) + i * 512, inp(c, 16) + i * 512, glu, vn, qb, kb, vt);
                break;
            case 3:
                if (!odd) {
                    for (int it = c.vcu; it < 512; it += c.G) attn_item<true>(c, it, qb, kb, vt, ycat, 512, inp(c, 10) + i * 8);
                    for (int it = c.vcu; it < 512; it += c.G) conv_item(c, it, glu, inp(c, 6) + (size_t)i * 31 * 512, inp(c, 7) + i * 512, inp(c, 8) + i * 512, inp(c, 9) + i * 512, ycat);
                } else {
                    for (int it = c.vcu; it < 512; it += c.G) attn_item<false>(c, it, qb, kb, vt, ycat, 0, nullptr);
                    for (int it = c.vcu; it < 512; it += c.G) sgu_item(c, it, inp(c, 17) + (size_t)i * 4 * 128 * 128, inp(c, 18) + i * 512, vn, glu, ycat);
                }
                break;
            case 4: if (rep) phase_gemm<0>(c, ycat, (const bf16*)(ws + WS_WOUT) + (size_t)l * D * D, D, z); else phase_gemm<1>(c, ycat, (const bf16*)(ws + WS_WOUT) + (size_t)l * D * D, D, xres); break;
            case 5: phase_norm(c, xres, inp(c, 2) + (size_t)l * D, hb); break;
            case 6: phase_gemm<2>(c, hb, (const bf16*)(ws + WS_WQ) + (size_t)l * D * D, D, qp); break;
            case 7: for (int it = c.vcu; it < 512; it += c.G) route_item(c, it, qp, (const bf16*)(ws + WS_SK) + (size_t)l * 16 * 128 * 64, eidx, gate); break;
            case 8: { const int nq = c.G >> 3, q = c.vid / nq, rq = c.vid % nq;
                gu_wave(c, q, rq * NWAVES + c.wave, nq * NWAVES, hb, eidx, ws + WS_UB + (size_t)l * PEER_E * D, z); } break;
            case 9: phase_w(c, z, eidx, gate, (const float*)(ws + WS_SCL) + (size_t)l * PEER_E, (const float*)(ws + WS_SCL) + (size_t)(DEPTH + l) * PEER_E, (float*)(ws + WS_WB)); break;
            case 10: { const int nq = c.G >> 3, q = c.vid / nq, rq = c.vid % nq;
                gv_wave(c, q, rq * NWAVES + c.wave, nq * NWAVES, eidx, (const float*)(ws + WS_WB), ws + WS_VB + (size_t)l * PEER_E * D, xres, rep ? (float*)qp : xres); } break;
            }
        }
    }
}
}

extern "C" void kernel_launch(void* const* d_in, const int* in_sizes, int n_in, void* d_out, int out_size, void* d_ws, size_t ws_size, hipStream_t stream) {
    static int grid = 0;
    if (grid == 0) {
        if (n_in != 23 || out_size != T * D || ws_size < WS_END) { fprintf(stderr, "kernel_launch: unexpected shapes n_in %d out %d ws %zu (need %zu)\n", n_in, out_size, ws_size, (size_t)WS_END); grid = -1; return; }
        int dev = 0, cus = 0;
        if (hipGetDevice(&dev) != hipSuccess || hipDeviceGetAttribute(&cus, hipDeviceAttributeMultiprocessorCount, dev) != hipSuccess) { grid = -1; return; }
        if (hipFuncSetAttribute((const void*)mk_fwd, hipFuncAttributeMaxDynamicSharedMemorySize, LDS_BYTES) != hipSuccess) { fprintf(stderr, "kernel_launch: hipFuncSetAttribute failed\n"); grid = -1; return; }
        (void)hipGetLastError();
        grid = (cus / 8) * 8;
    }
    if (grid < 0) return;
    (void)hipMemsetAsync((char*)d_ws + WS_CTL, 0, 1 * MiB, stream);
    Args a{};
    for (int i = 0; i < 23; ++i) a.in[i] = (const float*)d_in[i];
    a.out = (float*)d_out; a.ws = (unsigned char*)d_ws;
#if MK_ONE_LAUNCH
    a.ph_lo = 0; a.ph_hi = NPHASES;
    hipLaunchKernelGGL(mk_fwd, dim3(grid), dim3(NT), LDS_BYTES, stream, a);
#else
    for (int p = 0; p < NPHASES; ++p) { a.ph_lo = p; a.ph_hi = p + 1; hipLaunchKernelGGL(mk_fwd, dim3(grid), dim3(NT), LDS_BYTES, stream, a); }
#endif
}
```

```cpp
#include <hip/hip_runtime.h>
#include <hip/hip_bf16.h>
#include <cmath>
#include <cstdio>
#include <cstdint>

#ifndef MK_ONE_LAUNCH
#define MK_ONE_LAUNCH 1
#endif
#ifndef PROBE_EMASK
#define PROBE_EMASK -1
#endif
#ifndef PROBE_PARITY
#define PROBE_PARITY -1
#endif
#ifndef PROBE_LITE
#define PROBE_LITE 0
#endif
#ifndef PROBE_STEP
#define PROBE_STEP -1
#endif

namespace {
constexpr int D = 1024, BATCH = 4, SEQ = 4096, T = BATCH * SEQ, DEPTH = 4;
constexpr int NIN = 1792, HD = 64, NQH = 8, NKVH = 2;
constexpr int PEER_E = 16384;
constexpr float EPS = 1e-6f;
constexpr float LOG2E = 1.4426950408889634f;
constexpr int NWAVES = 8, NT = NWAVES * 64;

constexpr size_t MiB = 1u << 20;
constexpr size_t WS_CTL = 0;
constexpr size_t WS_XRES = 1 * MiB;
constexpr size_t WS_HB = WS_XRES + 64 * MiB;
constexpr size_t WS_YCAT = WS_HB + 32 * MiB;
constexpr size_t WS_Z = WS_YCAT + 32 * MiB;
constexpr size_t WS_QP = WS_Z + 128 * MiB;
constexpr size_t WS_QB = WS_QP + 32 * MiB;
constexpr size_t WS_KB = WS_QB + 16 * MiB;
constexpr size_t WS_VT = WS_KB + 4 * MiB;
constexpr size_t WS_GLU = WS_VT + 4 * MiB;
constexpr size_t WS_VN = WS_GLU + 32 * MiB;
constexpr size_t WS_EIDX = WS_VN + 16 * MiB;
constexpr size_t WS_GATE = WS_EIDX + 8 * MiB;
constexpr size_t WS_WIN = WS_GATE + 8 * MiB;
constexpr size_t WS_WOUT = WS_WIN + 14 * MiB;
constexpr size_t WS_WQ = WS_WOUT + 8 * MiB;
constexpr size_t WS_SK = WS_WQ + 8 * MiB;
constexpr size_t WS_ROPE = WS_SK + 1 * MiB;
constexpr size_t WS_SCL = WS_ROPE + 2 * MiB;
constexpr size_t WS_X8 = WS_SCL + 1 * MiB;
constexpr size_t WS_SSQ = WS_X8 + 16 * MiB;
constexpr size_t WS_LNP = WS_SSQ + 8 * MiB;
constexpr size_t WS_WB = WS_LNP + 1 * MiB;
constexpr size_t WS_UB = WS_WB + 8 * MiB;
constexpr size_t WS_VB = WS_UB + 128 * MiB;
constexpr size_t WS_END = WS_VB + 128 * MiB;

constexpr int LDS_BYTES = 147456;

#define LAS __attribute__((address_space(3)))
typedef unsigned short bf16;
typedef short bf16x8 __attribute__((ext_vector_type(8)));
typedef float f32x4 __attribute__((ext_vector_type(4)));
typedef float f32x16 __attribute__((ext_vector_type(16)));
typedef unsigned u32x4 __attribute__((ext_vector_type(4)));
typedef unsigned u32x2 __attribute__((ext_vector_type(2)));
#define DI __device__ __forceinline__
#define MFMA32(a, b, c) __builtin_amdgcn_mfma_f32_32x32x16_bf16((a), (b), (c), 0, 0, 0)

typedef float f32x2 __attribute__((ext_vector_type(2)));
typedef __bf16 bf16x2_t __attribute__((ext_vector_type(2)));
DI unsigned f2bf(float f) { return (unsigned)__builtin_bit_cast(unsigned short, (__bf16)f); }
DI unsigned pk2(float lo, float hi) { const f32x2 v = {lo, hi}; return __builtin_bit_cast(unsigned, __builtin_convertvector(v, bf16x2_t)); }
DI float bf_lo(unsigned w) { return __uint_as_float(w << 16); }
DI float bf_hi(unsigned w) { return __uint_as_float(w & 0xffff0000u); }
DI float wave_sum(float v) {
#pragma unroll
    for (int o = 1; o < 64; o <<= 1) v += __shfl_xor(v, o);
    return v;
}
#define DPP_ADD(v, ctrl) ((v) + __builtin_bit_cast(float, __builtin_amdgcn_update_dpp(0, __builtin_bit_cast(int, (v)), (ctrl), 0xF, 0xF, true)))
DI float swap16_sum(float v) { const auto r = __builtin_amdgcn_permlane16_swap(__float_as_uint(v), __float_as_uint(v), false, false); return __uint_as_float(r[0]) + __uint_as_float(r[1]); }
DI float swap32_sum(float v) { const auto r = __builtin_amdgcn_permlane32_swap(__float_as_uint(v), __float_as_uint(v), false, false); return __uint_as_float(r[0]) + __uint_as_float(r[1]); }
DI float wave_sum_fast(float v) {
    v = DPP_ADD(v, 0xB1); v = DPP_ADD(v, 0x4E); v = DPP_ADD(v, 0x141); v = DPP_ADD(v, 0x140);
    v = swap16_sum(v); v = swap32_sum(v);
    return v;
}
DI float xor32f(float v, int lane) { const auto r = __builtin_amdgcn_permlane32_swap(__float_as_uint(v), __float_as_uint(v), false, false); return __uint_as_float((lane & 32) ? r[0] : r[1]); }
DI unsigned pack_i8x4(float a, float b, float c_, float d) {
    unsigned p = __builtin_amdgcn_cvt_pk_u8_f32(__builtin_rintf(a + 128.0f), 0, 0u);
    p = __builtin_amdgcn_cvt_pk_u8_f32(__builtin_rintf(b + 128.0f), 1, p);
    p = __builtin_amdgcn_cvt_pk_u8_f32(__builtin_rintf(c_ + 128.0f), 2, p);
    p = __builtin_amdgcn_cvt_pk_u8_f32(__builtin_rintf(d + 128.0f), 3, p);
    return p ^ 0x80808080u;
}
DI float sigmoidf_(float x) { return 1.0f / (1.0f + __expf(-x)); }
DI float gelu_tanh(float x) {
    const float u = 0.7978845608028654f * (x + 0.044715f * x * x * x);
    const float e = __expf(2.0f * u);
    const float th = 1.0f - 2.0f / (e + 1.0f);
    return 0.5f * x * (1.0f + th);
}
DI int crow(int reg, int h) { return (reg & 3) + 8 * (reg >> 2) + 4 * h; }

struct Args {
    const float* in[23];
    float* out;
    unsigned char* ws;
    int ph_lo, ph_hi;
};

struct Ctx {
    LAS unsigned char* lds;
    int tid, lane, wave, vcu, G, vid;
};
constexpr int ARGS_OFF = 147456 - 512;
DI const float* inp(const Ctx& c, int k) {
    volatile LAS unsigned* p = (volatile LAS unsigned*)(c.lds + ARGS_OFF) + 2 * k;
    const unsigned lo = __builtin_amdgcn_readfirstlane(p[0]), hi = __builtin_amdgcn_readfirstlane(p[1]);
    return (const float*)(const float __attribute__((address_space(1)))*)(((unsigned long long)hi << 32) | lo);
}

#define XB_TMO      128
#define XB_XCNT(j)  (256  + 64 * (j))
#define XB_XSUB(j)  (1280 + 64 * (j))
#define XB_XGEN(j)  (2304 + 64 * (j))
#define XB_TOP      3328
#define XB_TOPGEN   3392
#define XCD_BAR_WORDS 3456
#define XB_SPIN_CAP (1u << 22)
DI unsigned xb_ld(unsigned* p) { return __hip_atomic_load(p, __ATOMIC_RELAXED, __HIP_MEMORY_SCOPE_AGENT); }
DI unsigned xb_add(unsigned* p, unsigned v) { return __hip_atomic_fetch_add(p, v, __ATOMIC_RELAXED, __HIP_MEMORY_SCOPE_AGENT); }
DI unsigned xb_xcc_id() { return (unsigned)__builtin_amdgcn_s_getreg((3 << 11) | 20) & 0xFu; }
#define XB_SPIN(cond, bar) do { unsigned _sp = 0; while (cond) { __builtin_amdgcn_s_sleep(1); \
    if ((++_sp & 255u) == 0u) { if (xb_ld(&(bar)[XB_TMO])) break; if (_sp > XB_SPIN_CAP) { atomicAdd(&(bar)[XB_TMO], 1u); break; } } } } while (0)
struct XcdBarrier { unsigned* bar; unsigned x; volatile LAS unsigned* st; };
DI XcdBarrier xcd_barrier_post(unsigned* bar, volatile LAS unsigned* st) {
    XcdBarrier b; b.bar = bar; b.x = xb_xcc_id(); b.st = st;
    if (threadIdx.x == 0) st[2] = xb_add(&bar[XB_XCNT(b.x)], 1u);
    return b;
}
DI void xcd_barrier_complete(unsigned* bar, unsigned x, unsigned& nloc, unsigned& nx) {
    const unsigned G = gridDim.x * gridDim.y * gridDim.z;
    unsigned sum, cnt, mine, sp = 0u;
    for (;;) {
        sum = 0u; cnt = 0u; mine = 0u;
#pragma unroll
        for (unsigned j = 0; j < 16; ++j) { const unsigned c = xb_ld(&bar[XB_XCNT(j)]); sum += c; cnt += (c > 0u) ? 1u : 0u; mine = (j == x) ? c : mine; }
        if (sum == G) break;
        __builtin_amdgcn_s_sleep(1);
        if ((++sp & 255u) == 0u) { if (xb_ld(&bar[XB_TMO])) break; if (sp > XB_SPIN_CAP) { atomicAdd(&bar[XB_TMO], 1u); break; } }
    }
    nloc = mine > 0u ? mine : 1u; nx = cnt > 0u ? cnt : 1u;
}
DI void xcd_barrier(const XcdBarrier& b) {
    asm volatile("s_waitcnt vmcnt(0)" ::: "memory");
    __syncthreads();
    if (threadIdx.x == 0) {
        unsigned* bar = b.bar;
        __builtin_amdgcn_s_waitcnt(0);
        unsigned nloc = b.st[0], nx = b.st[1];
        if (nloc == 0u) { xcd_barrier_complete(bar, b.x, nloc, nx); b.st[0] = nloc; b.st[1] = nx; }
        const unsigned old = xb_add(&bar[XB_XSUB(b.x)], 1u);
        const unsigned gen = old / nloc;
        if (old + 1u == (gen + 1u) * nloc) {
            __builtin_amdgcn_fence(__ATOMIC_RELEASE, "agent");
            asm volatile("s_waitcnt vmcnt(0)" ::: "memory");
            const unsigned og = xb_add(&bar[XB_TOP], 1u);
            const unsigned tg = og / nx;
            if (og + 1u == (tg + 1u) * nx) xb_add(&bar[XB_TOPGEN], 1u);
            else XB_SPIN(xb_ld(&bar[XB_TOPGEN]) == tg, bar);
            __builtin_amdgcn_fence(__ATOMIC_ACQUIRE, "agent");
            xb_add(&bar[XB_XGEN(b.x)], 1u);
            asm volatile("s_waitcnt vmcnt(0)" ::: "memory");
        } else {
            XB_SPIN(xb_ld(&bar[XB_XGEN(b.x)]) == gen, bar);
            __builtin_amdgcn_fence(__ATOMIC_ACQUIRE, "agent");
            asm volatile("s_waitcnt vmcnt(0)" ::: "memory");
        }
    }
    __syncthreads();
}

DI int blkperm_even(int nb) {
    if (nb < 16) return 8 * (nb >> 2) + (nb & 3);
    if (nb < 32) { const int x = nb - 16; return 8 * (x >> 2) + 4 + (x & 3); }
    if (nb < 48) { const int x = nb - 32, head = x >> 1, half = x & 1; return 8 * (4 + (head >> 2)) + 4 * half + (head & 3); }
    if (nb < 52) { const int x = nb - 48, head = x >> 1, half = x & 1; return 48 + 4 * half + head; }
    { const int x = nb - 52, head = x >> 1, part = x & 1; return 48 + 4 * head + 2 + part; }
}
DI int blkperm_odd(int nb) {
    if (nb < 16) { const int head = nb >> 1, half = nb & 1; return 8 * (head >> 2) + 4 * half + (head & 3); }
    if (nb < 20) { const int x = nb - 16, head = x >> 1, half = x & 1; return 16 + 4 * half + head; }
    if (nb < 24) { const int x = nb - 20, head = x >> 1, part = x & 1; return 16 + 4 * head + 2 + part; }
    return nb;
}
DI void transpose_item(const float* W, int K, int N, bf16* WT, LAS float* scr, int item, int lane, const float* gk, int perm) {
    const int nblk = N / 32, kb = item / nblk, nb = item % nblk, k0 = 64 * kb, n0 = 32 * nb, nd0 = 32 * (perm == 1 ? blkperm_even(nb) : perm == 2 ? blkperm_odd(nb) : nb);
#pragma unroll
    for (int i = 0; i < 8; ++i) { const int kk = 8 * i + (lane >> 3), nn = 4 * (lane & 7);
        const f32x4 w4 = *(const f32x4*)(W + (size_t)(k0 + kk) * N + n0 + nn) * (gk ? gk[k0 + kk] : 1.0f);
        scr[kk * 33 + nn] = w4.x; scr[kk * 33 + nn + 1] = w4.y; scr[kk * 33 + nn + 2] = w4.z; scr[kk * 33 + nn + 3] = w4.w; }
    asm volatile("s_waitcnt lgkmcnt(0)" ::: "memory");
    const int c = lane & 7;
#pragma unroll
    for (int j = 0; j < 4; ++j) { const int n = (lane >> 3) + 8 * j; const LAS float* s = scr + (8 * c) * 33 + n;
        u32x4 o; o.x = pk2(s[0 * 33], s[1 * 33]); o.y = pk2(s[2 * 33], s[3 * 33]); o.z = pk2(s[4 * 33], s[5 * 33]); o.w = pk2(s[6 * 33], s[7 * 33]);
        *(u32x4*)(WT + (size_t)(nd0 + n) * K + k0 + 8 * c) = o; }
    asm volatile("s_waitcnt lgkmcnt(0)" ::: "memory");
}
DI void cvt_stream(const float* src, bf16* dst, size_t n8, size_t gtid, size_t gthreads) {
    for (size_t i = gtid; i < n8; i += gthreads) {
        const f32x4 a = *(const f32x4*)(src + i * 8), b = *(const f32x4*)(src + i * 8 + 4);
        u32x4 o; o.x = pk2(a.x, a.y); o.y = pk2(a.z, a.w); o.z = pk2(b.x, b.y); o.w = pk2(b.z, b.w);
        *(u32x4*)(dst + i * 8) = o;
    }
}

struct TabRow { f32x4 v[4]; };
DI void tabrow_load(TabRow& k, int lane, int lyr, int r, const float* usrc, const float* vsrc) {
    const int tab = r >= PEER_E, er = tab ? r - PEER_E : r;
    const f32x4* src = (const f32x4*)((tab ? vsrc : usrc) + ((size_t)lyr * PEER_E + er) * D) + lane;
#pragma unroll
    for (int j = 0; j < 4; ++j) k.v[j] = __builtin_nontemporal_load(src + 64 * j);
}
DI void tabrow_finish(TabRow& k, int lane, int lyr, int r, const float* fg, unsigned char* ws) {
    const int tab = r >= PEER_E, er = tab ? r - PEER_E : r;
    float am = 0.f;
#pragma unroll
    for (int j = 0; j < 4; ++j) { if (!tab) k.v[j] = k.v[j] * ((const f32x4*)(fg + (size_t)lyr * D))[lane + 64 * j];
        am = fmaxf(am, fmaxf(fmaxf(fabsf(k.v[j].x), fabsf(k.v[j].y)), fmaxf(fabsf(k.v[j].z), fabsf(k.v[j].w)))); }
    am = fmaxf(am, __builtin_bit_cast(float, __builtin_amdgcn_update_dpp(0, __builtin_bit_cast(int, am), 0xB1, 0xF, 0xF, true)));
    am = fmaxf(am, __builtin_bit_cast(float, __builtin_amdgcn_update_dpp(0, __builtin_bit_cast(int, am), 0x4E, 0xF, 0xF, true)));
    am = fmaxf(am, __builtin_bit_cast(float, __builtin_amdgcn_update_dpp(0, __builtin_bit_cast(int, am), 0x141, 0xF, 0xF, true)));
    am = fmaxf(am, __builtin_bit_cast(float, __builtin_amdgcn_update_dpp(0, __builtin_bit_cast(int, am), 0x140, 0xF, 0xF, true)));
    { const auto p = __builtin_amdgcn_permlane16_swap(__float_as_uint(am), __float_as_uint(am), false, false); am = fmaxf(__uint_as_float(p[0]), __uint_as_float(p[1])); }
    { const auto p = __builtin_amdgcn_permlane32_swap(__float_as_uint(am), __float_as_uint(am), false, false); am = fmaxf(__uint_as_float(p[0]), __uint_as_float(p[1])); }
    float sc = 1.f;
    if (am > 0.f) sc = tab ? __uint_as_float(__float_as_uint(448.0f / am) & 0x7F800000u) : 127.0f / am;
    unsigned char* dst = ws + (tab ? WS_VB : WS_UB) + (size_t)lyr * PEER_E * D + (size_t)er * 128 + ((4 * lane) & 127);
#pragma unroll
    for (int j = 0; j < 4; ++j) { int p = __builtin_amdgcn_cvt_pk_fp8_f32(k.v[j].x * sc, k.v[j].y * sc, 0, false); p = __builtin_amdgcn_cvt_pk_fp8_f32(k.v[j].z * sc, k.v[j].w * sc, p, true);
        if (!tab) p = (int)pack_i8x4(k.v[j].x * sc, k.v[j].y * sc, k.v[j].z * sc, k.v[j].w * sc);
        __builtin_nontemporal_store((unsigned)p, (unsigned*)(dst + (size_t)(2 * j + (lane >> 5)) * (PEER_E * 128))); }
    if (lane == 0) ((float*)(ws + WS_SCL))[(size_t)(tab * DEPTH + lyr) * PEER_E + er] = 1.0f / sc;
}
DI void phase_prologue(const Ctx& c, unsigned char* ws) {
    LAS float* scr = (LAS float*)(c.lds + c.wave * 8704);
    const int gw = c.vcu * NWAVES + c.wave, NGW = c.G * NWAVES;
    constexpr int I_IN = (D / 64) * (NIN / 32), I_SQ = (D / 64) * (D / 32), I_L = I_IN + 2 * I_SQ;
    for (int it = gw; it < DEPTH * I_L; it += NGW) {
        const int l = it / I_L; int r = it % I_L; const int i = l >> 1;
        if (r < I_IN) { const float* W = inp(c, (l & 1) ? 11 : 4) + (size_t)i * D * NIN;
            transpose_item(W, D, NIN, (bf16*)(ws + WS_WIN) + (size_t)l * NIN * D, scr, r, c.lane, inp(c, 1) + (size_t)l * D, (l & 1) ? 2 : 1); continue; }
        r -= I_IN;
        if (r < I_SQ) { const float* W = inp(c, (l & 1) ? 12 : 5) + (size_t)i * D * D;
            transpose_item(W, D, D, (bf16*)(ws + WS_WOUT) + (size_t)l * D * D, scr, r, c.lane, nullptr, 0); continue; }
        r -= I_SQ;
        transpose_item(inp(c, 19) + (size_t)l * D * D, D, D, (bf16*)(ws + WS_WQ) + (size_t)l * D * D, scr, r, c.lane, inp(c, 2) + (size_t)l * D, 0);
    }
    const size_t gtid = (size_t)c.vcu * NT + c.tid, gth = (size_t)c.G * NT;
    cvt_stream(inp(c, 20), (bf16*)(ws + WS_SK), (size_t)DEPTH * 16 * 128 * 64 / 8, gtid, gth);
    {
        const float* usrc = inp(c, 21); const float* vsrc = inp(c, 22); const float* fg = inp(c, 2);
        for (int r0 = gw; r0 < 2 * PEER_E; r0 += 4 * NGW) {
            TabRow R[4];
#pragma unroll
            for (int k = 0; k < 4; ++k) tabrow_load(R[k], c.lane, 0, r0 + k * NGW < 2 * PEER_E ? r0 + k * NGW : r0, usrc, vsrc);
#pragma unroll
            for (int k = 0; k < 4; ++k) if (r0 + k * NGW < 2 * PEER_E) tabrow_finish(R[k], c.lane, 0, r0 + k * NGW, fg, ws);
        }
    }
    { const float* xin = inp(c, 0); float* ssq = (float*)(ws + WS_SSQ);
      for (int m = gw; m < T; m += NGW) {
          const f32x4* xr = (const f32x4*)(xin + (size_t)m * D) + c.lane;
          u32x2* o8 = (u32x2*)(ws + WS_HB + (size_t)m * D * 2) + c.lane; float sq = 0.f;
#pragma unroll
          for (int j = 0; j < 4; ++j) { const f32x4 v = xr[64 * j]; sq += (v.x * v.x + v.y * v.y) + (v.z * v.z + v.w * v.w);
              u32x2 o; o.x = pk2(v.x, v.y); o.y = pk2(v.z, v.w); o8[64 * j] = o; }
          sq = wave_sum_fast(sq); if (c.lane < 8) ssq[(size_t)m * 8 + c.lane] = c.lane ? 0.f : sq; } }
    float* rope = (float*)(ws + WS_ROPE);
    for (size_t i = gtid; i < (size_t)SEQ * 32; i += gth) {
        const int pos = (int)(i >> 5), fi = (int)(i & 31);
        const float inv = exp2f(-(float)(2 * fi) * (13.287712379549449f / 64.0f));
        const float ang = (float)pos * inv;
        const float rh = ang * 0.15915493667125702f, re = fmaf(ang, 0.15915493667125702f, -rh) + ang * 6.4206382432985265e-09f;
        const float fr = (rh - rintf(rh)) + re;
        rope[i] = __builtin_amdgcn_cosf(fr); rope[(size_t)SEQ * 32 + i] = __builtin_amdgcn_sinf(fr);
    }
    for (size_t i = gtid; i < 64 * 16; i += gth) {
        const int pos = (int)(i >> 4), fi = (int)(i & 15);
        const float inv = exp2f(-(float)(2 * fi) * (13.287712379549449f / 32.0f));
        const float ang = (float)pos * inv;
        const float rh = ang * 0.15915493667125702f, re = fmaf(ang, 0.15915493667125702f, -rh) + ang * 6.4206382432985265e-09f;
        const float fr = (rh - rintf(rh)) + re;
        rope[(size_t)2 * SEQ * 32 + i] = __builtin_amdgcn_cosf(fr); rope[(size_t)2 * SEQ * 32 + 1024 + i] = __builtin_amdgcn_sinf(fr);
    }
}

DI void phase_final(const Ctx& c, const float* x, const float* g, float* out) {
    const int gw = c.vcu * NWAVES + c.wave, NGW = c.G * NWAVES;
    for (int m = gw; m < T; m += NGW) {
        const f32x4* xr = (const f32x4*)(x + (size_t)m * D) + c.lane;
        f32x4 v[4]; float s = 0.f;
#pragma unroll
        for (int j = 0; j < 4; ++j) { v[j] = xr[64 * j]; s += (v[j].x * v[j].x + v[j].y * v[j].y) + (v[j].z * v[j].z + v[j].w * v[j].w); }
        const float r = 1.0f / sqrtf(wave_sum(s) * (1.0f / D) + EPS);
        f32x4* o = (f32x4*)(out + (size_t)m * D) + c.lane;
#pragma unroll
        for (int j = 0; j < 4; ++j) { const f32x4 gg = ((const f32x4*)g)[c.lane + 64 * j]; o[64 * j] = v[j] * r * gg; }
    }
}

DI float rnorm8(const float* p) { const f32x4 a = ((const f32x4*)p)[0], b = ((const f32x4*)p)[1];
    return 1.0f / sqrtf((((a.x + a.y) + (a.z + a.w)) + ((b.x + b.y) + (b.z + b.w))) * (1.0f / 1024.0f) + EPS); }
DI float rnorm16(const float* p) { float s = 0.f;
#pragma unroll
    for (int j = 0; j < 4; ++j) { const f32x4 a = ((const f32x4*)p)[j]; s += (a.x + a.y) + (a.z + a.w); }
    return 1.0f / sqrtf(s * (1.0f / 1024.0f) + EPS); }
namespace pg8 {
#define PG8_LAS __attribute__((address_space(3)))
typedef unsigned short bf16_t;
typedef short bf16x8 __attribute__((ext_vector_type(8)));
typedef float f32x4 __attribute__((ext_vector_type(4)));
typedef unsigned u32x4 __attribute__((ext_vector_type(4)));
constexpr int BM = 256, BK = 64, HALF = 128, HTB = HALF * BK * 2  , STAGE_BYTES = 8 * HTB, NXCD = 8, WGM = 8;

__host__ __device__ __forceinline__ int lds_byte(int r, int c) { const int st = (r >> 4) * 2 + (c >> 5), rr = r & 15, cc = c & 31, ob = rr * 64 + cc * 2; return st * 1024 + (ob ^ (((ob >> 9) & 1) << 5)); }
__host__ __device__ __forceinline__ void stage_rc(int b, int& R, int& C) { const int st = b / 1024, sb = b % 1024, swz = sb ^ (((sb >> 9) & 1) << 5); R = (st >> 1) * 16 + swz / 64; C = (st & 1) * 32 + (swz % 64) / 2; }
__host__ __device__ __forceinline__ int perm32(int rho) { const int n = rho >> 4, i = rho & 15; return 8 * (i >> 2) + 4 * n + (i & 3); }

struct Unit { int pm, pn; };
struct Gemm { const bf16_t* A; const bf16_t* Bt; int M, N, K; };

struct StaticOrder {
    int nM, nN, nwg, G, c;
    __host__ __device__ void init(int M, int N, int G_, int c_) { nM = M / BM; nN = N / BM; nwg = nM * nN; G = G_; c = c_; }
    __host__ __device__ bool next(int i, Unit& u) const {
        const long L = (long)i * G + c; if (L >= nwg) return false;
        int wgid = (int)L; { const int q = nwg / NXCD, r = nwg % NXCD, xcd = wgid % NXCD, off = wgid / NXCD; wgid = (xcd < r ? xcd * (q + 1) : r * (q + 1) + (xcd - r) * q) + off; }
        const int nig = WGM * nN, gid = wgid / nig, fm = gid * WGM, gsz = (nM - fm) < WGM ? (nM - fm) : WGM;
        u.pm = fm + ((wgid % nig) % gsz); u.pn = (wgid % nig) / gsz; return true;
    }
    __device__ __forceinline__ void a_ready(const Unit&) const {}
    __device__ __forceinline__ void done(const Unit&) const {}
};

__device__ __forceinline__ unsigned cvt_pk_bf16(float lo, float hi) { unsigned r; asm volatile("v_cvt_pk_bf16_f32 %0, %1, %2" : "=v"(r) : "v"(lo), "v"(hi)); return r; }
typedef float f32x2 __attribute__((ext_vector_type(2)));
__device__ __forceinline__ f32x2 gelu_pk(f32x2 v) {
    const f32x2 av = __builtin_elementwise_abs(v), d = av * 0.2316418882f + 1.0f;
    f32x2 t; t.x = __builtin_amdgcn_rcpf(d.x); t.y = __builtin_amdgcn_rcpf(d.y);
    f32x2 q = t * 0.5307027145f + (-0.7265760135f); q = q * t + 0.7107068705f; q = q * t + (-0.142248368f); q = q * t + 0.127414796f; q = q * t;
    const f32x2 s = (v * v) * (-0.72134752044f);
    f32x2 e; e.x = __builtin_amdgcn_exp2f(s.x); e.y = __builtin_amdgcn_exp2f(s.y);
    const f32x2 m = v * (q * e), r = v - m;
    f32x2 o; o.x = v.x < 0.f ? m.x : r.x; o.y = v.y < 0.f ? m.y : r.y; return o;
}

template <int ACT  > struct EpiBf16 {
    static constexpr bool PERM = true, AFTER_DRAIN = false; static_assert(ACT == 0 || ACT == 1, "EpiBf16: ACT is 0 (none) or 1 (gelu_pk)");
    bf16_t* O; int ldc; const float* bias; int split_cols; size_t split_stride; float scale0;
    __device__ __forceinline__ void operator()(const f32x4 (&acc)[2][2][4][2], const Unit& u, int wr, int wc, int fr, int fq) const {
        const int row0 = u.pm * BM + wr * 64 + fr; int colt = u.pn * BM; bf16_t* base = O;
        float sc = 1.f; if (split_cols) { const int t = colt / split_cols; base += (size_t)t * split_stride; colt -= t * split_cols; if (t == 0) sc = scale0; }
        const int col0 = colt + wc * 32 + 8 * fq, bcol0 = u.pn * BM + wc * 32 + 8 * fq;
        f32x4 bv[2][2];
#pragma unroll
        for (int bj = 0; bj < 2; ++bj)
#pragma unroll
            for (int n = 0; n < 2; ++n) bv[bj][n] = bias ? *(const f32x4*)(bias + bcol0 + bj * HALF + 4 * n) : (f32x4){0.f, 0.f, 0.f, 0.f};
#pragma unroll
        for (int ai = 0; ai < 2; ++ai)
#pragma unroll
            for (int m = 0; m < 4; ++m) { bf16_t* rowp = base + (size_t)(row0 + ai * HALF + m * 16) * ldc + col0;
#pragma unroll
                for (int bj = 0; bj < 2; ++bj) { f32x4 v0 = acc[ai][bj][m][0] + bv[bj][0], v1 = acc[ai][bj][m][1] + bv[bj][1];
                    if (ACT == 1) { f32x2 a = gelu_pk((f32x2){v0[0], v0[1]}), b = gelu_pk((f32x2){v0[2], v0[3]}), c = gelu_pk((f32x2){v1[0], v1[1]}), d = gelu_pk((f32x2){v1[2], v1[3]});
                        v0 = (f32x4){a.x, a.y, b.x, b.y}; v1 = (f32x4){c.x, c.y, d.x, d.y}; }
                    v0 = v0 * sc; v1 = v1 * sc; u32x4 w; w.x = cvt_pk_bf16(v0[0], v0[1]); w.y = cvt_pk_bf16(v0[2], v0[3]); w.z = cvt_pk_bf16(v1[0], v1[1]); w.w = cvt_pk_bf16(v1[2], v1[3]);
                    *(u32x4*)(rowp + bj * HALF) = w; } }
    }
};

template <class Epi, class Sched, bool ALIGN_EPI = false, bool SP2 = false>
__device__ __forceinline__ void gemm_phase(PG8_LAS unsigned char* lds, const Gemm g, const Sched& S, const Epi& E, const int tid_in) {
    const int tid = tid_in, wid = __builtin_amdgcn_readfirstlane(tid >> 6), lane = tid & 63, wr = wid >> 2, wc = wid & 3, fr = lane & 15, fq = lane >> 4;
    const int K = g.K, nt = K / BK;
    unsigned voffA[2], voffB[2];
#pragma unroll
    for (int i = 0; i < 2; ++i) { int R, C; stage_rc(tid * 16 + i * 8192, R, C); const int Rb = Epi::PERM ? ((R & ~31) + perm32(R & 31)) : R;
        voffA[i] = (unsigned)(R * K + C) * 2u; voffB[i] = (unsigned)(Rb * K + C) * 2u; }
    const size_t kstep = (size_t)(BK * 2);
    const size_t hstep = (size_t)HALF * K * 2;
    const size_t tstep = 2 * hstep;
    const unsigned ldsw = (unsigned)wid * 1024u;
    const int aoff = lds_byte(wr * 64 + fr, fq * 8), boff = lds_byte(wc * 32 + fr, fq * 8);
#define PG8_SA(b, h) (((b) * 2 + (h)) * HTB)
#define PG8_SB(b, h) ((4 + (b) * 2 + (h)) * HTB)
#define PG8_STAGE(bufoff, gbase, voff) do { _Pragma("unroll") for (int _i = 0; _i < 2; ++_i) \
        __builtin_amdgcn_global_load_lds((const unsigned*)((const char*)(gbase) + (voff)[_i]), (PG8_LAS unsigned*)(lds + (bufoff) + ldsw + _i * 8192), 16, 0, 0); } while (0)
#define PG8_LDA(dst, b, h) do { _Pragma("unroll") for (int m = 0; m < 4; ++m) _Pragma("unroll") for (int k = 0; k < 2; ++k) dst[m][k] = *(const PG8_LAS bf16x8*)(lds + PG8_SA(b, h) + aoff + m * 2048 + k * 1024); } while (0)
#define PG8_LDB(dst, b, h) do { _Pragma("unroll") for (int n = 0; n < 2; ++n) _Pragma("unroll") for (int k = 0; k < 2; ++k) dst[n][k] = *(const PG8_LAS bf16x8*)(lds + PG8_SB(b, h) + boff + n * 2048 + k * 1024); } while (0)
#define PG8_MMA(ai, bj, At, Bt) do { __builtin_amdgcn_s_setprio(1); _Pragma("unroll") for (int m = 0; m < 4; ++m) _Pragma("unroll") for (int n = 0; n < 2; ++n) _Pragma("unroll") for (int k = 0; k < 2; ++k) \
        acc[ai][bj][m][n] = __builtin_amdgcn_mfma_f32_16x16x32_bf16(Bt[n][k], At[m][k], acc[ai][bj][m][n], 0, 0, 0); __builtin_amdgcn_s_setprio(0); } while (0)
#define PG8_WAIT_V(n) asm volatile("s_waitcnt vmcnt(" #n ")" ::: "memory")
#define PG8_WAIT_L(n) asm volatile("s_waitcnt lgkmcnt(" #n ")" ::: "memory")
#define PG8_BAR __builtin_amdgcn_s_barrier()
#define PG8_SCHED __builtin_amdgcn_sched_barrier(0)
    Unit cur, nxt; int ui = 0;
    if (!S.next(0, cur)) return;
    f32x4 acc[2][2][4][2];
#pragma unroll
    for (int a = 0; a < 2; ++a)
#pragma unroll
        for (int b = 0; b < 2; ++b)
#pragma unroll
            for (int m = 0; m < 4; ++m)
#pragma unroll
                for (int n = 0; n < 2; ++n) acc[a][b][m][n] = (f32x4){0.f, 0.f, 0.f, 0.f};
    bf16x8 At[4][2], B0[2][2], B1[2][2];
    const char* cA = (const char*)g.A + (size_t)cur.pm * tstep; const char* cB = (const char*)g.Bt + (size_t)cur.pn * tstep;
    S.a_ready(cur);
    if constexpr (SP2) {
        PG8_STAGE(PG8_SB(0, 0), cB, voffB); PG8_STAGE(PG8_SB(0, 1), cB + hstep, voffB); PG8_STAGE(PG8_SA(0, 0), cA, voffA); PG8_STAGE(PG8_SA(0, 1), cA + hstep, voffA);
        if (wr == 1) PG8_BAR;
        PG8_WAIT_V(2); PG8_BAR;
        PG8_STAGE(PG8_SB(1, 0), cB + kstep, voffB); PG8_STAGE(PG8_SA(1, 0), cA + kstep, voffA); PG8_STAGE(PG8_SB(1, 1), cB + hstep + kstep, voffB);
        PG8_WAIT_V(6); PG8_BAR;
    } else {
        PG8_STAGE(PG8_SB(0, 0), cB, voffB); PG8_STAGE(PG8_SA(0, 0), cA, voffA); PG8_STAGE(PG8_SB(0, 1), cB + hstep, voffB); PG8_STAGE(PG8_SA(0, 1), cA + hstep, voffA);
        if (wr == 1) PG8_BAR;
        PG8_WAIT_V(4); PG8_BAR;
        PG8_STAGE(PG8_SB(1, 0), cB + kstep, voffB); PG8_STAGE(PG8_SA(1, 0), cA + kstep, voffA); PG8_STAGE(PG8_SB(1, 1), cB + hstep + kstep, voffB);
        PG8_WAIT_V(6); PG8_BAR;
    }
    for (;;) {
        const bool has_next = S.next(ui + 1, nxt);
        const char* nA = has_next ? (const char*)g.A + (size_t)nxt.pm * tstep : cA; const char* nB = has_next ? (const char*)g.Bt + (size_t)nxt.pn * tstep : cB;
        for (int t = 0; t < nt; t += 2) {
            const bool last = (t == nt - 2);
            const char* a1 = cA + (size_t)(t + 1) * kstep;
            const char* a2 = last ? nA : cA + (size_t)(t + 2) * kstep; const char* b2 = last ? nB : cB + (size_t)(t + 2) * kstep;
            const char* a3 = a2 + kstep; const char* b3 = b2 + kstep;
            if (last && has_next) S.a_ready(nxt);
            if constexpr (SP2) {
            PG8_LDB(B0, 0, 0); PG8_LDB(B1, 0, 1); PG8_SCHED; PG8_LDA(At, 0, 0); PG8_STAGE(PG8_SA(1, 1), a1 + hstep, voffA);
            PG8_WAIT_V(8); PG8_WAIT_L(0); PG8_BAR; PG8_MMA(0, 0, At, B0); PG8_MMA(0, 1, At, B1); PG8_BAR; PG8_SCHED;
            PG8_LDA(At, 0, 1); PG8_STAGE(PG8_SB(0, 0), b2, voffB); PG8_STAGE(PG8_SB(0, 1), b2 + hstep, voffB); PG8_STAGE(PG8_SA(0, 0), a2, voffA);
            PG8_WAIT_V(8); PG8_WAIT_L(0); PG8_BAR; PG8_MMA(1, 0, At, B0); PG8_MMA(1, 1, At, B1); PG8_BAR; PG8_SCHED;
            PG8_LDB(B0, 1, 0); PG8_LDB(B1, 1, 1); PG8_SCHED; PG8_LDA(At, 1, 0); PG8_STAGE(PG8_SA(0, 1), a2 + hstep, voffA);
            PG8_WAIT_V(8); PG8_WAIT_L(0); PG8_BAR; PG8_MMA(0, 0, At, B0); PG8_MMA(0, 1, At, B1); PG8_BAR; PG8_SCHED;
            PG8_LDA(At, 1, 1); PG8_STAGE(PG8_SB(1, 0), b3, voffB); PG8_STAGE(PG8_SB(1, 1), b3 + hstep, voffB); PG8_STAGE(PG8_SA(1, 0), a3, voffA);
            PG8_WAIT_V(8); PG8_WAIT_L(0); PG8_BAR; PG8_MMA(1, 0, At, B0); PG8_MMA(1, 1, At, B1); PG8_BAR; PG8_SCHED;
            } else {
            PG8_LDB(B0, 0, 0); PG8_SCHED; PG8_LDA(At, 0, 0); PG8_STAGE(PG8_SA(1, 1), a1 + hstep, voffA);
            PG8_WAIT_L(8); PG8_BAR; PG8_WAIT_L(0); PG8_MMA(0, 0, At, B0); PG8_BAR; PG8_SCHED;
            PG8_LDB(B1, 0, 1); PG8_STAGE(PG8_SB(0, 0), b2, voffB);
            PG8_BAR; PG8_WAIT_L(0); PG8_MMA(0, 1, At, B1); PG8_BAR;
            PG8_LDA(At, 0, 1); PG8_STAGE(PG8_SA(0, 0), a2, voffA);
            PG8_BAR; PG8_WAIT_L(0); PG8_MMA(1, 0, At, B0); PG8_BAR; PG8_SCHED;
            PG8_STAGE(PG8_SB(0, 1), b2 + hstep, voffB);
            PG8_WAIT_V(6); PG8_BAR; PG8_MMA(1, 1, At, B1); PG8_BAR;
            PG8_LDB(B0, 1, 0); PG8_SCHED; PG8_LDA(At, 1, 0); PG8_STAGE(PG8_SA(0, 1), a2 + hstep, voffA);
            PG8_WAIT_L(8); PG8_BAR; PG8_WAIT_L(0); PG8_MMA(0, 0, At, B0); PG8_BAR; PG8_SCHED;
            PG8_LDB(B1, 1, 1); PG8_STAGE(PG8_SB(1, 0), b3, voffB);
            PG8_BAR; PG8_WAIT_L(0); PG8_MMA(0, 1, At, B1); PG8_BAR;
            PG8_LDA(At, 1, 1); PG8_STAGE(PG8_SA(1, 0), a3, voffA);
            PG8_BAR; PG8_WAIT_L(0); PG8_MMA(1, 0, At, B0); PG8_BAR; PG8_SCHED;
            PG8_STAGE(PG8_SB(1, 1), b3 + hstep, voffB);
            PG8_WAIT_V(6); PG8_BAR; PG8_MMA(1, 1, At, B1); PG8_BAR;
            }
        }
        if constexpr (ALIGN_EPI) { if (wr == 0) PG8_BAR; }
        if constexpr (!Epi::AFTER_DRAIN) { E(acc, cur, wr, wc, fr, fq); S.done(cur); }
        if (!has_next) break;
#pragma unroll
        for (int a = 0; a < 2; ++a)
#pragma unroll
            for (int b = 0; b < 2; ++b)
#pragma unroll
                for (int m = 0; m < 4; ++m)
#pragma unroll
                    for (int n = 0; n < 2; ++n) acc[a][b][m][n] = (f32x4){0.f, 0.f, 0.f, 0.f};
        cur = nxt; cA = nA; cB = nB; ++ui;
        if constexpr (ALIGN_EPI) { if (wr == 1) PG8_BAR; }
    }
    PG8_WAIT_V(0);
    if constexpr (!ALIGN_EPI) { if (wr == 0) PG8_BAR; }
    PG8_BAR;
    if constexpr (Epi::AFTER_DRAIN) { E.fused(acc, cur, wr, wc, fr, fq, lds, wid, lane); S.done(cur); }
#undef PG8_SA
#undef PG8_SB
#undef PG8_STAGE
#undef PG8_LDA
#undef PG8_LDB
#undef PG8_MMA
#undef PG8_WAIT_V
#undef PG8_WAIT_L
#undef PG8_BAR
#undef PG8_SCHED
}
}

namespace pg8 {
struct EpiF32 {
    static constexpr bool PERM = true, AFTER_DRAIN = false;
    float* C; int ldc; const float* ssq;
    __device__ __forceinline__ void operator()(const f32x4 (&acc)[2][2][4][2], const Unit& u, int wr, int wc, int fr, int fq) const {
        const int row0 = u.pm * BM + wr * 64 + fr, col0 = u.pn * BM + wc * 32 + 8 * fq;
#pragma unroll
        for (int ai = 0; ai < 2; ++ai)
#pragma unroll
            for (int m = 0; m < 4; ++m) { const int row = row0 + ai * HALF + m * 16; float* rowp = C + (size_t)row * ldc + col0;
                const float r = ssq ? rnorm8(ssq + (size_t)row * 8) : 1.0f;
#pragma unroll
                for (int bj = 0; bj < 2; ++bj) { *(f32x4*)(rowp + bj * HALF) = acc[ai][bj][m][0] * r; *(f32x4*)(rowp + bj * HALF + 4) = acc[ai][bj][m][1] * r; } }
    }
};
struct EpiRes {
    static constexpr bool PERM = true, AFTER_DRAIN = false;
    int ldc; bf16_t* Cb; float* ssq; unsigned char* X8;
    __device__ __forceinline__ void operator()(const f32x4 (&acc)[2][2][4][2], const Unit& u, int wr, int wc, int fr, int fq) const {
        const int row0 = u.pm * BM + wr * 64 + fr, col0 = u.pn * BM + wc * 32 + 8 * fq;
#pragma unroll
        for (int ai = 0; ai < 2; ++ai)
#pragma unroll
            for (int m = 0; m < 4; ++m) { const int row = row0 + ai * HALF + m * 16; bf16_t* rowb = Cb + (size_t)row * ldc + col0; float sq = 0.f;
#pragma unroll
                for (int bj = 0; bj < 2; ++bj) { const u32x4 xi = *(const u32x4*)(rowb + bj * HALF);
                    const f32x4 o0 = (f32x4){__uint_as_float(xi.x << 16), __uint_as_float(xi.x & 0xffff0000u), __uint_as_float(xi.y << 16), __uint_as_float(xi.y & 0xffff0000u)} + acc[ai][bj][m][0],
                                o1 = (f32x4){__uint_as_float(xi.z << 16), __uint_as_float(xi.z & 0xffff0000u), __uint_as_float(xi.w << 16), __uint_as_float(xi.w & 0xffff0000u)} + acc[ai][bj][m][1];
                    sq += (o0[0] * o0[0] + o0[1] * o0[1]) + (o0[2] * o0[2] + o0[3] * o0[3]) + (o1[0] * o1[0] + o1[1] * o1[1]) + (o1[2] * o1[2] + o1[3] * o1[3]);
                    u32x4 w; w.x = cvt_pk_bf16(o0[0], o0[1]); w.y = cvt_pk_bf16(o0[2], o0[3]); w.z = cvt_pk_bf16(o1[0], o1[1]); w.w = cvt_pk_bf16(o1[2], o1[3]); *(u32x4*)(rowb + bj * HALF) = w;
                    typedef unsigned u32x2v __attribute__((ext_vector_type(2)));
                    *(u32x2v*)(X8 + (size_t)row * ldc + col0 + bj * HALF) = (u32x2v){pack_i8x4(o0[0] * 16.0f, o0[1] * 16.0f, o0[2] * 16.0f, o0[3] * 16.0f), pack_i8x4(o1[0] * 16.0f, o1[1] * 16.0f, o1[2] * 16.0f, o1[3] * 16.0f)}; }
                sq = swap16_sum(sq); sq = swap32_sum(sq);
                if (fq == 0) ssq[(size_t)row * 16 + u.pn * 4 + wc] = sq; }
    }
};
struct EpiEven {
    static constexpr bool PERM = true, AFTER_DRAIN = false;
    const float* ssq; const float* rope; float* glu; bf16_t* qb; bf16_t* kb; bf16_t* vb;
    __device__ __forceinline__ void operator()(const f32x4 (&acc)[2][2][4][2], const Unit& u, int wr, int wc, int fr, int fq) const {
        const int row0 = u.pm * BM + wr * 64 + fr, c8 = wc * 32 + 8 * fq;
#pragma unroll
        for (int ai = 0; ai < 2; ++ai)
#pragma unroll
            for (int m = 0; m < 4; ++m) { const int row = row0 + ai * HALF + m * 16, b = row / SEQ, sq = row % SEQ; const float r = rnorm8(ssq + (size_t)row * 8);
                float xa[8], xb[8];
#pragma unroll
                for (int e = 0; e < 4; ++e) { xa[e] = acc[ai][0][m][0][e] * r; xa[4 + e] = acc[ai][0][m][1][e] * r; xb[e] = acc[ai][1][m][0][e] * r; xb[4 + e] = acc[ai][1][m][1][e] * r; }
                if (u.pn < 4) {
                    float* gp = glu + (size_t)row * 512 + u.pn * 128 + c8; f32x4 o0, o1;
#pragma unroll
                    for (int e = 0; e < 4; ++e) { o0[e] = xa[e] * sigmoidf_(xb[e]); o1[e] = xa[4 + e] * sigmoidf_(xb[4 + e]); }
                    *(f32x4*)gp = o0; *(f32x4*)(gp + 4) = o1;
                } else if (u.pn < 6 || wc < 2) {
                    const float* cs = rope + (size_t)sq * 32 + 8 * fq; const float* sn = cs + (size_t)SEQ * 32;
                    const f32x4 c0 = *(const f32x4*)cs, c1 = *(const f32x4*)(cs + 4), s0 = *(const f32x4*)sn, s1 = *(const f32x4*)(sn + 4);
                    const float sc = (u.pn < 6) ? 0.125f * LOG2E : 1.0f; float o1[8], o2[8];
#pragma unroll
                    for (int e = 0; e < 8; ++e) { const float cc = e < 4 ? c0[e & 3] : c1[e & 3], ss = e < 4 ? s0[e & 3] : s1[e & 3]; o1[e] = (xa[e] * cc - xb[e] * ss) * sc; o2[e] = (xb[e] * cc + xa[e] * ss) * sc; }
                    bf16_t* dst = (u.pn < 6) ? qb + ((size_t)(b * 8 + 4 * (u.pn - 4) + wc) * SEQ + sq) * 64 + 8 * fq : kb + ((size_t)(b * 2 + wc) * SEQ + sq) * 64 + 8 * fq;
                    u32x4 w1, w2; w1.x = cvt_pk_bf16(o1[0], o1[1]); w1.y = cvt_pk_bf16(o1[2], o1[3]); w1.z = cvt_pk_bf16(o1[4], o1[5]); w1.w = cvt_pk_bf16(o1[6], o1[7]);
                    w2.x = cvt_pk_bf16(o2[0], o2[1]); w2.y = cvt_pk_bf16(o2[2], o2[3]); w2.z = cvt_pk_bf16(o2[4], o2[5]); w2.w = cvt_pk_bf16(o2[6], o2[7]);
                    *(u32x4*)dst = w1; *(u32x4*)(dst + 32) = w2;
                } else {
                    bf16_t* d0 = vb + ((size_t)(b * 2) * SEQ + sq) * 64 + 32 * (wc - 2) + 8 * fq; bf16_t* d1 = d0 + (size_t)SEQ * 64;
                    u32x4 w1, w2; w1.x = cvt_pk_bf16(xa[0], xa[1]); w1.y = cvt_pk_bf16(xa[2], xa[3]); w1.z = cvt_pk_bf16(xa[4], xa[5]); w1.w = cvt_pk_bf16(xa[6], xa[7]);
                    w2.x = cvt_pk_bf16(xb[0], xb[1]); w2.y = cvt_pk_bf16(xb[2], xb[3]); w2.z = cvt_pk_bf16(xb[4], xb[5]); w2.w = cvt_pk_bf16(xb[6], xb[7]);
                    *(u32x4*)d0 = w1; *(u32x4*)d1 = w2;
                } }
    }
};
struct EpiOdd {
    static constexpr bool PERM = true, AFTER_DRAIN = false;
    const float* ssq; const float* axc; const float* qg; const float* kg; float* ug; bf16_t* vraw; float* lnp; bf16_t* qb; bf16_t* kb; bf16_t* vb; int lane;
    __device__ __forceinline__ void operator()(const f32x4 (&acc)[2][2][4][2], const Unit& u, int wr, int wc, int fr, int fq) const {
        const int row0 = u.pm * BM + wr * 64 + fr, c8 = wc * 32 + 8 * fq; const float* axs = axc + 1024;
#pragma unroll
        for (int ai = 0; ai < 2; ++ai)
#pragma unroll
            for (int m = 0; m < 4; ++m) { const int row = row0 + ai * HALF + m * 16, b = row / SEQ, sq = row % SEQ; const float r = rnorm8(ssq + (size_t)row * 8);
                float xa[8], xb[8];
#pragma unroll
                for (int e = 0; e < 4; ++e) { xa[e] = acc[ai][0][m][0][e] * r; xa[4 + e] = acc[ai][0][m][1][e] * r; xb[e] = acc[ai][1][m][0][e] * r; xb[4 + e] = acc[ai][1][m][1][e] * r; }
                if (u.pn < 2 || (u.pn == 2 && wc < 2)) {
                    const bool isq = u.pn < 2; const float* g = isq ? qg : kg;
                    float ss = 0.f;
#pragma unroll
                    for (int e = 0; e < 8; ++e) ss += xa[e] * xa[e] + xb[e] * xb[e];
                    ss = swap16_sum(ss); ss = swap32_sum(ss);
                    const float rr = 1.0f / sqrtf(ss * (1.0f / 64.0f) + EPS);
                    const f32x4 g10 = *(const f32x4*)(g + 8 * fq), g11 = *(const f32x4*)(g + 8 * fq + 4), g20 = *(const f32x4*)(g + 32 + 8 * fq), g21 = *(const f32x4*)(g + 32 + 8 * fq + 4);
                    const int fi = 8 * (fq & 1), pr = sq >> 6, pc = sq & 63;
                    const f32x4 cr0 = *(const f32x4*)(axc + pr * 16 + fi), cr1 = *(const f32x4*)(axc + pr * 16 + fi + 4), sr0 = *(const f32x4*)(axs + pr * 16 + fi), sr1 = *(const f32x4*)(axs + pr * 16 + fi + 4);
                    const f32x4 cc0 = *(const f32x4*)(axc + pc * 16 + fi), cc1 = *(const f32x4*)(axc + pc * 16 + fi + 4), sc0 = *(const f32x4*)(axs + pc * 16 + fi), sc1 = *(const f32x4*)(axs + pc * 16 + fi + 4);
                    const float sgn = (fq < 2) ? -1.0f : 1.0f, sc = isq ? 0.125f * LOG2E : 1.0f; float o1[8], o2[8];
#pragma unroll
                    for (int e = 0; e < 8; ++e) { const float x1 = xa[e] * rr * (e < 4 ? g10[e & 3] : g11[e & 3]), x2 = xb[e] * rr * (e < 4 ? g20[e & 3] : g21[e & 3]);
                        const float p1 = xor32f(x1, lane), p2 = xor32f(x2, lane);
                        o1[e] = (x1 * (e < 4 ? cr0[e & 3] : cr1[e & 3]) + sgn * p1 * (e < 4 ? sr0[e & 3] : sr1[e & 3])) * sc;
                        o2[e] = (x2 * (e < 4 ? cc0[e & 3] : cc1[e & 3]) + sgn * p2 * (e < 4 ? sc0[e & 3] : sc1[e & 3])) * sc; }
                    bf16_t* dst = isq ? qb + ((size_t)(b * 8 + 4 * u.pn + wc) * SEQ + sq) * 64 + 8 * fq : kb + ((size_t)(b * 2 + wc) * SEQ + sq) * 64 + 8 * fq;
                    u32x4 w1, w2; w1.x = cvt_pk_bf16(o1[0], o1[1]); w1.y = cvt_pk_bf16(o1[2], o1[3]); w1.z = cvt_pk_bf16(o1[4], o1[5]); w1.w = cvt_pk_bf16(o1[6], o1[7]);
                    w2.x = cvt_pk_bf16(o2[0], o2[1]); w2.y = cvt_pk_bf16(o2[2], o2[3]); w2.z = cvt_pk_bf16(o2[4], o2[5]); w2.w = cvt_pk_bf16(o2[6], o2[7]);
                    *(u32x4*)dst = w1; *(u32x4*)(dst + 32) = w2;
                } else if (u.pn == 2) {
                    bf16_t* d0 = vb + ((size_t)(b * 2) * SEQ + sq) * 64 + 32 * (wc - 2) + 8 * fq; bf16_t* d1 = d0 + (size_t)SEQ * 64;
                    u32x4 w1, w2; w1.x = cvt_pk_bf16(xa[0], xa[1]); w1.y = cvt_pk_bf16(xa[2], xa[3]); w1.z = cvt_pk_bf16(xa[4], xa[5]); w1.w = cvt_pk_bf16(xa[6], xa[7]);
                    w2.x = cvt_pk_bf16(xb[0], xb[1]); w2.y = cvt_pk_bf16(xb[2], xb[3]); w2.z = cvt_pk_bf16(xb[4], xb[5]); w2.w = cvt_pk_bf16(xb[6], xb[7]);
                    *(u32x4*)d0 = w1; *(u32x4*)d1 = w2;
                } else if (u.pn < 5) {
                    float* up = ug + (size_t)row * 512 + 256 * (u.pn - 3) + c8; f32x4 o0, o1, o2, o3;
#pragma unroll
                    for (int e = 0; e < 4; ++e) { o0[e] = gelu_tanh(xa[e]); o1[e] = gelu_tanh(xa[4 + e]); o2[e] = gelu_tanh(xb[e]); o3[e] = gelu_tanh(xb[4 + e]); }
                    *(f32x4*)up = o0; *(f32x4*)(up + 4) = o1; *(f32x4*)(up + 128) = o2; *(f32x4*)(up + 132) = o3;
                } else {
                    float s1 = 0.f, s2 = 0.f;
#pragma unroll
                    for (int e = 0; e < 8; ++e) { xa[e] = gelu_tanh(xa[e]); xb[e] = gelu_tanh(xb[e]); s1 += xa[e] + xb[e]; s2 += xa[e] * xa[e] + xb[e] * xb[e]; }
                    bf16_t* vp = vraw + (size_t)row * 512 + 256 * (u.pn - 5) + c8;
                    u32x4 w1, w2; w1.x = cvt_pk_bf16(xa[0], xa[1]); w1.y = cvt_pk_bf16(xa[2], xa[3]); w1.z = cvt_pk_bf16(xa[4], xa[5]); w1.w = cvt_pk_bf16(xa[6], xa[7]);
                    w2.x = cvt_pk_bf16(xb[0], xb[1]); w2.y = cvt_pk_bf16(xb[2], xb[3]); w2.z = cvt_pk_bf16(xb[4], xb[5]); w2.w = cvt_pk_bf16(xb[6], xb[7]);
                    *(u32x4*)vp = w1; *(u32x4*)(vp + 128) = w2;
                    s1 = swap16_sum(s1); s1 = swap32_sum(s1); s2 = swap16_sum(s2); s2 = swap32_sum(s2);
                    if (fq == 0) { float* lp = lnp + ((size_t)row * 8 + (u.pn - 5) * 4 + wc) * 2; lp[0] = s1; lp[1] = s2; }
                } }
    }
};
struct EpiBf16Scale {
    static constexpr bool PERM = true, AFTER_DRAIN = false;
    bf16_t* O; int ldc; const float* ssq;
    __device__ __forceinline__ void operator()(const f32x4 (&acc)[2][2][4][2], const Unit& u, int wr, int wc, int fr, int fq) const {
        const int row0 = u.pm * BM + wr * 64 + fr, col0 = u.pn * BM + wc * 32 + 8 * fq;
#pragma unroll
        for (int ai = 0; ai < 2; ++ai)
#pragma unroll
            for (int m = 0; m < 4; ++m) { const int row = row0 + ai * HALF + m * 16; bf16_t* rowp = O + (size_t)row * ldc + col0;
                const float r = rnorm16(ssq + (size_t)row * 16);
#pragma unroll
                for (int bj = 0; bj < 2; ++bj) { const f32x4 v0 = acc[ai][bj][m][0] * r, v1 = acc[ai][bj][m][1] * r;
                    u32x4 w; w.x = cvt_pk_bf16(v0[0], v0[1]); w.y = cvt_pk_bf16(v0[2], v0[3]); w.z = cvt_pk_bf16(v1[0], v1[1]); w.w = cvt_pk_bf16(v1[2], v1[3]); *(u32x4*)(rowp + bj * HALF) = w; } }
    }
};
}

DI void conv_item(const Ctx& c, int item, const float* glu, const float* cw, const float* cb, const float* lng, const float* lnb, bf16* ycat) {
    const int t0 = item * 32, b = t0 / SEQ, s0 = t0 % SEQ, ch = c.tid;
    LAS float* sc = (LAS float*)c.lds;
    float v[62], w[31];
#pragma unroll
    for (int i = 0; i < 62; ++i) { const int s = s0 + i - 15; v[i] = (s >= 0 && s < SEQ) ? glu[((size_t)b * SEQ + s) * 512 + ch] : 0.f; }
#pragma unroll
    for (int j = 0; j < 31; ++j) w[j] = cw[j * 512 + ch];
    const float bias = cb[ch];
    __syncthreads();
#pragma unroll
    for (int i = 0; i < 32; ++i) { float acc = bias;
#pragma unroll
        for (int j = 0; j < 31; ++j) acc += w[j] * v[i + j];
        sc[i * 512 + ch] = acc; }
    __syncthreads();
#pragma unroll
    for (int q = 0; q < 4; ++q) {
        const int i = c.wave * 4 + q; float x[8]; float sm = 0.f;
#pragma unroll
        for (int m = 0; m < 8; ++m) { x[m] = sc[i * 512 + c.lane + 64 * m]; sm += x[m]; }
        const float mean = wave_sum(sm) * (1.0f / 512.0f); float sq = 0.f;
#pragma unroll
        for (int m = 0; m < 8; ++m) { x[m] -= mean; sq += x[m] * x[m]; }
        const float rstd = 1.0f / sqrtf(wave_sum(sq) * (1.0f / 512.0f) + EPS);
#pragma unroll
        for (int m = 0; m < 8; ++m) { const int cc = c.lane + 64 * m; const float y = x[m] * rstd * lng[cc] + lnb[cc];
            ycat[(size_t)(t0 + i) * D + cc] = (bf16)f2bf(y * sigmoidf_(y)); }
    }
}

template <bool WIN>
DI void attn_item(const Ctx& c, int item, const bf16* qb, const bf16* kb, const bf16* vt, bf16* ycat, int ycol0, const float* sink) {
    const int qblk = item & 63, kvh = (item >> 6) & 1, b = item >> 7;
    const int tid = c.tid, lane = c.lane, l31 = lane & 31, h = lane >> 5;
    const int head = kvh * 4 + (c.wave & 3), q0 = qblk * 64 + (c.wave >> 2) * 32;
    const bf16* qrow = qb + ((size_t)(b * 8 + head) * SEQ + q0 + l31) * 64;
    bf16x8 qf[4];
#pragma unroll
    for (int kk = 0; kk < 4; ++kk) qf[kk] = *(const bf16x8*)(qrow + 16 * kk + 8 * h);
    f32x16 o0, o1;
#pragma unroll
    for (int i = 0; i < 16; ++i) { o0[i] = 0.f; o1[i] = 0.f; }
    float m, l;
    if (WIN) { m = sink[head] * LOG2E; l = (h == 0) ? 1.f : 0.f; } else { m = -1e30f; l = 0.f; }
    const bf16* kbase = kb + (size_t)(b * 2 + kvh) * SEQ * 64;
    const bf16* vbase = vt + (size_t)(b * 2 + kvh) * SEQ * 64;
    int t_lo = 0, t_hi = 63;
    if (WIN) { t_lo = qblk - 2 < 0 ? 0 : qblk - 2; t_hi = qblk + 2 > 63 ? 63 : qblk + 2; }
    LAS unsigned char* sK = c.lds; LAS unsigned char* sV = c.lds + 64 * 144;
    const int qpos = q0 + l31;
    u32x4 rk = *(const u32x4*)(kbase + (size_t)(t_lo * 64 + (tid >> 3)) * 64 + (tid & 7) * 8);
    u32x4 rv = *(const u32x4*)(vbase + (size_t)(t_lo * 64 + (tid >> 3)) * 64 + (tid & 7) * 8);
    for (int kt = t_lo; kt <= t_hi; ++kt) {
        __syncthreads();
        *(LAS u32x4*)(sK + (tid >> 3) * 144 + (tid & 7) * 16) = rk;
        *(LAS u32x4*)(sV + (tid >> 3) * 192 + (tid & 7) * 16) = rv;
        __syncthreads();
        { const int kn = kt < t_hi ? kt + 1 : kt;
          rk = *(const u32x4*)(kbase + (size_t)(kn * 64 + (tid >> 3)) * 64 + (tid & 7) * 8);
          rv = *(const u32x4*)(vbase + (size_t)(kn * 64 + (tid >> 3)) * 64 + (tid & 7) * 8); }
        f32x16 s0, s1;
#pragma unroll
        for (int i = 0; i < 16; ++i) { s0[i] = 0.f; s1[i] = 0.f; }
#pragma unroll
        for (int kk = 0; kk < 4; ++kk) {
            const bf16x8 k0 = *(const LAS bf16x8*)(sK + l31 * 144 + (16 * kk + 8 * h) * 2);
            const bf16x8 k1 = *(const LAS bf16x8*)(sK + (32 + l31) * 144 + (16 * kk + 8 * h) * 2);
            s0 = MFMA32(k0, qf[kk], s0); s1 = MFMA32(k1, qf[kk], s1);
        }
        if (WIN) {
#pragma unroll
            for (int r = 0; r < 16; ++r) {
                const int kp0 = kt * 64 + crow(r, h), kp1 = kp0 + 32;
                const int d0 = kp0 - qpos, d1 = kp1 - qpos;
                if (d0 > 128 || d0 < -128) s0[r] = -1e30f;
                if (d1 > 128 || d1 < -128) s1[r] = -1e30f;
            }
        }
        float mx = s0[0];
#pragma unroll
        for (int r = 1; r < 16; ++r) mx = fmaxf(mx, s0[r]);
#pragma unroll
        for (int r = 0; r < 16; ++r) mx = fmaxf(mx, s1[r]);
        mx = fmaxf(mx, __shfl_xor(mx, 32));
        const float mn = fmaxf(m, mx), alpha = __builtin_amdgcn_exp2f(m - mn); m = mn;
        float ls = 0.f;
#pragma unroll
        for (int r = 0; r < 16; ++r) { s0[r] = __builtin_amdgcn_exp2f(s0[r] - mn); s1[r] = __builtin_amdgcn_exp2f(s1[r] - mn); ls += s0[r] + s1[r]; }
        l = l * alpha + ls;
        if (__any(alpha != 1.0f)) {
#pragma unroll
            for (int i = 0; i < 16; ++i) { o0[i] *= alpha; o1[i] *= alpha; }
        }
#pragma unroll
        for (int tl = 0; tl < 2; ++tl)
#pragma unroll
            for (int st = 0; st < 2; ++st) {
                u32x4 pp;
                if (tl == 0) { pp.x = pk2(s0[8 * st], s0[8 * st + 1]); pp.y = pk2(s0[8 * st + 2], s0[8 * st + 3]); pp.z = pk2(s0[8 * st + 4], s0[8 * st + 5]); pp.w = pk2(s0[8 * st + 6], s0[8 * st + 7]); }
                else         { pp.x = pk2(s1[8 * st], s1[8 * st + 1]); pp.y = pk2(s1[8 * st + 2], s1[8 * st + 3]); pp.z = pk2(s1[8 * st + 4], s1[8 * st + 5]); pp.w = pk2(s1[8 * st + 6], s1[8 * st + 7]); }
                const bf16x8 pf = __builtin_bit_cast(bf16x8, pp);
                const int gi = lane & 15, gg = lane >> 4;
                const int vaddr = (tl * 32 + 16 * st + 4 * h + (gi >> 2)) * 192 + (16 * (gg & 1) + 4 * (gi & 3)) * 2;
                typedef short v4i16_t __attribute__((ext_vector_type(4)));
                {
                    const v4i16_t lo = __builtin_amdgcn_ds_read_tr16_b64_v4i16((LAS v4i16_t*)(sV + vaddr)), hi = __builtin_amdgcn_ds_read_tr16_b64_v4i16((LAS v4i16_t*)(sV + vaddr + 8 * 192));
                    const bf16x8 vf = {lo[0], lo[1], lo[2], lo[3], hi[0], hi[1], hi[2], hi[3]};
                    o0 = MFMA32(vf, pf, o0);
                }
                {
                    const v4i16_t lo = __builtin_amdgcn_ds_read_tr16_b64_v4i16((LAS v4i16_t*)(sV + vaddr + 64)), hi = __builtin_amdgcn_ds_read_tr16_b64_v4i16((LAS v4i16_t*)(sV + vaddr + 64 + 8 * 192));
                    const bf16x8 vf = {lo[0], lo[1], lo[2], lo[3], hi[0], hi[1], hi[2], hi[3]};
                    o1 = MFMA32(vf, pf, o1);
                }
            }
    }
    const float lt = l + __shfl_xor(l, 32), inv = 1.0f / lt;
    bf16* orow = ycat + (size_t)(b * SEQ + q0 + l31) * D + ycol0 + head * 64;
#pragma unroll
    for (int g = 0; g < 4; ++g) {
        u32x2 w0; w0.x = pk2(o0[4 * g] * inv, o0[4 * g + 1] * inv); w0.y = pk2(o0[4 * g + 2] * inv, o0[4 * g + 3] * inv);
        u32x2 w1; w1.x = pk2(o1[4 * g] * inv, o1[4 * g + 1] * inv); w1.y = pk2(o1[4 * g + 2] * inv, o1[4 * g + 3] * inv);
        *(u32x2*)(orow + 8 * g + 4 * h) = w0; *(u32x2*)(orow + 32 + 8 * g + 4 * h) = w1;
    }
    __syncthreads();
}

DI void sgu_item(const Ctx& c, int item, const float* sw, const float* sb, const bf16* vn, const float* lnp, const float* lng, const float* lnb, const float* ug, bf16* ycat) {
    const int g = item & 3, n = (item >> 2) & 31, b = item >> 7;
    const int tid = c.tid, lane = c.lane, l31 = lane & 31, h = lane >> 5;
    LAS unsigned char* sW = c.lds; LAS unsigned char* sV = c.lds + 128 * 272;
    const float* wg = sw + (size_t)g * 128 * 128;
    __syncthreads();
#pragma unroll
    for (int i = 0; i < 4; ++i) { const int idx = tid + NT * i, row = idx >> 4, ch = idx & 15;
        const f32x4 a = *(const f32x4*)(wg + row * 128 + ch * 8), bq = *(const f32x4*)(wg + row * 128 + ch * 8 + 4);
        u32x4 o; o.x = pk2(a.x, a.y); o.y = pk2(a.z, a.w); o.z = pk2(bq.x, bq.y); o.w = pk2(bq.z, bq.w);
        *(LAS u32x4*)(sW + row * 272 + ch * 16) = o;
        const size_t tk = (size_t)b * SEQ + n * 128 + row;
        const u32x4 vv = *(const u32x4*)(vn + tk * 512 + g * 128 + ch * 8);
        float s1 = 0.f, s2 = 0.f;
#pragma unroll
        for (int p = 0; p < 4; ++p) { const f32x4 t4 = ((const f32x4*)(lnp + tk * 16))[p]; s1 += t4.x + t4.z; s2 += t4.y + t4.w; }
        const float mean = s1 * (1.0f / 512.0f), rstd = 1.0f / sqrtf(fmaxf(s2 * (1.0f / 512.0f) - mean * mean, 0.f) + EPS);
        const f32x4 ga = *(const f32x4*)(lng + g * 128 + ch * 8), gb = *(const f32x4*)(lng + g * 128 + ch * 8 + 4), ba = *(const f32x4*)(lnb + g * 128 + ch * 8), bb = *(const f32x4*)(lnb + g * 128 + ch * 8 + 4);
        u32x4 vo;
        vo.x = pk2((bf_lo(vv.x) - mean) * rstd * ga.x + ba.x, (bf_hi(vv.x) - mean) * rstd * ga.y + ba.y); vo.y = pk2((bf_lo(vv.y) - mean) * rstd * ga.z + ba.z, (bf_hi(vv.y) - mean) * rstd * ga.w + ba.w);
        vo.z = pk2((bf_lo(vv.z) - mean) * rstd * gb.x + bb.x, (bf_hi(vv.z) - mean) * rstd * gb.y + bb.y); vo.w = pk2((bf_lo(vv.w) - mean) * rstd * gb.z + bb.z, (bf_hi(vv.w) - mean) * rstd * gb.w + bb.w);
        *(LAS u32x4*)(sV + row * 272 + ch * 16) = vo; }
    __syncthreads();
    const int ct = c.wave & 3, pt0 = (c.wave >> 2) * 2;
    f32x16 acc[2];
#pragma unroll
    for (int j = 0; j < 2; ++j)
#pragma unroll
        for (int i = 0; i < 16; ++i) acc[j][i] = 0.f;
#pragma unroll
    for (int kk = 0; kk < 8; ++kk) {
        bf16x8 bfr;
#pragma unroll
        for (int j = 0; j < 8; ++j) bfr[j] = *(const LAS short*)(sV + (16 * kk + 8 * h + j) * 272 + (ct * 32 + l31) * 2);
#pragma unroll
        for (int j = 0; j < 2; ++j) {
            const bf16x8 af = *(const LAS bf16x8*)(sW + ((pt0 + j) * 32 + l31) * 272 + (16 * kk + 8 * h) * 2);
            acc[j] = MFMA32(af, bfr, acc[j]);
        }
    }
#pragma unroll
    for (int j = 0; j < 2; ++j)
#pragma unroll
        for (int r = 0; r < 16; ++r) {
            const int p = (pt0 + j) * 32 + crow(r, h), cc = ct * 32 + l31; const size_t t = (size_t)b * SEQ + n * 128 + p;
            const float mixed = acc[j][r] + sb[g * 128 + p];
            ycat[t * D + 512 + g * 128 + cc] = (bf16)f2bf(ug[t * 512 + g * 128 + cc] * mixed);
        }
}

DI unsigned fkey(float f, unsigned code, unsigned mask) { const unsigned b = __float_as_uint(f); const unsigned s = b ^ ((unsigned)((int)b >> 31) | 0x80000000u); return (s & ~mask) | code; }
DI float keyval(unsigned k, unsigned mask, unsigned mid) { const unsigned s = (k & ~mask) | mid; const unsigned b = (s & 0x80000000u) ? (s ^ 0x80000000u) : ~s; return __uint_as_float(b); }
#define CE_DESC(x, y) do { const unsigned mx_ = (x) > (y) ? (x) : (y), mn_ = (x) > (y) ? (y) : (x); (x) = mx_; (y) = mn_; } while (0)
DI void sort16_desc(unsigned (&a)[16]) {
    CE_DESC(a[0], a[1]); CE_DESC(a[2], a[3]); CE_DESC(a[0], a[2]); CE_DESC(a[1], a[3]); CE_DESC(a[1], a[2]); CE_DESC(a[4], a[5]); CE_DESC(a[6], a[7]);
    CE_DESC(a[4], a[6]); CE_DESC(a[5], a[7]); CE_DESC(a[5], a[6]); CE_DESC(a[0], a[4]); CE_DESC(a[2], a[6]); CE_DESC(a[2], a[4]); CE_DESC(a[1], a[5]);
    CE_DESC(a[3], a[7]); CE_DESC(a[3], a[5]); CE_DESC(a[1], a[2]); CE_DESC(a[3], a[4]); CE_DESC(a[5], a[6]); CE_DESC(a[8], a[9]); CE_DESC(a[10], a[11]);
    CE_DESC(a[8], a[10]); CE_DESC(a[9], a[11]); CE_DESC(a[9], a[10]); CE_DESC(a[12], a[13]); CE_DESC(a[14], a[15]); CE_DESC(a[12], a[14]); CE_DESC(a[13], a[15]);
    CE_DESC(a[13], a[14]); CE_DESC(a[8], a[12]); CE_DESC(a[10], a[14]); CE_DESC(a[10], a[12]); CE_DESC(a[9], a[13]); CE_DESC(a[11], a[15]); CE_DESC(a[11], a[13]);
    CE_DESC(a[9], a[10]); CE_DESC(a[11], a[12]); CE_DESC(a[13], a[14]); CE_DESC(a[0], a[8]); CE_DESC(a[4], a[12]); CE_DESC(a[4], a[8]); CE_DESC(a[2], a[10]);
    CE_DESC(a[6], a[14]); CE_DESC(a[6], a[10]); CE_DESC(a[2], a[4]); CE_DESC(a[6], a[8]); CE_DESC(a[10], a[12]); CE_DESC(a[1], a[9]); CE_DESC(a[5], a[13]);
    CE_DESC(a[5], a[9]); CE_DESC(a[3], a[11]); CE_DESC(a[7], a[15]); CE_DESC(a[7], a[11]); CE_DESC(a[3], a[5]); CE_DESC(a[7], a[9]); CE_DESC(a[11], a[13]);
    CE_DESC(a[1], a[2]); CE_DESC(a[3], a[4]); CE_DESC(a[5], a[6]); CE_DESC(a[7], a[8]); CE_DESC(a[9], a[10]); CE_DESC(a[11], a[12]); CE_DESC(a[13], a[14]);
}
DI void merge16_desc(unsigned (&a)[16], const unsigned (&b)[16]) {
#pragma unroll
    for (int i = 0; i < 16; ++i) a[i] = a[i] > b[15 - i] ? a[i] : b[15 - i];
#pragma unroll
    for (int j = 8; j > 0; j >>= 1)
#pragma unroll
        for (int i = 0; i < 16; ++i) { const int l = i ^ j; if (l > i) CE_DESC(a[i], a[l]); }
}
DI void pair_merge16(unsigned (&a)[16]) {
    unsigned lo[16], hi[16];
#pragma unroll
    for (int i = 0; i < 16; ++i) { const auto r = __builtin_amdgcn_permlane32_swap(a[i], a[i], false, false); lo[i] = r[0]; hi[i] = r[1]; }
    merge16_desc(lo, hi);
#pragma unroll
    for (int i = 0; i < 16; ++i) a[i] = lo[i];
}
struct CandTab { int ci[64], cj[64]; constexpr CandTab() : ci(), cj() { int n = 0; for (int i = 0; i < 16; ++i) for (int j = 0; j < 16; ++j) if ((i + 1) * (j + 1) <= 16) { ci[n] = i; cj[n] = j; ++n; } for (; n < 64; ++n) { ci[n] = -1; cj[n] = -1; } } };
constexpr CandTab CAND{};
DI unsigned pick_byte(unsigned w0, unsigned w1, unsigned w2, unsigned w3, unsigned i) {
    const unsigned w = (i & 8u) ? ((i & 4u) ? w3 : w2) : ((i & 4u) ? w1 : w0);
    return (w >> ((i & 3u) * 8u)) & 0xFFu;
}
DI void route_item(const Ctx& c, int item, const bf16* qp, const bf16* sk, int* eidx, float* gate, bool stage, int lds_off = 0) {
    const int hd = item & 7, tb = item >> 3;
    const int tid = c.tid, lane = c.lane, l31 = lane & 31, h = lane >> 5;
    LAS unsigned char* sS = c.lds + lds_off;
    if (stage) {
    __syncthreads();
#pragma unroll
    for (int i = 0; i < 4; ++i) { const int idx = tid + NT * i, row = idx >> 3, ch = idx & 7;
        *(LAS u32x4*)(sS + row * 144 + ch * 16) = *(const u32x4*)(sk + (size_t)hd * 2 * 128 * 64 + (size_t)row * 64 + ch * 8); }
    }
    const int t = tb * 256 + c.wave * 32 + l31;
    const bf16* qrow = qp + (size_t)t * D + hd * 128;
    bf16x8 qf[8];
#pragma unroll
    for (int kk = 0; kk < 8; ++kk) qf[kk] = *(const bf16x8*)(qrow + 16 * kk + 8 * h);
    if (stage) __syncthreads();
    unsigned sv[2][16];
#pragma unroll
    for (int p = 0; p < 2; ++p) {
        unsigned top[16];
#pragma unroll
        for (int tl = 0; tl < 4; ++tl) {
            f32x16 acc;
#pragma unroll
            for (int i = 0; i < 16; ++i) acc[i] = 32.0f;
#pragma unroll
            for (int kk = 0; kk < 4; ++kk) {
                const bf16x8 af = *(const LAS bf16x8*)(sS + (p * 128 + tl * 32 + l31) * 144 + (16 * kk + 8 * h) * 2);
                acc = MFMA32(af, qf[p * 4 + kk], acc);
            }
            unsigned g[16];
#pragma unroll
            for (int r = 0; r < 16; ++r) g[r] = (__float_as_uint(acc[r]) & ~127u) | ((unsigned)(127 - (tl * 32 + (r & 3) + 8 * (r >> 2))) - 4u * (unsigned)h);
            sort16_desc(g);
            if (tl == 0) {
#pragma unroll
                for (int i = 0; i < 16; ++i) top[i] = g[i];
            } else merge16_desc(top, g);
        }
        pair_merge16(top);
#pragma unroll
        for (int i = 0; i < 16; ++i) sv[p][i] = top[i];
    }
    float v0[16], v1[16];
#pragma unroll
    for (int i = 0; i < 16; ++i) { v0[i] = __uint_as_float((sv[0][i] & ~127u) | 64u) - 32.0f; v1[i] = __uint_as_float((sv[1][i] & ~127u) | 64u) - 32.0f; }
    unsigned ca[16], cb[16];
#pragma unroll
    for (int m = 0; m < 32; ++m) {
        constexpr int dummy = 0; (void)dummy;
        const int ia = CAND.ci[m], ja = CAND.cj[m], ib = CAND.ci[32 + m], jb = CAND.cj[32 + m];
        const unsigned ka = fkey(v0[ia] + v1[ja], (unsigned)(255 - (ia * 16 + ja)), 255u);
        const int ibc = ib >= 0 ? ib : 0, jbc = jb >= 0 ? jb : 0;
        const unsigned kb2 = (ib >= 0) ? fkey(v0[ibc] + v1[jbc], (unsigned)(255 - (ibc * 16 + jbc)), 255u) : 0u;
        const unsigned kx = h ? kb2 : ka;
        if (m < 16) ca[m] = kx; else cb[m - 16] = kx;
    }
    sort16_desc(ca); sort16_desc(cb); merge16_desc(ca, cb);
    pair_merge16(ca);
    unsigned p0[4], p1[4];
#pragma unroll
    for (int w = 0; w < 4; ++w) { p0[w] = 0u; p1[w] = 0u;
#pragma unroll
        for (int q = 0; q < 4; ++q) { p0[w] |= (127u - (sv[0][4 * w + q] & 127u)) << (8 * q); p1[w] |= (127u - (sv[1][4 * w + q] & 127u)) << (8 * q); } }
    float fv[16]; int ex[16];
#pragma unroll
    for (int r = 0; r < 16; ++r) { const unsigned code = 255u - (ca[r] & 255u); fv[r] = keyval(ca[r], 255u, 128u);
        ex[r] = (int)(pick_byte(p0[0], p0[1], p0[2], p0[3], code >> 4) * 128u + pick_byte(p1[0], p1[1], p1[2], p1[3], code & 15u)); }
    float sum = 0.f; const float mxv = fv[0];
#pragma unroll
    for (int r = 0; r < 16; ++r) { fv[r] = __expf(fv[r] - mxv); sum += fv[r]; }
    const float inv = 1.0f / sum;
    int eo[8]; float go[8];
#pragma unroll
    for (int r = 0; r < 8; ++r) { eo[r] = h ? ex[8 + r] : ex[r]; go[r] = (h ? fv[8 + r] : fv[r]) * inv; }
    int* ep = eidx + (size_t)t * 128 + hd * 16 + 8 * h; float* gp = gate + (size_t)t * 128 + hd * 16 + 8 * h;
    typedef int i32x4 __attribute__((ext_vector_type(4)));
    i32x4 e0, e1; e0.x = eo[0]; e0.y = eo[1]; e0.z = eo[2]; e0.w = eo[3]; e1.x = eo[4]; e1.y = eo[5]; e1.z = eo[6]; e1.w = eo[7];
    f32x4 g0, g1; g0.x = go[0]; g0.y = go[1]; g0.z = go[2]; g0.w = go[3]; g1.x = go[4]; g1.y = go[5]; g1.z = go[6]; g1.w = go[7];
    *(i32x4*)ep = e0; *(i32x4*)(ep + 4) = e1; *(f32x4*)gp = g0; *(f32x4*)(gp + 4) = g1;
}

struct GuTok { u32x4 seg[16]; u32x4 h; };
DI void gu_issue(GuTok& k, int lane, int q, int t, int e0, int e1, const unsigned char* ub, const unsigned char* x8) {
    const int sub = lane >> 3, ch = lane & 7;
    k.h = *(const u32x4*)(x8 + ((unsigned)t * (unsigned)D + (unsigned)(q * 128 + ch * 16)));
#pragma unroll
    for (int i = 0; i < 16; ++i) { const int src = (8 * i + sub) & 63; const int e = __shfl(i < 8 ? e0 : e1, src);
        k.seg[i] = *(const u32x4*)(ub + (unsigned)(q * (PEER_E * 128) + e * 128 + ch * 16)); }
}
DI float lane_xor4(float v, bool b2) {
    int r = __builtin_amdgcn_update_dpp(0, __builtin_bit_cast(int, v), 0x104, 0xF, 0x5, false);
    r = __builtin_amdgcn_update_dpp(r, __builtin_bit_cast(int, v), 0x114, 0xF, 0xA, false);
    (void)b2; return __builtin_bit_cast(float, r);
}
DI void gu_finish(const GuTok& k, int lane, bf16* pa_t) {
    const int sub = lane >> 3;
    const bool b0 = lane & 1, b1 = lane & 2, b2 = lane & 4;
    float d[16];
#pragma unroll
    for (int i = 0; i < 16; ++i) { int di = __builtin_amdgcn_sdot4((int)k.seg[i].x, (int)k.h.x, 0, false); di = __builtin_amdgcn_sdot4((int)k.seg[i].y, (int)k.h.y, di, false);
        di = __builtin_amdgcn_sdot4((int)k.seg[i].z, (int)k.h.z, di, false); di = __builtin_amdgcn_sdot4((int)k.seg[i].w, (int)k.h.w, di, false); d[i] = (float)di; }
    float r8[8], r4[4], r2[2];
#pragma unroll
    for (int i = 0; i < 8; ++i) { const float mine = b0 ? d[8 + i] : d[i], send = b0 ? d[i] : d[8 + i];
        r8[i] = mine + __builtin_bit_cast(float, __builtin_amdgcn_update_dpp(0, __builtin_bit_cast(int, send), 0xB1, 0xF, 0xF, true)); }
#pragma unroll
    for (int i = 0; i < 4; ++i) { const float mine = b1 ? r8[4 + i] : r8[i], send = b1 ? r8[i] : r8[4 + i];
        r4[i] = mine + __builtin_bit_cast(float, __builtin_amdgcn_update_dpp(0, __builtin_bit_cast(int, send), 0x4E, 0xF, 0xF, true)); }
#pragma unroll
    for (int i = 0; i < 2; ++i) { const float mine = b2 ? r4[2 + i] : r4[i], send = b2 ? r4[i] : r4[2 + i]; r2[i] = mine + lane_xor4(send, b2); }
    const int i0 = (b0 ? 8 : 0) + (b1 ? 4 : 0) + (b2 ? 2 : 0);
    __builtin_nontemporal_store((bf16)f2bf(r2[0]), pa_t + 8 * i0 + sub); __builtin_nontemporal_store((bf16)f2bf(r2[1]), pa_t + 8 * (i0 + 1) + sub);
}
DI void gu_wave(const Ctx& c, int q, int t_first, int t_step, const unsigned char* hb, const int* eidx, const unsigned char* ub, bf16* pa,
                int cl, const float* usrc, const float* vsrc, const float* fg, unsigned char* ws) {
    const int lane = c.lane;
    const int n = (t_first < T) ? (T - t_first + t_step - 1) >> __builtin_ctz(t_step) : 0;
    if (n == 0) return;
#define GU_ROUTE(tt, E0, E1) do { const int t_ = (tt) < T ? (tt) : t_first; E0 = eidx[(size_t)t_ * 128 + lane]; E1 = eidx[(size_t)t_ * 128 + 64 + lane]; } while (0)
    int ea0, ea1, eb0, eb1;
    GU_ROUTE(t_first, ea0, ea1);
    GU_ROUTE(t_first + t_step, eb0, eb1);
    GuTok A, B;
    if (c.wave & 1) __builtin_amdgcn_s_sleep(32);
    gu_issue(A, lane, q, t_first, ea0, ea1, ub, hb);
    int i = 0;
    const int gwv = c.vid * NWAVES + c.wave, ngw = c.G * NWAVES;
    int cr = gwv; TabRow R;
    if (cl < DEPTH && cr < 2 * PEER_E) tabrow_load(R, lane, cl, cr, usrc, vsrc);
    for (; i + 1 < n; i += 2) {
        const int t = t_first + i * t_step;
        if ((i & 2) && cl < DEPTH && cr < 2 * PEER_E) { tabrow_finish(R, lane, cl, cr, fg, ws); cr += ngw; if (cr < 2 * PEER_E) tabrow_load(R, lane, cl, cr, usrc, vsrc); }
        gu_issue(B, lane, q, t + t_step, eb0, eb1, ub, hb);
        GU_ROUTE(t + 2 * t_step, ea0, ea1);
        gu_finish(A, lane, pa + ((size_t)q * T + t) * 128);
        if (i + 2 < n) gu_issue(A, lane, q, t + 2 * t_step, ea0, ea1, ub, hb);
        GU_ROUTE(t + 3 * t_step, eb0, eb1);
        gu_finish(B, lane, pa + ((size_t)q * T + t + t_step) * 128);
    }
    if (i < n) gu_finish(A, lane, pa + ((size_t)q * T + t_first + i * t_step) * 128);
    while (cl < DEPTH && cr < 2 * PEER_E) { tabrow_finish(R, lane, cl, cr, fg, ws); cr += ngw; if (cr < 2 * PEER_E) tabrow_load(R, lane, cl, cr, usrc, vsrc); }
#undef GU_ROUTE
}
DI void phase_w(const Ctx& c, const bf16* pa, const int* eidx, const float* gate, const float* uinv, const float* vinv, const float* ssq, float* wbuf) {
    const unsigned gth = (unsigned)c.G * NT;
    for (unsigned i0 = (unsigned)c.vcu * NT + c.tid; i0 < (unsigned)T * 128; i0 += 8 * gth) {
        float a[8]; int e[8]; float g[8], sq[8];
#pragma unroll
        for (int j = 0; j < 8; ++j) { const unsigned i = i0 + j * gth < (unsigned)T * 128 ? i0 + j * gth : i0; a[j] = 0.f;
#pragma unroll
            for (int q = 0; q < 8; ++q) a[j] += __uint_as_float((unsigned)pa[(size_t)q * T * 128 + i] << 16);
            e[j] = eidx[i]; g[j] = gate[i];
            const unsigned tk = (unsigned)__builtin_amdgcn_readfirstlane((int)(i >> 7));
            sq[j] = rnorm16(ssq + (size_t)tk * 16); }
#pragma unroll
        for (int j = 0; j < 8; ++j) { const unsigned i = i0 + j * gth;
            if (i < (unsigned)T * 128) ((unsigned*)wbuf)[i] = (unsigned)e[j] | (f2bf(gelu_tanh(a[j] * uinv[e[j]] * sq[j] * 0.0625f) * g[j] * vinv[e[j]]) << 16); }
    }
}
DI float lane_xor16(float v, bool odd_row) { const auto r = __builtin_amdgcn_permlane16_swap(__float_as_uint(v), __float_as_uint(v), false, false); return __uint_as_float(odd_row ? r[0] : r[1]); }
DI float lane_xor32(float v, bool hi) { const auto r = __builtin_amdgcn_permlane32_swap(__float_as_uint(v), __float_as_uint(v), false, false); return __uint_as_float(hi ? r[0] : r[1]); }
struct GmHalf { u32x4 seg[8]; };
DI void gm_issue(GmHalf& k, int lane, int q, unsigned ew, const unsigned char* vb, int emask) {
    const int sub = lane >> 3, ch = lane & 7;
#pragma unroll
    for (int i = 0; i < 8; ++i) { const int ei = (int)(__shfl(ew, 8 * i + sub) & 0xFFFFu) & emask; k.seg[i] = *(const u32x4*)(vb + (unsigned)(q * (PEER_E * 128) + ei * 128 + ch * 16)); }
}
DI float gm_prep(unsigned ew0, unsigned ew1, LAS unsigned char* wslot, int lane) {
    const float w0 = __uint_as_float(ew0 & 0xFFFF0000u), w1 = __uint_as_float(ew1 & 0xFFFF0000u);
    float m = fmaxf(fabsf(w0), fabsf(w1));
    m = fmaxf(m, __builtin_bit_cast(float, __builtin_amdgcn_update_dpp(0, __builtin_bit_cast(int, m), 0xB1, 0xF, 0xF, true)));
    m = fmaxf(m, __builtin_bit_cast(float, __builtin_amdgcn_update_dpp(0, __builtin_bit_cast(int, m), 0x4E, 0xF, 0xF, true)));
    m = fmaxf(m, __builtin_bit_cast(float, __builtin_amdgcn_update_dpp(0, __builtin_bit_cast(int, m), 0x141, 0xF, 0xF, true)));
    m = fmaxf(m, __builtin_bit_cast(float, __builtin_amdgcn_update_dpp(0, __builtin_bit_cast(int, m), 0x140, 0xF, 0xF, true)));
    { const auto p = __builtin_amdgcn_permlane16_swap(__float_as_uint(m), __float_as_uint(m), false, false); m = fmaxf(__uint_as_float(p[0]), __uint_as_float(p[1])); }
    { const auto p = __builtin_amdgcn_permlane32_swap(__float_as_uint(m), __float_as_uint(m), false, false); m = fmaxf(__uint_as_float(p[0]), __uint_as_float(p[1])); }
    unsigned em = (__float_as_uint(m) >> 23) & 0xFFu; em = em < 16u ? 16u : em;
    const float S = __uint_as_float((261u - em) << 23);
    const int p = __builtin_amdgcn_cvt_pk_fp8_f32(w0 * S, w1 * S, 0, false);
    wslot[lane] = (unsigned char)(p & 0xFF); wslot[64 + lane] = (unsigned char)((p >> 8) & 0xFF);
    return __uint_as_float((em - 7u) << 23);
}
DI void gm_accum(const GmHalf& k, const LAS unsigned char* wh, int lane, f32x4& alo, f32x4& ahi) {
    const unsigned sub = (unsigned)lane >> 3, sh = 8u * ((unsigned)lane & 7u), sel = 0x0C0C0C00u | sub;
    u32x4 W[4];
#pragma unroll
    for (int j = 0; j < 4; ++j) W[j] = *(const LAS u32x4*)(wh + 16 * j);
#pragma unroll
    for (int i = 0; i < 8; ++i) { const unsigned lo = (i & 1) ? W[i >> 1].z : W[i >> 1].x, hi = (i & 1) ? W[i >> 1].w : W[i >> 1].y;
        const long A = (long)((unsigned long long)__builtin_amdgcn_perm(hi, lo, sel) << sh);
        alo = __builtin_amdgcn_mfma_f32_16x16x32_fp8_fp8(A, (long)(((unsigned long long)k.seg[i].y << 32) | k.seg[i].x), alo, 0, 0, 0);
        ahi = __builtin_amdgcn_mfma_f32_16x16x32_fp8_fp8(A, (long)(((unsigned long long)k.seg[i].w << 32) | k.seg[i].z), ahi, 0, 0, 0); }
}
DI void gm_store(const f32x4 alo, const f32x4 ahi, float invS, int lane, int q, int t, bf16* xb, float* xf, float* ssq) {
    const int j = lane & 15, g = lane >> 4;
    float v[8];
#pragma unroll
    for (int r = 0; r < 4; ++r) { v[r] = alo[r]; v[4 + r] = ahi[r]; }
#pragma unroll
    for (int r = 0; r < 8; ++r) { const float p8 = __builtin_bit_cast(float, __builtin_amdgcn_update_dpp(0, __builtin_bit_cast(int, v[r]), 0x128, 0xF, 0xF, true));
        v[r] = (v[r] + lane_xor32(p8, lane >= 32)) * invS; }
    const bool own = (j < 8) && (g < 2);
    float sq = 0.f;
    if (own) { const unsigned off = (unsigned)t * (unsigned)D + (unsigned)(q * 128 + 16 * j + 4 * g);
        const u32x2 xa = *(const u32x2*)(xb + off), xc = *(const u32x2*)(xb + off + 8);
        f32x4 a = {bf_lo(xa.x) + v[0], bf_hi(xa.x) + v[1], bf_lo(xa.y) + v[2], bf_hi(xa.y) + v[3]}, b = {bf_lo(xc.x) + v[4], bf_hi(xc.x) + v[5], bf_lo(xc.y) + v[6], bf_hi(xc.y) + v[7]};
        if (xf) { *(f32x4*)(xf + off) = a; *(f32x4*)(xf + off + 8) = b; }
        if (ssq) { u32x2 w0; w0.x = pk2(a.x, a.y); w0.y = pk2(a.z, a.w); u32x2 w1; w1.x = pk2(b.x, b.y); w1.y = pk2(b.z, b.w); *(u32x2*)(xb + off) = w0; *(u32x2*)(xb + off + 8) = w1; }
        sq = (a.x * a.x + a.y * a.y) + (a.z * a.z + a.w * a.w) + (b.x * b.x + b.y * b.y) + (b.z * b.z + b.w * b.w); }
    if (ssq) { sq = wave_sum_fast(sq); if (lane == 0) ssq[(unsigned)t * 8u + (unsigned)q] = sq; }
}
DI void gv_wave(const Ctx& c, int q, int t_first, int t_step, const int* eidx, const float* wbuf, const unsigned char* vb, int emask, bf16* xb, float* xf, float* ssq) {
    const int lane = c.lane;
    const int n = (t_first < T) ? (T - t_first + t_step - 1) >> __builtin_ctz(t_step) : 0;
    if (n == 0) return;
    (void)eidx;
    LAS unsigned char* wl = c.lds + c.wave * 512;
#define TOK(k) (t_first + (k) * t_step)
#define GV_RT(k, E0, E1) do { const unsigned o_ = (unsigned)TOK(k) * 128u + (unsigned)lane; E0 = ewb[o_]; E1 = ewb[o_ + 64u]; } while (0)
    const unsigned* ewb = (const unsigned*)wbuf;
    unsigned r00, r01, rx0, rx1, ry0, ry1, rz0, rz1;
    GV_RT(0, r00, r01); GV_RT(1, rx0, rx1); GV_RT(2, ry0, ry1); GV_RT(3, rz0, rz1);
    float is0 = gm_prep(r00, r01, wl + 0, lane), is1 = gm_prep(rx0, rx1, wl + 128, lane);
    GmHalf U0, U1, U2, U3;
    gm_issue(U0, lane, q, r00, vb, emask); gm_issue(U1, lane, q, r01, vb, emask); gm_issue(U2, lane, q, rx0, vb, emask);
    for (int i = 0; i < n; i += 2) {
        unsigned rn0, rn1;
        GV_RT(i + 4, rn0, rn1);
        const float is2 = gm_prep(ry0, ry1, wl + 128 * ((i + 2) & 3), lane);
        f32x4 alo = {0.f, 0.f, 0.f, 0.f}, ahi = {0.f, 0.f, 0.f, 0.f};
        gm_issue(U3, lane, q, rx1, vb, emask);
        gm_accum(U0, wl + 128 * (i & 3), lane, alo, ahi);
        gm_issue(U0, lane, q, ry0, vb, emask);
        gm_accum(U1, wl + 128 * (i & 3) + 64, lane, alo, ahi);
        gm_store(alo, ahi, is0, lane, q, TOK(i), xb, xf, ssq);
        gm_issue(U1, lane, q, ry1, vb, emask);
        unsigned rm0, rm1;
        GV_RT(i + 5, rm0, rm1);
        const float is3 = gm_prep(rz0, rz1, wl + 128 * ((i + 3) & 3), lane);
        alo = (f32x4){0.f, 0.f, 0.f, 0.f}; ahi = (f32x4){0.f, 0.f, 0.f, 0.f};
        gm_accum(U2, wl + 128 * ((i + 1) & 3), lane, alo, ahi);
        gm_issue(U2, lane, q, rz0, vb, emask);
        gm_accum(U3, wl + 128 * ((i + 1) & 3) + 64, lane, alo, ahi);
        if (i + 1 < n) gm_store(alo, ahi, is1, lane, q, TOK(i + 1), xb, xf, ssq);
        rx1 = rz1; ry0 = rn0; ry1 = rn1; rz0 = rm0; rz1 = rm1; is0 = is2; is1 = is3;
    }
#undef GV_RT
#undef TOK
}

namespace attn_body {
using bf16=__hip_bfloat16;
using bf16x8=__attribute__((ext_vector_type(8)))short;
using s16x4=__attribute__((ext_vector_type(4)))short;
using f32x16=__attribute__((ext_vector_type(16)))float;
using u32x4=__attribute__((ext_vector_type(4)))unsigned;
constexpr int BATCH=4,NHEAD=8,NKV=2,SEQ=4096,D=64;
constexpr int QP=64,KP=64,VP=64,OP=1024;
constexpr int NW=8,QBLK=32,QB=QBLK*NW,KVBLK=64,NQB=SEQ/QB;
constexpr int ATTN_UNIT_ROWS=QB;
__device__ __forceinline__ int crow(int r,int hi){return (r&3)+8*(r>>2)+4*hi;}
#define SBAR() __builtin_amdgcn_sched_barrier(0)
__device__ __forceinline__ void cmask(f32x16&p0,f32x16&p1,int jb,int qrel,int hi){
  const float NEG=-INFINITY; int kb=64*jb+4*hi;
  #pragma unroll
  for(int r=0;r<16;++r){int kv=kb+(r&3)+8*(r>>2); if(kv>qrel)p0[r]=NEG; if(kv+32>qrel)p1[r]=NEG;}
}

constexpr int NSLOT=3, SLOTB=8192;
constexpr int LDS_K=0, LDS_V=NSLOT*SLOTB, LDS_WS=2*NSLOT*SLOTB, LDS_OST=LDS_WS+NW*64*4, LDS_BYTES=LDS_OST+NW*4096;
constexpr float C2=0.125f*1.4426950408889634f;
__device__ __forceinline__ void glds16(const void*gsrc,unsigned lds_dst){unsigned keep;
  asm volatile("s_mov_b32 %0, m0\n\ts_mov_b32 m0, %2\n\ts_nop 0\n\tglobal_load_lds_dwordx4 %1, off\n\ts_mov_b32 m0, %0":"=&s"(keep):"v"(gsrc),"s"(lds_dst):"memory");}
__device__ __forceinline__ float max3f(float a,float b,float c){float r;asm("v_max3_f32 %0, %1, %2, %3":"=v"(r):"v"(a),"v"(b),"v"(c));return r;}
__device__ __forceinline__ float max2f(float a,float b){float r;asm("v_max_f32_e32 %0, %1, %2":"=v"(r):"v"(a),"v"(b));return r;}
__device__ __forceinline__ float fadd_s(float a,float b){float r;asm("v_add_f32_e32 %0, %1, %2":"=v"(r):"v"(a),"v"(b));return r;}
__device__ __forceinline__ float fsub_s(float a,float b){float r;asm("v_sub_f32_e32 %0, %1, %2":"=v"(r):"v"(a),"v"(b));return r;}
typedef float f32x2_t __attribute__((ext_vector_type(2))); typedef __bf16 bf16x2_t __attribute__((ext_vector_type(2)));
__device__ __forceinline__ unsigned cvtpk_s(float lo,float hi){f32x2_t v={lo,hi};bf16x2_t b=__builtin_convertvector(v,bf16x2_t);return __builtin_bit_cast(unsigned,b);}
#define WAIT_BAR(N) asm volatile("s_waitcnt vmcnt(" #N ") lgkmcnt(0)\n\ts_barrier":::"memory")

__device__ __forceinline__ void qkt(f32x16&p0,f32x16&p1,const char*Kslot,const bf16x8*qr,const f32x16&negm,int r32,int hi){
  const char*kb=Kslot+hi*1024+r32*16;
  #pragma unroll
  for(int d0=0;d0<4;++d0){
    const bf16x8 b0=*reinterpret_cast<const bf16x8*>(kb+d0*2048);
    const bf16x8 b1=*reinterpret_cast<const bf16x8*>(kb+d0*2048+512);
    if(d0==0){p0=__builtin_amdgcn_mfma_f32_32x32x16_bf16(b0,qr[0],negm,0,0,0);p1=__builtin_amdgcn_mfma_f32_32x32x16_bf16(b1,qr[0],negm,0,0,0);}
    else{p0=__builtin_amdgcn_mfma_f32_32x32x16_bf16(b0,qr[d0],p0,0,0,0);p1=__builtin_amdgcn_mfma_f32_32x32x16_bf16(b1,qr[d0],p1,0,0,0);}}
}
typedef __attribute__((address_space(3))) const char* lds_cptr;
typedef short v4i16_t __attribute__((ext_vector_type(4)));
__device__ __forceinline__ void kload8(bf16x8*kf,lds_cptr kp){
  kf[0]=*(const __attribute__((address_space(3))) bf16x8*)(kp);      kf[1]=*(const __attribute__((address_space(3))) bf16x8*)(kp+512);
  kf[2]=*(const __attribute__((address_space(3))) bf16x8*)(kp+2048); kf[3]=*(const __attribute__((address_space(3))) bf16x8*)(kp+2560);
  kf[4]=*(const __attribute__((address_space(3))) bf16x8*)(kp+4096); kf[5]=*(const __attribute__((address_space(3))) bf16x8*)(kp+4608);
  kf[6]=*(const __attribute__((address_space(3))) bf16x8*)(kp+6144); kf[7]=*(const __attribute__((address_space(3))) bf16x8*)(kp+6656);
}
__device__ __forceinline__ void kload2(bf16x8*kf,lds_cptr kp,int j){ kf[2*j]=*(const __attribute__((address_space(3))) bf16x8*)(kp+j*2048); kf[2*j+1]=*(const __attribute__((address_space(3))) bf16x8*)(kp+j*2048+512); }
__device__ __forceinline__ s16x4 vtr(lds_cptr p){ return __builtin_bit_cast(s16x4,__builtin_amdgcn_ds_read_tr16_b64_v4i16((__attribute__((address_space(3))) v4i16_t*)p)); }
__device__ __forceinline__ float rowmax(const f32x16&p0,const f32x16&p1){
  float a=max3f(p0[0],p0[1],p1[0]),b=max3f(p0[2],p0[3],p1[1]);a=max3f(a,p1[2],p1[3]);
  #pragma unroll
  for(int r=4;r<16;r+=4){a=max3f(a,p0[r],p0[r+1]);b=max3f(b,p0[r+2],p0[r+3]);a=max3f(a,p1[r],p1[r+1]);b=max3f(b,p1[r+2],p1[r+3]);}
  const float m=max2f(a,b);
  auto rr=__builtin_amdgcn_permlane32_swap(__float_as_uint(m),__float_as_uint(m),false,false);
  return max2f(__uint_as_float(rr[0]),__uint_as_float(rr[1]));
}
__device__ __forceinline__ void pv(f32x16*o,int vb,bf16x8 pa0,bf16x8 pa1,bf16x8 pa2,bf16x8 pa3){
  #pragma unroll
  for(int d0=0;d0<2;++d0){s16x4 lo[4],hi[4];
    #pragma unroll
    for(int ks=0;ks<4;++ks){
      asm volatile("ds_read_b64_tr_b16 %0,%1 offset:%c2":"=&v"(lo[ks]):"v"(vb),"i"(d0*4096+ks*1024):"memory");
      asm volatile("ds_read_b64_tr_b16 %0,%1 offset:%c2":"=&v"(hi[ks]):"v"(vb),"i"(d0*4096+ks*1024+512):"memory");}
    asm volatile("s_waitcnt lgkmcnt(0)":::"memory");SBAR();
    #define PK(k) (bf16x8){lo[k][0],lo[k][1],lo[k][2],lo[k][3],hi[k][0],hi[k][1],hi[k][2],hi[k][3]}
    o[d0]=__builtin_amdgcn_mfma_f32_32x32x16_bf16(pa0,PK(0),o[d0],0,0,0);
    o[d0]=__builtin_amdgcn_mfma_f32_32x32x16_bf16(pa1,PK(1),o[d0],0,0,0);
    o[d0]=__builtin_amdgcn_mfma_f32_32x32x16_bf16(pa2,PK(2),o[d0],0,0,0);
    o[d0]=__builtin_amdgcn_mfma_f32_32x32x16_bf16(pa3,PK(3),o[d0],0,0,0);
    #undef PK
  }
}

#ifndef ATTN_STORE16
#define ATTN_STORE16(p,v) (*(u32x4*)(p)=(v))
#endif
template<int THRL> __device__ __forceinline__ void attn_unit(int b,int h,int qb,const bf16*Q,const bf16*K,const bf16*V,bf16*O,char*shm,const int tid){
  const int lane=tid&63,r32=lane&31,hi=lane>>5; const int wid=__builtin_amdgcn_readfirstlane(tid>>6);
  const long rowbase=(long)b*SEQ; const int q0=qb*QB;
  const bf16*Qw=Q+(((long)b*NHEAD+h)*SEQ+q0+wid*QBLK)*QP;
  const bf16*Kh=K+((long)b*NKV+(h>>2))*SEQ*KP,*Vh=V+((long)b*NKV+(h>>2))*SEQ*VP;
  const unsigned lds0=(unsigned)(uintptr_t)shm;
  float*wsf=(float*)(shm+LDS_WS)+wid*64;
  const bf16*ksrc=Kh+(long)lane*KP+wid*8;
  const bf16*vsrc=Vh+(long)(16*(wid&3)+(lane>>2))*VP+(wid>>2)*32+(lane&3)*8;
  const unsigned kdst=lds0+LDS_K+wid*1024, vdst=lds0+LDS_V+wid*1024;
  #define DMA_K(t,slot) glds16(ksrc+(long)(t)*KVBLK*KP,(unsigned)__builtin_amdgcn_readfirstlane(kdst+(slot)))
  #define DMA_V(t,slot) glds16(vsrc+(long)(t)*KVBLK*VP,(unsigned)__builtin_amdgcn_readfirstlane(vdst+(slot)))
  const int vb0=(int)(lds0+LDS_V)+((lane>>4)&1)*32+(lane&3)*8+(4*hi+((lane&15)>>2))*64;
  const char*Kbase=shm+LDS_K; bf16x8 kf[8];
  const lds_cptr shm3=(lds_cptr)shm; const lds_cptr kp0=shm3+LDS_K+hi*1024+r32*16; const lds_cptr vp0=shm3+LDS_V+((lane>>4)&1)*32+(lane&3)*8+(4*hi+((lane&15)>>2))*64;
  const int NT=SEQ/KVBLK;
  DMA_K(0,0);DMA_V(0,0);DMA_K(1,SLOTB);
  bf16x8 qr[4];
  #pragma unroll
  for(int d0=0;d0<4;++d0)qr[d0]=*reinterpret_cast<const bf16x8*>(&Qw[(long)r32*QP+d0*16+hi*8]);
  float mhat=0.f,l_reg=0.f;f32x16 o[2],negm;{float z0=(float)(tid>>12);asm volatile("":"+v"(z0));
  _Pragma("unroll") for(int r=0;r<16;++r){o[0][r]=z0;o[1][r]=z0;negm[r]=z0;}}asm volatile("":"+v"(negm));
  const int qrel=wid*QBLK+r32;
  #define CMASK(P0,P1,t) do{}while(0)
  bool resc=false;
  #define START(P0,P1) do{ const float rm=rowmax(P0,P1); resc=false; \
    { const float dl=rm; mhat=fadd_s(mhat,dl); \
      _Pragma("unroll") for(int r=0;r<16;++r){P0[r]=fsub_s(P0[r],dl);P1[r]=fsub_s(P1[r],dl);} \
      _Pragma("unroll") for(int r=0;r<16;++r)negm[r]=-mhat; asm volatile("":"+v"(negm)); } \
    _Pragma("unroll") for(int r=0;r<16;++r)P0[r]=__builtin_amdgcn_exp2f(P0[r]); }while(0)
  #define RESC() do{ if(resc){ asm volatile("s_waitcnt lgkmcnt(0)":::"memory"); \
      _Pragma("unroll") for(int d_=0;d_<2;++d_) _Pragma("unroll") for(int r=0;r<16;++r)o[d_][r]*=wsf[crow(r,hi)]; } }while(0)
  f32x16 pA0,pA1,pB0,pB1;
  int sl_prev=0,sl_cur=0,sl_next=SLOTB;
  #define ROT() do{sl_prev=sl_cur;sl_cur=sl_next;sl_next=(sl_next==(NSLOT-1)*SLOTB)?0:sl_next+SLOTB;}while(0)
  DMA_K(2,2*SLOTB);
  WAIT_BAR(3);
  qkt(pA0,pA1,Kbase,qr,negm,r32,hi);asm volatile("s_nop 15\n\ts_nop 7":"+v"(pA0),"+v"(pA1));CMASK(pA0,pA1,0);
  START(pA0,pA1);
  _Pragma("unroll") for(int r=0;r<16;++r)pA1[r]=__builtin_amdgcn_exp2f(pA1[r]);
  WAIT_BAR(0);
  DMA_K(3,0);DMA_V(1,SLOTB);
  ROT();
  kload8(kf,kp0+sl_cur);
  WAIT_BAR(2);
  s16x4 vlo[8],vhi[8]; u32x4 pw0,pw1,pw2,pw3;
  #define PKW(P,B) cvtpk_s(P[B],P[B+1])
  #define PAF(k) __builtin_bit_cast(bf16x8,pw##k)
  #define VFR(i) (bf16x8){vlo[i][0],vlo[i][1],vlo[i][2],vlo[i][3],vhi[i][0],vhi[i][1],vhi[i][2],vhi[i][3]}
  #define PIN(x) asm volatile("":"+v"(x))
  #define MX3(a,b,c) __builtin_fmaxf(__builtin_fmaxf((a),(b)),(c))
  #define GAPA(MF,A0,A1,A2,A3,W0,W1,PW) do{ MF; sacc+=A0; sacc+=A1; sacc+=A2; sacc+=A3; PIN(sacc); W0; W1; PIN(PW); SBAR(); }while(0)
  #define EX(v) __builtin_amdgcn_exp2f(v)
  #define GAPB(MF,X,B) do{ MF; X[B]=EX(X[B]); X[B+1]=EX(X[B+1]); X[B+2]=EX(X[B+2]); X[B+3]=EX(X[B+3]); PIN(X); SBAR(); }while(0)
  #define VRD(i) do{ vlo[i]=vtr(vp_+(((i)>>2)*4096+((i)&3)*1024)); vhi[i]=vtr(vp_+(((i)>>2)*4096+((i)&3)*1024+512)); }while(0)
  #define KRD(G,j) do{ if(G){ kload2(kf,kp0+sl_next,j); SBAR(); } }while(0)
  #define STEP(C0,C1,P0,P1,t,GK,GV,GL) do{ SBAR(); \
    const lds_cptr vp_=vp0+sl_prev; \
    VRD(0); SBAR(); float sacc=(P0[0]+P0[1]); \
    GAPA(C0=__builtin_amdgcn_mfma_f32_32x32x16_bf16(kf[0],qr[0],negm,0,0,0), P0[2],P0[3],P0[4],P0[5],     pw0[0]=PKW(P0,0), pw0[1]=PKW(P0,2), pw0); \
    VRD(4); SBAR(); GAPA(C1=__builtin_amdgcn_mfma_f32_32x32x16_bf16(kf[1],qr[0],negm,0,0,0), P0[6],P0[7],P0[8],P0[9],     pw0[2]=PKW(P0,4), pw0[3]=PKW(P0,6), pw0); \
    VRD(1); SBAR(); GAPA(C0=__builtin_amdgcn_mfma_f32_32x32x16_bf16(kf[2],qr[1],C0,0,0,0),   P0[10],P0[11],P0[12],P0[13], pw1[0]=PKW(P0,8), pw1[1]=PKW(P0,10), pw1); \
    VRD(5); SBAR(); GAPA(C1=__builtin_amdgcn_mfma_f32_32x32x16_bf16(kf[3],qr[1],C1,0,0,0),   P0[14],P0[15],P1[0],P1[1],   pw1[2]=PKW(P0,12),pw1[3]=PKW(P0,14), pw1); \
    VRD(2); SBAR(); GAPA(C0=__builtin_amdgcn_mfma_f32_32x32x16_bf16(kf[4],qr[2],C0,0,0,0),   P1[2],P1[3],P1[4],P1[5],     pw2[0]=PKW(P1,0), pw2[1]=PKW(P1,2), pw2); \
    VRD(6); SBAR(); GAPA(C1=__builtin_amdgcn_mfma_f32_32x32x16_bf16(kf[5],qr[2],C1,0,0,0),   P1[6],P1[7],P1[8],P1[9],     pw2[2]=PKW(P1,4), pw2[3]=PKW(P1,6), pw2); \
    VRD(3); SBAR(); GAPA(C0=__builtin_amdgcn_mfma_f32_32x32x16_bf16(kf[6],qr[3],C0,0,0,0),   P1[10],P1[11],P1[12],P1[13], pw3[0]=PKW(P1,8), pw3[1]=PKW(P1,10), pw3); \
    VRD(7); SBAR(); GAPA(C1=__builtin_amdgcn_mfma_f32_32x32x16_bf16(kf[7],qr[3],C1,0,0,0),   P1[14],P1[15],0.f,0.f,       pw3[2]=PKW(P1,12),pw3[3]=PKW(P1,14), pw3); \
    l_reg+=sacc; \
    if(GK){DMA_K((t)+3,sl_cur);} if(GV){DMA_V((t)+1,sl_next);} \
    CMASK(C0,C1,t); \
    { float a=MX3(C0[0],C0[1],C1[0]),b=MX3(C0[2],C0[3],C1[1]); a=MX3(a,C1[2],C1[3]); \
      _Pragma("unroll") for(int r=4;r<16;r+=4){a=MX3(a,C0[r],C0[r+1]);b=MX3(b,C0[r+2],C0[r+3]);a=MX3(a,C1[r],C1[r+1]);b=MX3(b,C1[r+2],C1[r+3]);} \
      float rm=__builtin_fmaxf(a,b); { auto rr=__builtin_amdgcn_permlane32_swap(__float_as_uint(rm),__float_as_uint(rm),false,false); rm=__builtin_fmaxf(__uint_as_float(rr[0]),__uint_as_float(rr[1])); } \
      resc=false; \
      if(__builtin_expect(__any(rm>(float)THRL),0)){ const float dl=__builtin_fmaxf(rm,0.f); mhat+=dl; \
        _Pragma("unroll") for(int r=0;r<16;++r){C0[r]-=dl;C1[r]-=dl;} \
        _Pragma("unroll") for(int r=0;r<16;++r)negm[r]=-mhat; asm volatile("":"+v"(negm)); \
        const float f=__builtin_amdgcn_exp2f(-dl); l_reg*=f; if(hi==0)wsf[r32]=f; resc=true; } } \
    SBAR(); \
    GAPB(o[0]=__builtin_amdgcn_mfma_f32_32x32x16_bf16(PAF(0),VFR(0),o[0],0,0,0), C0,0); \
    GAPB(o[1]=__builtin_amdgcn_mfma_f32_32x32x16_bf16(PAF(0),VFR(4),o[1],0,0,0), C0,4); \
    KRD(GL,0); GAPB(o[0]=__builtin_amdgcn_mfma_f32_32x32x16_bf16(PAF(1),VFR(1),o[0],0,0,0), C0,8); \
    KRD(GL,1); GAPB(o[1]=__builtin_amdgcn_mfma_f32_32x32x16_bf16(PAF(1),VFR(5),o[1],0,0,0), C0,12); \
    KRD(GL,2); GAPB(o[0]=__builtin_amdgcn_mfma_f32_32x32x16_bf16(PAF(2),VFR(2),o[0],0,0,0), C1,0); \
    KRD(GL,3); GAPB(o[1]=__builtin_amdgcn_mfma_f32_32x32x16_bf16(PAF(2),VFR(6),o[1],0,0,0), C1,4); \
    GAPB(o[0]=__builtin_amdgcn_mfma_f32_32x32x16_bf16(PAF(3),VFR(3),o[0],0,0,0), C1,8); \
    GAPB(o[1]=__builtin_amdgcn_mfma_f32_32x32x16_bf16(PAF(3),VFR(7),o[1],0,0,0), C1,12); \
    }while(0)
  int t=1;
  #undef CMASK
  #define CMASK(P0,P1,t) do{}while(0)
  for(;t+5<NT;t+=2){
    STEP(pB0,pB1,pA0,pA1,t,true,true,true);     WAIT_BAR(2); RESC(); ROT();
    STEP(pA0,pA1,pB0,pB1,t+1,true,true,true);   WAIT_BAR(2); RESC(); ROT();
  }
  #undef CMASK
  #define CMASK(P0,P1,t) do{}while(0)
  #define ENDW(tt) do{ if((tt)+3<NT){WAIT_BAR(2);} else if((tt)+2<NT){WAIT_BAR(1);} else {WAIT_BAR(0);} }while(0)
  for(;t+1<NT;t+=2){
    STEP(pB0,pB1,pA0,pA1,t,(t+3<NT),(t+1<NT),(t+1<NT));       ENDW(t);   RESC(); ROT();
    STEP(pA0,pA1,pB0,pB1,t+1,(t+4<NT),(t+2<NT),(t+2<NT));     ENDW(t+1); RESC(); ROT();
  }
  STEP(pB0,pB1,pA0,pA1,NT-1,false,false,false); RESC();
  { float sacc=pB0[0]+pB0[1]; _Pragma("unroll") for(int r=2;r<16;++r)sacc+=pB0[r]; _Pragma("unroll") for(int r=0;r<16;++r)sacc+=pB1[r]; l_reg+=sacc;
    pw0=(u32x4){PKW(pB0,0),PKW(pB0,2),PKW(pB0,4),PKW(pB0,6)};pw1=(u32x4){PKW(pB0,8),PKW(pB0,10),PKW(pB0,12),PKW(pB0,14)};pw2=(u32x4){PKW(pB1,0),PKW(pB1,2),PKW(pB1,4),PKW(pB1,6)};pw3=(u32x4){PKW(pB1,8),PKW(pB1,10),PKW(pB1,12),PKW(pB1,14)};
    SBAR(); pv(o,vb0+sl_cur,PAF(0),PAF(1),PAF(2),PAF(3)); }
  #undef PKW
  #undef PAF
  #undef VFR
  #undef PIN
  #undef MX3
  #undef GAPA
  #undef GAPB
  #undef EX
  #undef VRD
  #undef KRD
  #undef STEP
  #undef ENDW
  {auto rr=__builtin_amdgcn_permlane32_swap(__float_as_uint(l_reg),__float_as_uint(l_reg),false,false);l_reg=__uint_as_float(rr[0])+__uint_as_float(rr[1]);}
  if(hi==0)wsf[32+r32]=l_reg;asm volatile("s_waitcnt lgkmcnt(0)":::"memory");
  float rli[16];
  #pragma unroll
  for(int r=0;r<16;++r)rli[r]=__builtin_amdgcn_rcpf(wsf[32+crow(r,hi)]);
  bf16*Ow=O+(rowbase+q0+wid*QBLK)*OP+h*D;
  { bf16*stg=(bf16*)(shm+LDS_OST)+wid*2048;
    #pragma unroll
    for(int r=0;r<16;++r){const int orow=crow(r,hi);
      #pragma unroll
      for(int d0=0;d0<2;++d0)stg[orow*64+d0*32+r32]=__float2bfloat16(o[d0][r]*rli[r]);}
    asm volatile("s_waitcnt lgkmcnt(0)":::"memory");
    #pragma unroll
    for(int i=0;i<4;++i){const int row=i*8+(lane>>3),ch=lane&7; const u32x4 v=*(const u32x4*)(stg+row*64+ch*8); ATTN_STORE16(Ow+(long)row*OP+ch*8,v);} }
  asm volatile("s_waitcnt lgkmcnt(0)\n\ts_barrier":::"memory");
  #undef DMA_K
  #undef DMA_V
  #undef CMASK
  #undef START
  #undef RESC
  #undef ROT
}
constexpr int ATTN_LDS_BYTES=LDS_BYTES;
__device__ __forceinline__ void attn_phase_dense(char*lds,const bf16*Q,const bf16*K,const bf16*V,bf16*O,int vcu,int G,const int tid){
  for(int u=vcu;u<512;u+=G){ const int x=u>>6, j=u&63; attn_unit<8>(x>>1, 4*(x&1)+(j>>4), j&15, Q,K,V,O,lds,tid); }
}
#undef SBAR
#undef WAIT_BAR
}

constexpr int STEPS_PER_LAYER = 7;
constexpr int NPHASES = 1 + DEPTH * STEPS_PER_LAYER + 1;

__global__ void __launch_bounds__(NT, 2) mk_fwd(Args args) {
    extern __shared__ __attribute__((aligned(16))) unsigned char lds_raw[];
    Ctx c0;
    c0.lds = (LAS unsigned char*)lds_raw;
    c0.tid = threadIdx.x; c0.lane = c0.tid & 63; c0.wave = __builtin_amdgcn_readfirstlane(c0.tid >> 6);
    c0.G = gridDim.x; { const int bx = blockIdx.x; c0.vcu = (c0.G % 8 == 0) ? (bx % 8) * (c0.G / 8) + bx / 8 : bx; }
    volatile LAS unsigned* misc = (volatile LAS unsigned*)(c0.lds + LDS_BYTES - 64);
    if (c0.tid < 16) misc[c0.tid] = 0u;
    if (c0.tid < 25) { const unsigned long long v = (c0.tid < 23) ? (unsigned long long)args.in[c0.tid] : (c0.tid == 23 ? (unsigned long long)args.out : (unsigned long long)args.ws);
        volatile LAS unsigned* p = (volatile LAS unsigned*)(c0.lds + ARGS_OFF) + 2 * c0.tid; p[0] = (unsigned)v; p[1] = (unsigned)(v >> 32); }
    __syncthreads();
    const int ph_lo = args.ph_lo, ph_hi = args.ph_hi;
    XcdBarrier bar; bar.bar = nullptr; bar.x = 0; bar.st = misc;
    const bool multi = (ph_hi - ph_lo) > 1;
    bool vid_done = false; c0.vid = c0.vcu;
    if (multi) bar = xcd_barrier_post((unsigned*)((unsigned char*)inp(c0, 24) + WS_CTL) + 4096, misc);

    for (int pc = 2 * ph_lo; pc < 2 * ph_hi; ++pc) {
        const int ph = pc >> 1, rep = pc & 1;
        const int st_ = (ph == 0) ? 20 : ((ph == NPHASES - 1) ? 21 : (ph - 1) % STEPS_PER_LAYER);
        if (rep && (st_ != PROBE_STEP || (PROBE_PARITY >= 0 && st_ < 20 && (((ph - 1) / STEPS_PER_LAYER) & 1) != PROBE_PARITY))) continue;
        if (pc > 2 * ph_lo) {
            xcd_barrier(bar);
            if (PROBE_STEP == 30) { xcd_barrier(bar); xcd_barrier(bar); xcd_barrier(bar); }
            if (!vid_done) {
                if (c0.tid == 0) { unsigned before = 0u;
#pragma unroll
                    for (unsigned j = 0; j < 16; ++j) { const unsigned n = xb_ld(&bar.bar[XB_XCNT(j)]); before += (j < bar.x) ? n : 0u; }
                    misc[3] = before + misc[2]; }
                __syncthreads();
                c0.vid = __builtin_amdgcn_readfirstlane((int)misc[3]); vid_done = true;
            }
        }
        Ctx c = c0;
        int zero_ = 0;
        asm volatile("" : "+s"(c.wave), "+s"(c.vcu), "+s"(c.vid), "+s"(zero_));
        c.lane = (int)__builtin_amdgcn_mbcnt_hi(~0u, __builtin_amdgcn_mbcnt_lo(~0u, (unsigned)zero_)); c.tid = c.wave * 64 + c.lane;
        unsigned char* ws = (unsigned char*)inp(c, 24);
#define xres ((float*)(ws + WS_XRES))
#define hb ((bf16*)(ws + WS_HB))
#define ycat ((bf16*)(ws + WS_YCAT))
#define z ((float*)(ws + WS_Z))
#define qp ((bf16*)(ws + WS_QP))
#define qb ((bf16*)(ws + WS_QB))
#define kb ((bf16*)(ws + WS_KB))
#define vt ((bf16*)(ws + WS_VT))
#define glu ((float*)(ws + WS_GLU))
#define vn ((bf16*)(ws + WS_VN))
#define eidx ((int*)(ws + WS_EIDX))
#define gate ((float*)(ws + WS_GATE))
#define rope ((const float*)(ws + WS_ROPE))
#define SSQA(l_) ((float*)(ws + WS_SSQ) + (size_t)(l_) * T * 8)
#define SSQB(l_) ((float*)(ws + WS_SSQ) + (size_t)5 * T * 8 + (size_t)(l_) * T * 16)
        if (ph == 0) phase_prologue(c, ws);
        else if (ph == NPHASES - 1) phase_final(c, xres, inp(c, 3), (float*)inp(c, 23));
        else {
            const int l = (ph - 1) / STEPS_PER_LAYER, st = (ph - 1) % STEPS_PER_LAYER, i = l >> 1; const bool odd = l & 1;
            switch (st) {
            case 0: { pg8::Gemm g{hb, (const bf16*)(ws + WS_WIN) + (size_t)l * NIN * D, T, NIN, D}; pg8::StaticOrder S; S.init(T, NIN, c.G, (int)blockIdx.x);
                if (!odd) { pg8::EpiEven E{SSQA(l), rope, glu, qb, kb, vt}; pg8::gemm_phase<pg8::EpiEven, pg8::StaticOrder, true, true>(c.lds, g, S, E, c.tid); }
                else { pg8::EpiOdd E{SSQA(l), rope + (size_t)2 * SEQ * 32, inp(c, 13) + i * 64, inp(c, 14) + i * 64, glu, vn, (float*)(ws + WS_LNP), qb, kb, vt, c.lane};
                       pg8::gemm_phase<pg8::EpiOdd, pg8::StaticOrder, true, true>(c.lds, g, S, E, c.tid); } } break;
            case 1:
                if (!odd) {
                    for (int it = c.vcu; it < 512; it += c.G) attn_item<true>(c, it, qb, kb, vt, ycat, 512, inp(c, 10) + i * 8);
                    for (int it = c.vcu; it < 512; it += c.G) conv_item(c, it, glu, inp(c, 6) + (size_t)i * 31 * 512, inp(c, 7) + i * 512, inp(c, 8) + i * 512, inp(c, 9) + i * 512, ycat);
                } else {
                    attn_body::attn_phase_dense((char*)lds_raw, (const __hip_bfloat16*)qb, (const __hip_bfloat16*)kb, (const __hip_bfloat16*)vt, (__hip_bfloat16*)ycat, c.vcu, c.G, c.tid);
                    for (int it = c.vcu; it < 512; it += c.G) sgu_item(c, it, inp(c, 17) + (size_t)i * 4 * 128 * 128, inp(c, 18) + i * 512, vn, (const float*)(ws + WS_LNP), inp(c, 15) + i * 512, inp(c, 16) + i * 512, glu, ycat);
                }
                break;
            case 2: { pg8::Gemm g{ycat, (const bf16*)(ws + WS_WOUT) + (size_t)l * D * D, T, D, D}; pg8::StaticOrder S; S.init(T, D, c.G, (int)blockIdx.x);
                if (rep) { pg8::EpiF32 E{z, D, nullptr}; pg8::gemm_phase<pg8::EpiF32, pg8::StaticOrder, true, true>(c.lds, g, S, E, c.tid); }
                else { pg8::EpiRes E{D, hb, SSQB(l), ws + WS_X8}; pg8::gemm_phase<pg8::EpiRes, pg8::StaticOrder, false, true>(c.lds, g, S, E, c.tid); } } break;
            case 3: { pg8::Gemm g{hb, (const bf16*)(ws + WS_WQ) + (size_t)l * D * D, T, D, D}; pg8::StaticOrder S; S.init(T, D, c.G, (int)blockIdx.x); pg8::EpiBf16Scale E{qp, D, SSQB(l)};
                pg8::gemm_phase<pg8::EpiBf16Scale, pg8::StaticOrder, true, true>(c.lds, g, S, E, c.tid);
                pg8::Unit u;
                for (int ui = 0; S.next(ui, u); ++ui) {
                    const bf16* skl = (const bf16*)(ws + WS_SK) + (size_t)l * 16 * 128 * 64;
                    __syncthreads();
#pragma unroll
                    for (int i2 = 0; i2 < 8; ++i2) { const int idx = c.tid + NT * i2, row = idx >> 3, ch = idx & 7;
                        *(LAS u32x4*)(c.lds + row * 144 + ch * 16) = *(const u32x4*)(skl + (size_t)(2 * u.pn) * 2 * 128 * 64 + (size_t)row * 64 + ch * 8); }
                    __syncthreads();
                    for (int hh = 0; hh < 2; ++hh) route_item(c, u.pm * 8 + 2 * u.pn + hh, qp, skl, eidx, gate, false, hh * 256 * 144);
                } } break;
            case 4: { const int lg = __builtin_ctz(c.G) - 3, nq = 1 << lg, q = c.vid >> lg, rq = c.vid & (nq - 1);
                gu_wave(c, q, rq * NWAVES + c.wave, nq * NWAVES, ws + WS_X8, eidx, ws + WS_UB + (size_t)l * PEER_E * D, (bf16*)z, rep ? DEPTH : l + 1, inp(c, 21), inp(c, 22), inp(c, 2), ws); } break;
            case 5: phase_w(c, (const bf16*)z, eidx, gate, (const float*)(ws + WS_SCL) + (size_t)l * PEER_E, (const float*)(ws + WS_SCL) + (size_t)(DEPTH + l) * PEER_E, SSQB(l), (float*)(ws + WS_WB)); break;
            case 6: { const int lg = __builtin_ctz(c.G) - 3, nq = 1 << lg, q = c.vid >> lg, rq = c.vid & (nq - 1);
                gv_wave(c, q, rq * NWAVES + c.wave, nq * NWAVES, eidx, (const float*)(ws + WS_WB), ws + WS_VB + (size_t)l * PEER_E * D, rep ? PROBE_EMASK : -1, hb, (!rep && l == DEPTH - 1) ? xres : nullptr, rep ? nullptr : SSQA(l + 1)); } break;
            }
        }
    }
}
#undef xres
#undef hb
#undef ycat
#undef z
#undef qp
#undef qb
#undef kb
#undef vt
#undef glu
#undef vn
#undef eidx
#undef gate
#undef rope
#undef SSQA
#undef SSQB
}

extern "C" void kernel_launch(void* const* d_in, const int* in_sizes, int n_in, void* d_out, int out_size, void* d_ws, size_t ws_size, hipStream_t stream) {
    static int grid = 0;
    if (grid == 0) {
        if (n_in != 23 || out_size != T * D || ws_size < WS_END) { fprintf(stderr, "kernel_launch: unexpected shapes n_in %d out %d ws %zu (need %zu)\n", n_in, out_size, ws_size, (size_t)WS_END); grid = -1; return; }
        int dev = 0, cus = 0;
        if (hipGetDevice(&dev) != hipSuccess || hipDeviceGetAttribute(&cus, hipDeviceAttributeMultiprocessorCount, dev) != hipSuccess) { grid = -1; return; }
        if (hipFuncSetAttribute((const void*)mk_fwd, hipFuncAttributeMaxDynamicSharedMemorySize, LDS_BYTES) != hipSuccess) { fprintf(stderr, "kernel_launch: hipFuncSetAttribute failed\n"); grid = -1; return; }
        (void)hipGetLastError();
        grid = 8; while (grid * 2 <= cus) grid *= 2;
    }
    if (grid < 0) return;
    (void)hipMemsetAsync((char*)d_ws + WS_CTL, 0, 1 * MiB, stream);
    Args a{};
    for (int i = 0; i < 23; ++i) a.in[i] = (const float*)d_in[i];
    a.out = (float*)d_out; a.ws = (unsigned char*)d_ws;
#if MK_ONE_LAUNCH
    a.ph_lo = 0; a.ph_hi = NPHASES;
    hipLaunchKernelGGL(mk_fwd, dim3(grid), dim3(NT), LDS_BYTES, stream, a);
#else
    for (int p = 0; p < NPHASES; ++p) { a.ph_lo = p; a.ph_hi = p + 1; hipLaunchKernelGGL(mk_fwd, dim3(grid), dim3(NT), LDS_BYTES, stream, a); }
#endif
}
```

```cpp
#include <hip/hip_runtime.h>
#include <hip/hip_bf16.h>
#include <cmath>
#include <cstdio>
#include <cstdint>

#ifndef MK_ONE_LAUNCH
#define MK_ONE_LAUNCH 1
#endif
#ifndef PROBE_EMASK
#define PROBE_EMASK -1
#endif
#ifndef PROBE_PARITY
#define PROBE_PARITY -1
#endif
#ifndef PROBE_LITE
#define PROBE_LITE 0
#endif
#ifndef PROBE_STEP
#define PROBE_STEP -1
#endif

namespace {
constexpr int D = 1024, BATCH = 4, SEQ = 4096, T = BATCH * SEQ, DEPTH = 4;
constexpr int NIN = 1792, HD = 64, NQH = 8, NKVH = 2;
constexpr int PEER_E = 16384;
constexpr float EPS = 1e-6f;
constexpr float LOG2E = 1.4426950408889634f;
constexpr int NWAVES = 8, NT = NWAVES * 64;

constexpr size_t MiB = 1u << 20;
constexpr size_t WS_CTL = 0;
constexpr size_t WS_XRES = 1 * MiB;
constexpr size_t WS_HB = WS_XRES + 64 * MiB;
constexpr size_t WS_YCAT = WS_HB + 32 * MiB;
constexpr size_t WS_Z = WS_YCAT + 32 * MiB;
constexpr size_t WS_QP = WS_Z + 128 * MiB;
constexpr size_t WS_QB = WS_QP + 32 * MiB;
constexpr size_t WS_KB = WS_QB + 16 * MiB;
constexpr size_t WS_VT = WS_KB + 4 * MiB;
constexpr size_t WS_GLU = WS_VT + 4 * MiB;
constexpr size_t WS_VN = WS_GLU + 32 * MiB;
constexpr size_t WS_EIDX = WS_VN + 16 * MiB;
constexpr size_t WS_GATE = WS_EIDX + 8 * MiB;
constexpr size_t WS_WIN = WS_GATE + 8 * MiB;
constexpr size_t WS_WOUT = WS_WIN + 14 * MiB;
constexpr size_t WS_WQ = WS_WOUT + 8 * MiB;
constexpr size_t WS_SK = WS_WQ + 8 * MiB;
constexpr size_t WS_ROPE = WS_SK + 1 * MiB;
constexpr size_t WS_SCL = WS_ROPE + 2 * MiB;
constexpr size_t WS_X8 = WS_SCL + 1 * MiB;
constexpr size_t WS_SSQ = WS_X8 + 16 * MiB;
constexpr size_t WS_LNP = WS_SSQ + 8 * MiB;
constexpr size_t WS_WB = WS_LNP + 1 * MiB;
constexpr size_t WS_UB = WS_WB + 8 * MiB;
constexpr size_t WS_VB = WS_UB + 128 * MiB;
constexpr size_t WS_END = WS_VB + 128 * MiB;

constexpr int LDS_BYTES = 147456;

#define LAS __attribute__((address_space(3)))
typedef unsigned short bf16;
typedef short bf16x8 __attribute__((ext_vector_type(8)));
typedef float f32x4 __attribute__((ext_vector_type(4)));
typedef float f32x16 __attribute__((ext_vector_type(16)));
typedef unsigned u32x4 __attribute__((ext_vector_type(4)));
typedef unsigned u32x2 __attribute__((ext_vector_type(2)));
#define DI __device__ __forceinline__
#define MFMA32(a, b, c) __builtin_amdgcn_mfma_f32_32x32x16_bf16((a), (b), (c), 0, 0, 0)

typedef float f32x2 __attribute__((ext_vector_type(2)));
typedef __bf16 bf16x2_t __attribute__((ext_vector_type(2)));
DI unsigned f2bf(float f) { return (unsigned)__builtin_bit_cast(unsigned short, (__bf16)f); }
DI unsigned pk2(float lo, float hi) { const f32x2 v = {lo, hi}; return __builtin_bit_cast(unsigned, __builtin_convertvector(v, bf16x2_t)); }
DI float bf_lo(unsigned w) { return __uint_as_float(w << 16); }
DI float bf_hi(unsigned w) { return __uint_as_float(w & 0xffff0000u); }
DI float wave_sum(float v) {
#pragma unroll
    for (int o = 1; o < 64; o <<= 1) v += __shfl_xor(v, o);
    return v;
}
#define DPP_ADD(v, ctrl) ((v) + __builtin_bit_cast(float, __builtin_amdgcn_update_dpp(0, __builtin_bit_cast(int, (v)), (ctrl), 0xF, 0xF, true)))
DI float swap16_sum(float v) { const auto r = __builtin_amdgcn_permlane16_swap(__float_as_uint(v), __float_as_uint(v), false, false); return __uint_as_float(r[0]) + __uint_as_float(r[1]); }
DI float swap32_sum(float v) { const auto r = __builtin_amdgcn_permlane32_swap(__float_as_uint(v), __float_as_uint(v), false, false); return __uint_as_float(r[0]) + __uint_as_float(r[1]); }
DI float wave_sum_fast(float v) {
    v = DPP_ADD(v, 0xB1); v = DPP_ADD(v, 0x4E); v = DPP_ADD(v, 0x141); v = DPP_ADD(v, 0x140);
    v = swap16_sum(v); v = swap32_sum(v);
    return v;
}
DI float xor32f(float v, int lane) { const auto r = __builtin_amdgcn_permlane32_swap(__float_as_uint(v), __float_as_uint(v), false, false); return __uint_as_float((lane & 32) ? r[0] : r[1]); }
DI unsigned pack_i8x4(float a, float b, float c_, float d) {
    unsigned p = __builtin_amdgcn_cvt_pk_u8_f32(__builtin_rintf(a + 128.0f), 0, 0u);
    p = __builtin_amdgcn_cvt_pk_u8_f32(__builtin_rintf(b + 128.0f), 1, p);
    p = __builtin_amdgcn_cvt_pk_u8_f32(__builtin_rintf(c_ + 128.0f), 2, p);
    p = __builtin_amdgcn_cvt_pk_u8_f32(__builtin_rintf(d + 128.0f), 3, p);
    return p ^ 0x80808080u;
}
DI float sigmoidf_(float x) { return 1.0f / (1.0f + __expf(-x)); }
DI float gelu_tanh(float x) {
    const float u = 0.7978845608028654f * (x + 0.044715f * x * x * x);
    const float e = __expf(2.0f * u);
    const float th = 1.0f - 2.0f / (e + 1.0f);
    return 0.5f * x * (1.0f + th);
}
DI int crow(int reg, int h) { return (reg & 3) + 8 * (reg >> 2) + 4 * h; }

struct Args {
    const float* in[23];
    float* out;
    unsigned char* ws;
    int ph_lo, ph_hi;
};

struct Ctx {
    LAS unsigned char* lds;
    int tid, lane, wave, vcu, G, vid;
};
constexpr int ARGS_OFF = 147456 - 512;
DI const float* inp(const Ctx& c, int k) {
    volatile LAS unsigned* p = (volatile LAS unsigned*)(c.lds + ARGS_OFF) + 2 * k;
    const unsigned lo = __builtin_amdgcn_readfirstlane(p[0]), hi = __builtin_amdgcn_readfirstlane(p[1]);
    return (const float*)(const float __attribute__((address_space(1)))*)(((unsigned long long)hi << 32) | lo);
}

#define XB_TMO      128
#define XB_XCNT(j)  (256  + 64 * (j))
#define XB_XSUB(j)  (1280 + 64 * (j))
#define XB_XGEN(j)  (2304 + 64 * (j))
#define XB_TOP      3328
#define XB_TOPGEN   3392
#define XCD_BAR_WORDS 3456
#define XB_SPIN_CAP (1u << 22)
DI unsigned xb_ld(unsigned* p) { return __hip_atomic_load(p, __ATOMIC_RELAXED, __HIP_MEMORY_SCOPE_AGENT); }
DI unsigned xb_add(unsigned* p, unsigned v) { return __hip_atomic_fetch_add(p, v, __ATOMIC_RELAXED, __HIP_MEMORY_SCOPE_AGENT); }
DI unsigned xb_xcc_id() { return (unsigned)__builtin_amdgcn_s_getreg((3 << 11) | 20) & 0xFu; }
#define XB_SPIN(cond, bar) do { unsigned _sp = 0; while (cond) { __builtin_amdgcn_s_sleep(1); \
    if ((++_sp & 255u) == 0u) { if (xb_ld(&(bar)[XB_TMO])) break; if (_sp > XB_SPIN_CAP) { atomicAdd(&(bar)[XB_TMO], 1u); break; } } } } while (0)
struct XcdBarrier { unsigned* bar; unsigned x; volatile LAS unsigned* st; };
DI XcdBarrier xcd_barrier_post(unsigned* bar, volatile LAS unsigned* st) {
    XcdBarrier b; b.bar = bar; b.x = xb_xcc_id(); b.st = st;
    if (threadIdx.x == 0) st[2] = xb_add(&bar[XB_XCNT(b.x)], 1u);
    return b;
}
DI void xcd_barrier_complete(unsigned* bar, unsigned x, unsigned& nloc, unsigned& nx) {
    const unsigned G = gridDim.x * gridDim.y * gridDim.z;
    unsigned sum, cnt, mine, sp = 0u;
    for (;;) {
        sum = 0u; cnt = 0u; mine = 0u;
#pragma unroll
        for (unsigned j = 0; j < 16; ++j) { const unsigned c = xb_ld(&bar[XB_XCNT(j)]); sum += c; cnt += (c > 0u) ? 1u : 0u; mine = (j == x) ? c : mine; }
        if (sum == G) break;
        __builtin_amdgcn_s_sleep(1);
        if ((++sp & 255u) == 0u) { if (xb_ld(&bar[XB_TMO])) break; if (sp > XB_SPIN_CAP) { atomicAdd(&bar[XB_TMO], 1u); break; } }
    }
    nloc = mine > 0u ? mine : 1u; nx = cnt > 0u ? cnt : 1u;
}
DI void xcd_barrier(const XcdBarrier& b) {
    asm volatile("s_waitcnt vmcnt(0)" ::: "memory");
    __syncthreads();
    if (threadIdx.x == 0) {
        unsigned* bar = b.bar;
        __builtin_amdgcn_s_waitcnt(0);
        unsigned nloc = b.st[0], nx = b.st[1];
        if (nloc == 0u) { xcd_barrier_complete(bar, b.x, nloc, nx); b.st[0] = nloc; b.st[1] = nx; }
        const unsigned old = xb_add(&bar[XB_XSUB(b.x)], 1u);
        const unsigned gen = old / nloc;
        if (old + 1u == (gen + 1u) * nloc) {
            __builtin_amdgcn_fence(__ATOMIC_RELEASE, "agent");
            asm volatile("s_waitcnt vmcnt(0)" ::: "memory");
            const unsigned og = xb_add(&bar[XB_TOP], 1u);
            const unsigned tg = og / nx;
            if (og + 1u == (tg + 1u) * nx) xb_add(&bar[XB_TOPGEN], 1u);
            else XB_SPIN(xb_ld(&bar[XB_TOPGEN]) == tg, bar);
            __builtin_amdgcn_fence(__ATOMIC_ACQUIRE, "agent");
            xb_add(&bar[XB_XGEN(b.x)], 1u);
            asm volatile("s_waitcnt vmcnt(0)" ::: "memory");
        } else {
            XB_SPIN(xb_ld(&bar[XB_XGEN(b.x)]) == gen, bar);
            __builtin_amdgcn_fence(__ATOMIC_ACQUIRE, "agent");
            asm volatile("s_waitcnt vmcnt(0)" ::: "memory");
        }
    }
    __syncthreads();
}

DI int blkperm_even(int nb) {
    if (nb < 16) return 8 * (nb >> 2) + (nb & 3);
    if (nb < 32) { const int x = nb - 16; return 8 * (x >> 2) + 4 + (x & 3); }
    if (nb < 48) { const int x = nb - 32, head = x >> 1, half = x & 1; return 8 * (4 + (head >> 2)) + 4 * half + (head & 3); }
    if (nb < 52) { const int x = nb - 48, head = x >> 1, half = x & 1; return 48 + 4 * half + head; }
    { const int x = nb - 52, head = x >> 1, part = x & 1; return 48 + 4 * head + 2 + part; }
}
DI int blkperm_odd(int nb) {
    if (nb < 16) { const int head = nb >> 1, half = nb & 1; return 8 * (head >> 2) + 4 * half + (head & 3); }
    if (nb < 20) { const int x = nb - 16, head = x >> 1, half = x & 1; return 16 + 4 * half + head; }
    if (nb < 24) { const int x = nb - 20, head = x >> 1, part = x & 1; return 16 + 4 * head + 2 + part; }
    return nb;
}
DI void transpose_item(const float* W, int K, int N, bf16* WT, LAS float* scr, int item, int lane, const float* gk, int perm) {
    const int nblk = N / 32, kb = item / nblk, nb = item % nblk, k0 = 64 * kb, n0 = 32 * nb, nd0 = 32 * (perm == 1 ? blkperm_even(nb) : perm == 2 ? blkperm_odd(nb) : nb);
#pragma unroll
    for (int i = 0; i < 8; ++i) { const int kk = 8 * i + (lane >> 3), nn = 4 * (lane & 7);
        const f32x4 w4 = *(const f32x4*)(W + (size_t)(k0 + kk) * N + n0 + nn) * (gk ? gk[k0 + kk] : 1.0f);
        scr[kk * 33 + nn] = w4.x; scr[kk * 33 + nn + 1] = w4.y; scr[kk * 33 + nn + 2] = w4.z; scr[kk * 33 + nn + 3] = w4.w; }
    asm volatile("s_waitcnt lgkmcnt(0)" ::: "memory");
    const int c = lane & 7;
#pragma unroll
    for (int j = 0; j < 4; ++j) { const int n = (lane >> 3) + 8 * j; const LAS float* s = scr + (8 * c) * 33 + n;
        u32x4 o; o.x = pk2(s[0 * 33], s[1 * 33]); o.y = pk2(s[2 * 33], s[3 * 33]); o.z = pk2(s[4 * 33], s[5 * 33]); o.w = pk2(s[6 * 33], s[7 * 33]);
        *(u32x4*)(WT + (size_t)(nd0 + n) * K + k0 + 8 * c) = o; }
    asm volatile("s_waitcnt lgkmcnt(0)" ::: "memory");
}
DI void cvt_stream(const float* src, bf16* dst, size_t n8, size_t gtid, size_t gthreads) {
    for (size_t i = gtid; i < n8; i += gthreads) {
        const f32x4 a = *(const f32x4*)(src + i * 8), b = *(const f32x4*)(src + i * 8 + 4);
        u32x4 o; o.x = pk2(a.x, a.y); o.y = pk2(a.z, a.w); o.z = pk2(b.x, b.y); o.w = pk2(b.z, b.w);
        *(u32x4*)(dst + i * 8) = o;
    }
}

struct TabRow { f32x4 v[4]; };
DI void tabrow_load(TabRow& k, int lane, int lyr, int r, const float* usrc, const float* vsrc) {
    const int tab = r >= PEER_E, er = tab ? r - PEER_E : r;
    const f32x4* src = (const f32x4*)((tab ? vsrc : usrc) + ((size_t)lyr * PEER_E + er) * D) + lane;
#pragma unroll
    for (int j = 0; j < 4; ++j) k.v[j] = __builtin_nontemporal_load(src + 64 * j);
}
DI void tabrow_finish(TabRow& k, int lane, int lyr, int r, const float* fg, unsigned char* ws) {
    const int tab = r >= PEER_E, er = tab ? r - PEER_E : r;
    float am = 0.f;
#pragma unroll
    for (int j = 0; j < 4; ++j) { if (!tab) k.v[j] = k.v[j] * ((const f32x4*)(fg + (size_t)lyr * D))[lane + 64 * j];
        am = fmaxf(am, fmaxf(fmaxf(fabsf(k.v[j].x), fabsf(k.v[j].y)), fmaxf(fabsf(k.v[j].z), fabsf(k.v[j].w)))); }
    am = fmaxf(am, __builtin_bit_cast(float, __builtin_amdgcn_update_dpp(0, __builtin_bit_cast(int, am), 0xB1, 0xF, 0xF, true)));
    am = fmaxf(am, __builtin_bit_cast(float, __builtin_amdgcn_update_dpp(0, __builtin_bit_cast(int, am), 0x4E, 0xF, 0xF, true)));
    am = fmaxf(am, __builtin_bit_cast(float, __builtin_amdgcn_update_dpp(0, __builtin_bit_cast(int, am), 0x141, 0xF, 0xF, true)));
    am = fmaxf(am, __builtin_bit_cast(float, __builtin_amdgcn_update_dpp(0, __builtin_bit_cast(int, am), 0x140, 0xF, 0xF, true)));
    { const auto p = __builtin_amdgcn_permlane16_swap(__float_as_uint(am), __float_as_uint(am), false, false); am = fmaxf(__uint_as_float(p[0]), __uint_as_float(p[1])); }
    { const auto p = __builtin_amdgcn_permlane32_swap(__float_as_uint(am), __float_as_uint(am), false, false); am = fmaxf(__uint_as_float(p[0]), __uint_as_float(p[1])); }
    float sc = 1.f;
    if (am > 0.f) sc = tab ? __uint_as_float(__float_as_uint(448.0f / am) & 0x7F800000u) : 127.0f / am;
    unsigned char* dst = ws + (tab ? WS_VB : WS_UB) + (size_t)lyr * PEER_E * D + (size_t)er * 128 + ((4 * lane) & 127);
#pragma unroll
    for (int j = 0; j < 4; ++j) { int p = __builtin_amdgcn_cvt_pk_fp8_f32(k.v[j].x * sc, k.v[j].y * sc, 0, false); p = __builtin_amdgcn_cvt_pk_fp8_f32(k.v[j].z * sc, k.v[j].w * sc, p, true);
        if (!tab) p = (int)pack_i8x4(k.v[j].x * sc, k.v[j].y * sc, k.v[j].z * sc, k.v[j].w * sc);
        __builtin_nontemporal_store((unsigned)p, (unsigned*)(dst + (size_t)(2 * j + (lane >> 5)) * (PEER_E * 128))); }
    if (lane == 0) ((float*)(ws + WS_SCL))[(size_t)(tab * DEPTH + lyr) * PEER_E + er] = 1.0f / sc;
}
DI void phase_prologue(const Ctx& c, unsigned char* ws) {
    LAS float* scr = (LAS float*)(c.lds + c.wave * 8704);
    const int gw = c.vcu * NWAVES + c.wave, NGW = c.G * NWAVES;
    constexpr int I_IN = (D / 64) * (NIN / 32), I_SQ = (D / 64) * (D / 32), I_L = I_IN + 2 * I_SQ;
    for (int it = gw; it < DEPTH * I_L; it += NGW) {
        const int l = it / I_L; int r = it % I_L; const int i = l >> 1;
        if (r < I_IN) { const float* W = inp(c, (l & 1) ? 11 : 4) + (size_t)i * D * NIN;
            transpose_item(W, D, NIN, (bf16*)(ws + WS_WIN) + (size_t)l * NIN * D, scr, r, c.lane, inp(c, 1) + (size_t)l * D, (l & 1) ? 2 : 1); continue; }
        r -= I_IN;
        if (r < I_SQ) { const float* W = inp(c, (l & 1) ? 12 : 5) + (size_t)i * D * D;
            transpose_item(W, D, D, (bf16*)(ws + WS_WOUT) + (size_t)l * D * D, scr, r, c.lane, nullptr, 0); continue; }
        r -= I_SQ;
        transpose_item(inp(c, 19) + (size_t)l * D * D, D, D, (bf16*)(ws + WS_WQ) + (size_t)l * D * D, scr, r, c.lane, inp(c, 2) + (size_t)l * D, 0);
    }
    const size_t gtid = (size_t)c.vcu * NT + c.tid, gth = (size_t)c.G * NT;
    cvt_stream(inp(c, 20), (bf16*)(ws + WS_SK), (size_t)DEPTH * 16 * 128 * 64 / 8, gtid, gth);
    {
        const float* usrc = inp(c, 21); const float* vsrc = inp(c, 22); const float* fg = inp(c, 2);
        for (int r0 = gw; r0 < 2 * PEER_E; r0 += 4 * NGW) {
            TabRow R[4];
#pragma unroll
            for (int k = 0; k < 4; ++k) tabrow_load(R[k], c.lane, 0, r0 + k * NGW < 2 * PEER_E ? r0 + k * NGW : r0, usrc, vsrc);
#pragma unroll
            for (int k = 0; k < 4; ++k) if (r0 + k * NGW < 2 * PEER_E) tabrow_finish(R[k], c.lane, 0, r0 + k * NGW, fg, ws);
        }
    }
    { const float* xin = inp(c, 0); float* ssq = (float*)(ws + WS_SSQ);
      for (int m = gw; m < T; m += NGW) {
          const f32x4* xr = (const f32x4*)(xin + (size_t)m * D) + c.lane;
          u32x2* o8 = (u32x2*)(ws + WS_HB + (size_t)m * D * 2) + c.lane; float sq = 0.f;
#pragma unroll
          for (int j = 0; j < 4; ++j) { const f32x4 v = xr[64 * j]; sq += (v.x * v.x + v.y * v.y) + (v.z * v.z + v.w * v.w);
              u32x2 o; o.x = pk2(v.x, v.y); o.y = pk2(v.z, v.w); o8[64 * j] = o; }
          sq = wave_sum_fast(sq); if (c.lane < 8) ssq[(size_t)m * 8 + c.lane] = c.lane ? 0.f : sq; } }
    float* rope = (float*)(ws + WS_ROPE);
    for (size_t i = gtid; i < (size_t)SEQ * 32; i += gth) {
        const int pos = (int)(i >> 5), fi = (int)(i & 31);
        const float inv = exp2f(-(float)(2 * fi) * (13.287712379549449f / 64.0f));
        const float ang = (float)pos * inv;
        const float rh = ang * 0.15915493667125702f, re = fmaf(ang, 0.15915493667125702f, -rh) + ang * 6.4206382432985265e-09f;
        const float fr = (rh - rintf(rh)) + re;
        rope[i] = __builtin_amdgcn_cosf(fr); rope[(size_t)SEQ * 32 + i] = __builtin_amdgcn_sinf(fr);
    }
    for (size_t i = gtid; i < 64 * 16; i += gth) {
        const int pos = (int)(i >> 4), fi = (int)(i & 15);
        const float inv = exp2f(-(float)(2 * fi) * (13.287712379549449f / 32.0f));
        const float ang = (float)pos * inv;
        const float rh = ang * 0.15915493667125702f, re = fmaf(ang, 0.15915493667125702f, -rh) + ang * 6.4206382432985265e-09f;
        const float fr = (rh - rintf(rh)) + re;
        rope[(size_t)2 * SEQ * 32 + i] = __builtin_amdgcn_cosf(fr); rope[(size_t)2 * SEQ * 32 + 1024 + i] = __builtin_amdgcn_sinf(fr);
    }
}

DI void phase_final(const Ctx& c, const float* x, const float* g, float* out) {
    const int gw = c.vcu * NWAVES + c.wave, NGW = c.G * NWAVES;
    for (int m = gw; m < T; m += NGW) {
        const f32x4* xr = (const f32x4*)(x + (size_t)m * D) + c.lane;
        f32x4 v[4]; float s = 0.f;
#pragma unroll
        for (int j = 0; j < 4; ++j) { v[j] = xr[64 * j]; s += (v[j].x * v[j].x + v[j].y * v[j].y) + (v[j].z * v[j].z + v[j].w * v[j].w); }
        const float r = 1.0f / sqrtf(wave_sum(s) * (1.0f / D) + EPS);
        f32x4* o = (f32x4*)(out + (size_t)m * D) + c.lane;
#pragma unroll
        for (int j = 0; j < 4; ++j) { const f32x4 gg = ((const f32x4*)g)[c.lane + 64 * j]; o[64 * j] = v[j] * r * gg; }
    }
}

DI float rnorm8(const float* p) { const f32x4 a = ((const f32x4*)p)[0], b = ((const f32x4*)p)[1];
    return 1.0f / sqrtf((((a.x + a.y) + (a.z + a.w)) + ((b.x + b.y) + (b.z + b.w))) * (1.0f / 1024.0f) + EPS); }
DI float rnorm16(const float* p) { float s = 0.f;
#pragma unroll
    for (int j = 0; j < 4; ++j) { const f32x4 a = ((const f32x4*)p)[j]; s += (a.x + a.y) + (a.z + a.w); }
    return 1.0f / sqrtf(s * (1.0f / 1024.0f) + EPS); }
namespace pg8 {
#define PG8_LAS __attribute__((address_space(3)))
typedef unsigned short bf16_t;
typedef short bf16x8 __attribute__((ext_vector_type(8)));
typedef float f32x4 __attribute__((ext_vector_type(4)));
typedef unsigned u32x4 __attribute__((ext_vector_type(4)));
constexpr int BM = 256, BK = 64, HALF = 128, HTB = HALF * BK * 2  , STAGE_BYTES = 8 * HTB, NXCD = 8, WGM = 8;

__host__ __device__ __forceinline__ int lds_byte(int r, int c) { const int st = (r >> 4) * 2 + (c >> 5), rr = r & 15, cc = c & 31, ob = rr * 64 + cc * 2; return st * 1024 + (ob ^ (((ob >> 9) & 1) << 5)); }
__host__ __device__ __forceinline__ void stage_rc(int b, int& R, int& C) { const int st = b / 1024, sb = b % 1024, swz = sb ^ (((sb >> 9) & 1) << 5); R = (st >> 1) * 16 + swz / 64; C = (st & 1) * 32 + (swz % 64) / 2; }
__host__ __device__ __forceinline__ int perm32(int rho) { const int n = rho >> 4, i = rho & 15; return 8 * (i >> 2) + 4 * n + (i & 3); }

struct Unit { int pm, pn; };
struct Gemm { const bf16_t* A; const bf16_t* Bt; int M, N, K; };

struct StaticOrder {
    int nM, nN, nwg, G, c;
    __host__ __device__ void init(int M, int N, int G_, int c_) { nM = M / BM; nN = N / BM; nwg = nM * nN; G = G_; c = c_; }
    __host__ __device__ bool next(int i, Unit& u) const {
        const long L = (long)i * G + c; if (L >= nwg) return false;
        int wgid = (int)L; { const int q = nwg / NXCD, r = nwg % NXCD, xcd = wgid % NXCD, off = wgid / NXCD; wgid = (xcd < r ? xcd * (q + 1) : r * (q + 1) + (xcd - r) * q) + off; }
        const int nig = WGM * nN, gid = wgid / nig, fm = gid * WGM, gsz = (nM - fm) < WGM ? (nM - fm) : WGM;
        u.pm = fm + ((wgid % nig) % gsz); u.pn = (wgid % nig) / gsz; return true;
    }
    __device__ __forceinline__ void a_ready(const Unit&) const {}
    __device__ __forceinline__ void done(const Unit&) const {}
};

__device__ __forceinline__ unsigned cvt_pk_bf16(float lo, float hi) { unsigned r; asm volatile("v_cvt_pk_bf16_f32 %0, %1, %2" : "=v"(r) : "v"(lo), "v"(hi)); return r; }
typedef float f32x2 __attribute__((ext_vector_type(2)));
__device__ __forceinline__ f32x2 gelu_pk(f32x2 v) {
    const f32x2 av = __builtin_elementwise_abs(v), d = av * 0.2316418882f + 1.0f;
    f32x2 t; t.x = __builtin_amdgcn_rcpf(d.x); t.y = __builtin_amdgcn_rcpf(d.y);
    f32x2 q = t * 0.5307027145f + (-0.7265760135f); q = q * t + 0.7107068705f; q = q * t + (-0.142248368f); q = q * t + 0.127414796f; q = q * t;
    const f32x2 s = (v * v) * (-0.72134752044f);
    f32x2 e; e.x = __builtin_amdgcn_exp2f(s.x); e.y = __builtin_amdgcn_exp2f(s.y);
    const f32x2 m = v * (q * e), r = v - m;
    f32x2 o; o.x = v.x < 0.f ? m.x : r.x; o.y = v.y < 0.f ? m.y : r.y; return o;
}

template <int ACT  > struct EpiBf16 {
    static constexpr bool PERM = true, AFTER_DRAIN = false; static_assert(ACT == 0 || ACT == 1, "EpiBf16: ACT is 0 (none) or 1 (gelu_pk)");
    bf16_t* O; int ldc; const float* bias; int split_cols; size_t split_stride; float scale0;
    __device__ __forceinline__ void operator()(const f32x4 (&acc)[2][2][4][2], const Unit& u, int wr, int wc, int fr, int fq) const {
        const int row0 = u.pm * BM + wr * 64 + fr; int colt = u.pn * BM; bf16_t* base = O;
        float sc = 1.f; if (split_cols) { const int t = colt / split_cols; base += (size_t)t * split_stride; colt -= t * split_cols; if (t == 0) sc = scale0; }
        const int col0 = colt + wc * 32 + 8 * fq, bcol0 = u.pn * BM + wc * 32 + 8 * fq;
        f32x4 bv[2][2];
#pragma unroll
        for (int bj = 0; bj < 2; ++bj)
#pragma unroll
            for (int n = 0; n < 2; ++n) bv[bj][n] = bias ? *(const f32x4*)(bias + bcol0 + bj * HALF + 4 * n) : (f32x4){0.f, 0.f, 0.f, 0.f};
#pragma unroll
        for (int ai = 0; ai < 2; ++ai)
#pragma unroll
            for (int m = 0; m < 4; ++m) { bf16_t* rowp = base + (size_t)(row0 + ai * HALF + m * 16) * ldc + col0;
#pragma unroll
                for (int bj = 0; bj < 2; ++bj) { f32x4 v0 = acc[ai][bj][m][0] + bv[bj][0], v1 = acc[ai][bj][m][1] + bv[bj][1];
                    if (ACT == 1) { f32x2 a = gelu_pk((f32x2){v0[0], v0[1]}), b = gelu_pk((f32x2){v0[2], v0[3]}), c = gelu_pk((f32x2){v1[0], v1[1]}), d = gelu_pk((f32x2){v1[2], v1[3]});
                        v0 = (f32x4){a.x, a.y, b.x, b.y}; v1 = (f32x4){c.x, c.y, d.x, d.y}; }
                    v0 = v0 * sc; v1 = v1 * sc; u32x4 w; w.x = cvt_pk_bf16(v0[0], v0[1]); w.y = cvt_pk_bf16(v0[2], v0[3]); w.z = cvt_pk_bf16(v1[0], v1[1]); w.w = cvt_pk_bf16(v1[2], v1[3]);
                    *(u32x4*)(rowp + bj * HALF) = w; } }
    }
};

template <class Epi, class Sched, bool ALIGN_EPI = false, bool SP2 = false>
__device__ __forceinline__ void gemm_phase(PG8_LAS unsigned char* lds, const Gemm g, const Sched& S, const Epi& E, const int tid_in) {
    const int tid = tid_in, wid = __builtin_amdgcn_readfirstlane(tid >> 6), lane = tid & 63, wr = wid >> 2, wc = wid & 3, fr = lane & 15, fq = lane >> 4;
    const int K = g.K, nt = K / BK;
    unsigned voffA[2], voffB[2];
#pragma unroll
    for (int i = 0; i < 2; ++i) { int R, C; stage_rc(tid * 16 + i * 8192, R, C); const int Rb = Epi::PERM ? ((R & ~31) + perm32(R & 31)) : R;
        voffA[i] = (unsigned)(R * K + C) * 2u; voffB[i] = (unsigned)(Rb * K + C) * 2u; }
    const size_t kstep = (size_t)(BK * 2);
    const size_t hstep = (size_t)HALF * K * 2;
    const size_t tstep = 2 * hstep;
    const unsigned ldsw = (unsigned)wid * 1024u;
    const int aoff = lds_byte(wr * 64 + fr, fq * 8), boff = lds_byte(wc * 32 + fr, fq * 8);
#define PG8_SA(b, h) (((b) * 2 + (h)) * HTB)
#define PG8_SB(b, h) ((4 + (b) * 2 + (h)) * HTB)
#define PG8_STAGE(bufoff, gbase, voff) do { _Pragma("unroll") for (int _i = 0; _i < 2; ++_i) \
        __builtin_amdgcn_global_load_lds((const unsigned*)((const char*)(gbase) + (voff)[_i]), (PG8_LAS unsigned*)(lds + (bufoff) + ldsw + _i * 8192), 16, 0, 0); } while (0)
#define PG8_LDA(dst, b, h) do { _Pragma("unroll") for (int m = 0; m < 4; ++m) _Pragma("unroll") for (int k = 0; k < 2; ++k) dst[m][k] = *(const PG8_LAS bf16x8*)(lds + PG8_SA(b, h) + aoff + m * 2048 + k * 1024); } while (0)
#define PG8_LDB(dst, b, h) do { _Pragma("unroll") for (int n = 0; n < 2; ++n) _Pragma("unroll") for (int k = 0; k < 2; ++k) dst[n][k] = *(const PG8_LAS bf16x8*)(lds + PG8_SB(b, h) + boff + n * 2048 + k * 1024); } while (0)
#define PG8_MMA(ai, bj, At, Bt) do { __builtin_amdgcn_s_setprio(1); _Pragma("unroll") for (int m = 0; m < 4; ++m) _Pragma("unroll") for (int n = 0; n < 2; ++n) _Pragma("unroll") for (int k = 0; k < 2; ++k) \
        acc[ai][bj][m][n] = __builtin_amdgcn_mfma_f32_16x16x32_bf16(Bt[n][k], At[m][k], acc[ai][bj][m][n], 0, 0, 0); __builtin_amdgcn_s_setprio(0); } while (0)
#define PG8_WAIT_V(n) asm volatile("s_waitcnt vmcnt(" #n ")" ::: "memory")
#define PG8_WAIT_L(n) asm volatile("s_waitcnt lgkmcnt(" #n ")" ::: "memory")
#define PG8_BAR __builtin_amdgcn_s_barrier()
#define PG8_SCHED __builtin_amdgcn_sched_barrier(0)
    Unit cur, nxt; int ui = 0;
    if (!S.next(0, cur)) return;
    f32x4 acc[2][2][4][2];
#pragma unroll
    for (int a = 0; a < 2; ++a)
#pragma unroll
        for (int b = 0; b < 2; ++b)
#pragma unroll
            for (int m = 0; m < 4; ++m)
#pragma unroll
                for (int n = 0; n < 2; ++n) acc[a][b][m][n] = (f32x4){0.f, 0.f, 0.f, 0.f};
    bf16x8 At[4][2], B0[2][2], B1[2][2];
    const char* cA = (const char*)g.A + (size_t)cur.pm * tstep; const char* cB = (const char*)g.Bt + (size_t)cur.pn * tstep;
    S.a_ready(cur);
    if constexpr (SP2) {
        PG8_STAGE(PG8_SB(0, 0), cB, voffB); PG8_STAGE(PG8_SB(0, 1), cB + hstep, voffB); PG8_STAGE(PG8_SA(0, 0), cA, voffA); PG8_STAGE(PG8_SA(0, 1), cA + hstep, voffA);
        if (wr == 1) PG8_BAR;
        PG8_WAIT_V(2); PG8_BAR;
        PG8_STAGE(PG8_SB(1, 0), cB + kstep, voffB); PG8_STAGE(PG8_SA(1, 0), cA + kstep, voffA); PG8_STAGE(PG8_SB(1, 1), cB + hstep + kstep, voffB);
        PG8_WAIT_V(6); PG8_BAR;
    } else {
        PG8_STAGE(PG8_SB(0, 0), cB, voffB); PG8_STAGE(PG8_SA(0, 0), cA, voffA); PG8_STAGE(PG8_SB(0, 1), cB + hstep, voffB); PG8_STAGE(PG8_SA(0, 1), cA + hstep, voffA);
        if (wr == 1) PG8_BAR;
        PG8_WAIT_V(4); PG8_BAR;
        PG8_STAGE(PG8_SB(1, 0), cB + kstep, voffB); PG8_STAGE(PG8_SA(1, 0), cA + kstep, voffA); PG8_STAGE(PG8_SB(1, 1), cB + hstep + kstep, voffB);
        PG8_WAIT_V(6); PG8_BAR;
    }
    for (;;) {
        const bool has_next = S.next(ui + 1, nxt);
        const char* nA = has_next ? (const char*)g.A + (size_t)nxt.pm * tstep : cA; const char* nB = has_next ? (const char*)g.Bt + (size_t)nxt.pn * tstep : cB;
        for (int t = 0; t < nt; t += 2) {
            const bool last = (t == nt - 2);
            const char* a1 = cA + (size_t)(t + 1) * kstep;
            const char* a2 = last ? nA : cA + (size_t)(t + 2) * kstep; const char* b2 = last ? nB : cB + (size_t)(t + 2) * kstep;
            const char* a3 = a2 + kstep; const char* b3 = b2 + kstep;
            if (last && has_next) S.a_ready(nxt);
            if constexpr (SP2) {
            PG8_LDB(B0, 0, 0); PG8_LDB(B1, 0, 1); PG8_SCHED; PG8_LDA(At, 0, 0); PG8_STAGE(PG8_SA(1, 1), a1 + hstep, voffA);
            PG8_WAIT_V(8); PG8_WAIT_L(0); PG8_BAR; PG8_MMA(0, 0, At, B0); PG8_MMA(0, 1, At, B1); PG8_BAR; PG8_SCHED;
            PG8_LDA(At, 0, 1); PG8_STAGE(PG8_SB(0, 0), b2, voffB); PG8_STAGE(PG8_SB(0, 1), b2 + hstep, voffB); PG8_STAGE(PG8_SA(0, 0), a2, voffA);
            PG8_WAIT_V(8); PG8_WAIT_L(0); PG8_BAR; PG8_MMA(1, 0, At, B0); PG8_MMA(1, 1, At, B1); PG8_BAR; PG8_SCHED;
            PG8_LDB(B0, 1, 0); PG8_LDB(B1, 1, 1); PG8_SCHED; PG8_LDA(At, 1, 0); PG8_STAGE(PG8_SA(0, 1), a2 + hstep, voffA);
            PG8_WAIT_V(8); PG8_WAIT_L(0); PG8_BAR; PG8_MMA(0, 0, At, B0); PG8_MMA(0, 1, At, B1); PG8_BAR; PG8_SCHED;
            PG8_LDA(At, 1, 1); PG8_STAGE(PG8_SB(1, 0), b3, voffB); PG8_STAGE(PG8_SB(1, 1), b3 + hstep, voffB); PG8_STAGE(PG8_SA(1, 0), a3, voffA);
            PG8_WAIT_V(8); PG8_WAIT_L(0); PG8_BAR; PG8_MMA(1, 0, At, B0); PG8_MMA(1, 1, At, B1); PG8_BAR; PG8_SCHED;
            } else {
            PG8_LDB(B0, 0, 0); PG8_SCHED; PG8_LDA(At, 0, 0); PG8_STAGE(PG8_SA(1, 1), a1 + hstep, voffA);
            PG8_WAIT_L(8); PG8_BAR; PG8_WAIT_L(0); PG8_MMA(0, 0, At, B0); PG8_BAR; PG8_SCHED;
            PG8_LDB(B1, 0, 1); PG8_STAGE(PG8_SB(0, 0), b2, voffB);
            PG8_BAR; PG8_WAIT_L(0); PG8_MMA(0, 1, At, B1); PG8_BAR;
            PG8_LDA(At, 0, 1); PG8_STAGE(PG8_SA(0, 0), a2, voffA);
            PG8_BAR; PG8_WAIT_L(0); PG8_MMA(1, 0, At, B0); PG8_BAR; PG8_SCHED;
            PG8_STAGE(PG8_SB(0, 1), b2 + hstep, voffB);
            PG8_WAIT_V(6); PG8_BAR; PG8_MMA(1, 1, At, B1); PG8_BAR;
            PG8_LDB(B0, 1, 0); PG8_SCHED; PG8_LDA(At, 1, 0); PG8_STAGE(PG8_SA(0, 1), a2 + hstep, voffA);
            PG8_WAIT_L(8); PG8_BAR; PG8_WAIT_L(0); PG8_MMA(0, 0, At, B0); PG8_BAR; PG8_SCHED;
            PG8_LDB(B1, 1, 1); PG8_STAGE(PG8_SB(1, 0), b3, voffB);
            PG8_BAR; PG8_WAIT_L(0); PG8_MMA(0, 1, At, B1); PG8_BAR;
            PG8_LDA(At, 1, 1); PG8_STAGE(PG8_SA(1, 0), a3, voffA);
            PG8_BAR; PG8_WAIT_L(0); PG8_MMA(1, 0, At, B0); PG8_BAR; PG8_SCHED;
            PG8_STAGE(PG8_SB(1, 1), b3 + hstep, voffB);
            PG8_WAIT_V(6); PG8_BAR; PG8_MMA(1, 1, At, B1); PG8_BAR;
            }
        }
        if constexpr (ALIGN_EPI) { if (wr == 0) PG8_BAR; }
        if constexpr (!Epi::AFTER_DRAIN) { E(acc, cur, wr, wc, fr, fq); S.done(cur); }
        if (!has_next) break;
#pragma unroll
        for (int a = 0; a < 2; ++a)
#pragma unroll
            for (int b = 0; b < 2; ++b)
#pragma unroll
                for (int m = 0; m < 4; ++m)
#pragma unroll
                    for (int n = 0; n < 2; ++n) acc[a][b][m][n] = (f32x4){0.f, 0.f, 0.f, 0.f};
        cur = nxt; cA = nA; cB = nB; ++ui;
        if constexpr (ALIGN_EPI) { if (wr == 1) PG8_BAR; }
    }
    PG8_WAIT_V(0);
    if constexpr (!ALIGN_EPI) { if (wr == 0) PG8_BAR; }
    PG8_BAR;
    if constexpr (Epi::AFTER_DRAIN) { E.fused(acc, cur, wr, wc, fr, fq, lds, wid, lane); S.done(cur); }
#undef PG8_SA
#undef PG8_SB
#undef PG8_STAGE
#undef PG8_LDA
#undef PG8_LDB
#undef PG8_MMA
#undef PG8_WAIT_V
#undef PG8_WAIT_L
#undef PG8_BAR
#undef PG8_SCHED
}
}

namespace pg8 {
struct EpiF32 {
    static constexpr bool PERM = true, AFTER_DRAIN = false;
    float* C; int ldc; const float* ssq;
    __device__ __forceinline__ void operator()(const f32x4 (&acc)[2][2][4][2], const Unit& u, int wr, int wc, int fr, int fq) const {
        const int row0 = u.pm * BM + wr * 64 + fr, col0 = u.pn * BM + wc * 32 + 8 * fq;
#pragma unroll
        for (int ai = 0; ai < 2; ++ai)
#pragma unroll
            for (int m = 0; m < 4; ++m) { const int row = row0 + ai * HALF + m * 16; float* rowp = C + (size_t)row * ldc + col0;
                const float r = ssq ? rnorm8(ssq + (size_t)row * 8) : 1.0f;
#pragma unroll
                for (int bj = 0; bj < 2; ++bj) { *(f32x4*)(rowp + bj * HALF) = acc[ai][bj][m][0] * r; *(f32x4*)(rowp + bj * HALF + 4) = acc[ai][bj][m][1] * r; } }
    }
};
struct EpiRes {
    static constexpr bool PERM = true, AFTER_DRAIN = false;
    int ldc; bf16_t* Cb; float* ssq; unsigned char* X8;
    __device__ __forceinline__ void operator()(const f32x4 (&acc)[2][2][4][2], const Unit& u, int wr, int wc, int fr, int fq) const {
        const int row0 = u.pm * BM + wr * 64 + fr, col0 = u.pn * BM + wc * 32 + 8 * fq;
#pragma unroll
        for (int ai = 0; ai < 2; ++ai)
#pragma unroll
            for (int m = 0; m < 4; ++m) { const int row = row0 + ai * HALF + m * 16; bf16_t* rowb = Cb + (size_t)row * ldc + col0; float sq = 0.f;
#pragma unroll
                for (int bj = 0; bj < 2; ++bj) { const u32x4 xi = *(const u32x4*)(rowb + bj * HALF);
                    const f32x4 o0 = (f32x4){__uint_as_float(xi.x << 16), __uint_as_float(xi.x & 0xffff0000u), __uint_as_float(xi.y << 16), __uint_as_float(xi.y & 0xffff0000u)} + acc[ai][bj][m][0],
                                o1 = (f32x4){__uint_as_float(xi.z << 16), __uint_as_float(xi.z & 0xffff0000u), __uint_as_float(xi.w << 16), __uint_as_float(xi.w & 0xffff0000u)} + acc[ai][bj][m][1];
                    sq += (o0[0] * o0[0] + o0[1] * o0[1]) + (o0[2] * o0[2] + o0[3] * o0[3]) + (o1[0] * o1[0] + o1[1] * o1[1]) + (o1[2] * o1[2] + o1[3] * o1[3]);
                    u32x4 w; w.x = cvt_pk_bf16(o0[0], o0[1]); w.y = cvt_pk_bf16(o0[2], o0[3]); w.z = cvt_pk_bf16(o1[0], o1[1]); w.w = cvt_pk_bf16(o1[2], o1[3]); *(u32x4*)(rowb + bj * HALF) = w;
                    typedef unsigned u32x2v __attribute__((ext_vector_type(2)));
                    *(u32x2v*)(X8 + (size_t)row * ldc + col0 + bj * HALF) = (u32x2v){pack_i8x4(o0[0] * 16.0f, o0[1] * 16.0f, o0[2] * 16.0f, o0[3] * 16.0f), pack_i8x4(o1[0] * 16.0f, o1[1] * 16.0f, o1[2] * 16.0f, o1[3] * 16.0f)}; }
                sq = swap16_sum(sq); sq = swap32_sum(sq);
                if (fq == 0) ssq[(size_t)row * 16 + u.pn * 4 + wc] = sq; }
    }
};
struct EpiEven {
    static constexpr bool PERM = true, AFTER_DRAIN = false;
    const float* ssq; const float* rope; float* glu; bf16_t* qb; bf16_t* kb; bf16_t* vb;
    __device__ __forceinline__ void operator()(const f32x4 (&acc)[2][2][4][2], const Unit& u, int wr, int wc, int fr, int fq) const {
        const int row0 = u.pm * BM + wr * 64 + fr, c8 = wc * 32 + 8 * fq;
#pragma unroll
        for (int ai = 0; ai < 2; ++ai)
#pragma unroll
            for (int m = 0; m < 4; ++m) { const int row = row0 + ai * HALF + m * 16, b = row / SEQ, sq = row % SEQ; const float r = rnorm8(ssq + (size_t)row * 8);
                float xa[8], xb[8];
#pragma unroll
                for (int e = 0; e < 4; ++e) { xa[e] = acc[ai][0][m][0][e] * r; xa[4 + e] = acc[ai][0][m][1][e] * r; xb[e] = acc[ai][1][m][0][e] * r; xb[4 + e] = acc[ai][1][m][1][e] * r; }
                if (u.pn < 4) {
                    float* gp = glu + (size_t)row * 512 + u.pn * 128 + c8; f32x4 o0, o1;
#pragma unroll
                    for (int e = 0; e < 4; ++e) { o0[e] = xa[e] * sigmoidf_(xb[e]); o1[e] = xa[4 + e] * sigmoidf_(xb[4 + e]); }
                    *(f32x4*)gp = o0; *(f32x4*)(gp + 4) = o1;
                } else if (u.pn < 6 || wc < 2) {
                    const float* cs = rope + (size_t)sq * 32 + 8 * fq; const float* sn = cs + (size_t)SEQ * 32;
                    const f32x4 c0 = *(const f32x4*)cs, c1 = *(const f32x4*)(cs + 4), s0 = *(const f32x4*)sn, s1 = *(const f32x4*)(sn + 4);
                    const float sc = (u.pn < 6) ? 0.125f * LOG2E : 1.0f; float o1[8], o2[8];
#pragma unroll
                    for (int e = 0; e < 8; ++e) { const float cc = e < 4 ? c0[e & 3] : c1[e & 3], ss = e < 4 ? s0[e & 3] : s1[e & 3]; o1[e] = (xa[e] * cc - xb[e] * ss) * sc; o2[e] = (xb[e] * cc + xa[e] * ss) * sc; }
                    bf16_t* dst = (u.pn < 6) ? qb + ((size_t)(b * 8 + 4 * (u.pn - 4) + wc) * SEQ + sq) * 64 + 8 * fq : kb + ((size_t)(b * 2 + wc) * SEQ + sq) * 64 + 8 * fq;
                    u32x4 w1, w2; w1.x = cvt_pk_bf16(o1[0], o1[1]); w1.y = cvt_pk_bf16(o1[2], o1[3]); w1.z = cvt_pk_bf16(o1[4], o1[5]); w1.w = cvt_pk_bf16(o1[6], o1[7]);
                    w2.x = cvt_pk_bf16(o2[0], o2[1]); w2.y = cvt_pk_bf16(o2[2], o2[3]); w2.z = cvt_pk_bf16(o2[4], o2[5]); w2.w = cvt_pk_bf16(o2[6], o2[7]);
                    *(u32x4*)dst = w1; *(u32x4*)(dst + 32) = w2;
                } else {
                    bf16_t* d0 = vb + ((size_t)(b * 2) * SEQ + sq) * 64 + 32 * (wc - 2) + 8 * fq; bf16_t* d1 = d0 + (size_t)SEQ * 64;
                    u32x4 w1, w2; w1.x = cvt_pk_bf16(xa[0], xa[1]); w1.y = cvt_pk_bf16(xa[2], xa[3]); w1.z = cvt_pk_bf16(xa[4], xa[5]); w1.w = cvt_pk_bf16(xa[6], xa[7]);
                    w2.x = cvt_pk_bf16(xb[0], xb[1]); w2.y = cvt_pk_bf16(xb[2], xb[3]); w2.z = cvt_pk_bf16(xb[4], xb[5]); w2.w = cvt_pk_bf16(xb[6], xb[7]);
                    *(u32x4*)d0 = w1; *(u32x4*)d1 = w2;
                } }
    }
};
struct EpiOdd {
    static constexpr bool PERM = true, AFTER_DRAIN = false;
    const float* ssq; const float* axc; const float* qg; const float* kg; float* ug; bf16_t* vraw; float* lnp; bf16_t* qb; bf16_t* kb; bf16_t* vb; int lane;
    __device__ __forceinline__ void operator()(const f32x4 (&acc)[2][2][4][2], const Unit& u, int wr, int wc, int fr, int fq) const {
        const int row0 = u.pm * BM + wr * 64 + fr, c8 = wc * 32 + 8 * fq; const float* axs = axc + 1024;
#pragma unroll
        for (int ai = 0; ai < 2; ++ai)
#pragma unroll
            for (int m = 0; m < 4; ++m) { const int row = row0 + ai * HALF + m * 16, b = row / SEQ, sq = row % SEQ; const float r = rnorm8(ssq + (size_t)row * 8);
                float xa[8], xb[8];
#pragma unroll
                for (int e = 0; e < 4; ++e) { xa[e] = acc[ai][0][m][0][e] * r; xa[4 + e] = acc[ai][0][m][1][e] * r; xb[e] = acc[ai][1][m][0][e] * r; xb[4 + e] = acc[ai][1][m][1][e] * r; }
                if (u.pn < 2 || (u.pn == 2 && wc < 2)) {
                    const bool isq = u.pn < 2; const float* g = isq ? qg : kg;
                    float ss = 0.f;
#pragma unroll
                    for (int e = 0; e < 8; ++e) ss += xa[e] * xa[e] + xb[e] * xb[e];
                    ss = swap16_sum(ss); ss = swap32_sum(ss);
                    const float rr = 1.0f / sqrtf(ss * (1.0f / 64.0f) + EPS);
                    const f32x4 g10 = *(const f32x4*)(g + 8 * fq), g11 = *(const f32x4*)(g + 8 * fq + 4), g20 = *(const f32x4*)(g + 32 + 8 * fq), g21 = *(const f32x4*)(g + 32 + 8 * fq + 4);
                    const int fi = 8 * (fq & 1), pr = sq >> 6, pc = sq & 63;
                    const f32x4 cr0 = *(const f32x4*)(axc + pr * 16 + fi), cr1 = *(const f32x4*)(axc + pr * 16 + fi + 4), sr0 = *(const f32x4*)(axs + pr * 16 + fi), sr1 = *(const f32x4*)(axs + pr * 16 + fi + 4);
                    const f32x4 cc0 = *(const f32x4*)(axc + pc * 16 + fi), cc1 = *(const f32x4*)(axc + pc * 16 + fi + 4), sc0 = *(const f32x4*)(axs + pc * 16 + fi), sc1 = *(const f32x4*)(axs + pc * 16 + fi + 4);
                    const float sgn = (fq < 2) ? -1.0f : 1.0f, sc = isq ? 0.125f * LOG2E : 1.0f; float o1[8], o2[8];
#pragma unroll
                    for (int e = 0; e < 8; ++e) { const float x1 = xa[e] * rr * (e < 4 ? g10[e & 3] : g11[e & 3]), x2 = xb[e] * rr * (e < 4 ? g20[e & 3] : g21[e & 3]);
                        const float p1 = xor32f(x1, lane), p2 = xor32f(x2, lane);
                        o1[e] = (x1 * (e < 4 ? cr0[e & 3] : cr1[e & 3]) + sgn * p1 * (e < 4 ? sr0[e & 3] : sr1[e & 3])) * sc;
                        o2[e] = (x2 * (e < 4 ? cc0[e & 3] : cc1[e & 3]) + sgn * p2 * (e < 4 ? sc0[e & 3] : sc1[e & 3])) * sc; }
                    bf16_t* dst = isq ? qb + ((size_t)(b * 8 + 4 * u.pn + wc) * SEQ + sq) * 64 + 8 * fq : kb + ((size_t)(b * 2 + wc) * SEQ + sq) * 64 + 8 * fq;
                    u32x4 w1, w2; w1.x = cvt_pk_bf16(o1[0], o1[1]); w1.y = cvt_pk_bf16(o1[2], o1[3]); w1.z = cvt_pk_bf16(o1[4], o1[5]); w1.w = cvt_pk_bf16(o1[6], o1[7]);
                    w2.x = cvt_pk_bf16(o2[0], o2[1]); w2.y = cvt_pk_bf16(o2[2], o2[3]); w2.z = cvt_pk_bf16(o2[4], o2[5]); w2.w = cvt_pk_bf16(o2[6], o2[7]);
                    *(u32x4*)dst = w1; *(u32x4*)(dst + 32) = w2;
                } else if (u.pn == 2) {
                    bf16_t* d0 = vb + ((size_t)(b * 2) * SEQ + sq) * 64 + 32 * (wc - 2) + 8 * fq; bf16_t* d1 = d0 + (size_t)SEQ * 64;
                    u32x4 w1, w2; w1.x = cvt_pk_bf16(xa[0], xa[1]); w1.y = cvt_pk_bf16(xa[2], xa[3]); w1.z = cvt_pk_bf16(xa[4], xa[5]); w1.w = cvt_pk_bf16(xa[6], xa[7]);
                    w2.x = cvt_pk_bf16(xb[0], xb[1]); w2.y = cvt_pk_bf16(xb[2], xb[3]); w2.z = cvt_pk_bf16(xb[4], xb[5]); w2.w = cvt_pk_bf16(xb[6], xb[7]);
                    *(u32x4*)d0 = w1; *(u32x4*)d1 = w2;
                } else if (u.pn < 5) {
                    float* up = ug + (size_t)row * 512 + 256 * (u.pn - 3) + c8; f32x4 o0, o1, o2, o3;
#pragma unroll
                    for (int e = 0; e < 4; ++e) { o0[e] = gelu_tanh(xa[e]); o1[e] = gelu_tanh(xa[4 + e]); o2[e] = gelu_tanh(xb[e]); o3[e] = gelu_tanh(xb[4 + e]); }
                    *(f32x4*)up = o0; *(f32x4*)(up + 4) = o1; *(f32x4*)(up + 128) = o2; *(f32x4*)(up + 132) = o3;
                } else {
                    float s1 = 0.f, s2 = 0.f;
#pragma unroll
                    for (int e = 0; e < 8; ++e) { xa[e] = gelu_tanh(xa[e]); xb[e] = gelu_tanh(xb[e]); s1 += xa[e] + xb[e]; s2 += xa[e] * xa[e] + xb[e] * xb[e]; }
                    bf16_t* vp = vraw + (size_t)row * 512 + 256 * (u.pn - 5) + c8;
                    u32x4 w1, w2; w1.x = cvt_pk_bf16(xa[0], xa[1]); w1.y = cvt_pk_bf16(xa[2], xa[3]); w1.z = cvt_pk_bf16(xa[4], xa[5]); w1.w = cvt_pk_bf16(xa[6], xa[7]);
                    w2.x = cvt_pk_bf16(xb[0], xb[1]); w2.y = cvt_pk_bf16(xb[2], xb[3]); w2.z = cvt_pk_bf16(xb[4], xb[5]); w2.w = cvt_pk_bf16(xb[6], xb[7]);
                    *(u32x4*)vp = w1; *(u32x4*)(vp + 128) = w2;
                    s1 = swap16_sum(s1); s1 = swap32_sum(s1); s2 = swap16_sum(s2); s2 = swap32_sum(s2);
                    if (fq == 0) { float* lp = lnp + ((size_t)row * 8 + (u.pn - 5) * 4 + wc) * 2; lp[0] = s1; lp[1] = s2; }
                } }
    }
};
struct EpiBf16Scale {
    static constexpr bool PERM = true, AFTER_DRAIN = false;
    bf16_t* O; int ldc; const float* ssq;
    __device__ __forceinline__ void operator()(const f32x4 (&acc)[2][2][4][2], const Unit& u, int wr, int wc, int fr, int fq) const {
        const int row0 = u.pm * BM + wr * 64 + fr, col0 = u.pn * BM + wc * 32 + 8 * fq;
#pragma unroll
        for (int ai = 0; ai < 2; ++ai)
#pragma unroll
            for (int m = 0; m < 4; ++m) { const int row = row0 + ai * HALF + m * 16; bf16_t* rowp = O + (size_t)row * ldc + col0;
                const float r = rnorm16(ssq + (size_t)row * 16);
#pragma unroll
                for (int bj = 0; bj < 2; ++bj) { const f32x4 v0 = acc[ai][bj][m][0] * r, v1 = acc[ai][bj][m][1] * r;
                    u32x4 w; w.x = cvt_pk_bf16(v0[0], v0[1]); w.y = cvt_pk_bf16(v0[2], v0[3]); w.z = cvt_pk_bf16(v1[0], v1[1]); w.w = cvt_pk_bf16(v1[2], v1[3]); *(u32x4*)(rowp + bj * HALF) = w; } }
    }
};
}

DI void conv_item(const Ctx& c, int item, const float* glu, const float* cw, const float* cb, const float* lng, const float* lnb, bf16* ycat) {
    const int t0 = item * 32, b = t0 / SEQ, s0 = t0 % SEQ, ch = c.tid;
    LAS float* sc = (LAS float*)c.lds;
    float v[62], w[31];
#pragma unroll
    for (int i = 0; i < 62; ++i) { const int s = s0 + i - 15; v[i] = (s >= 0 && s < SEQ) ? glu[((size_t)b * SEQ + s) * 512 + ch] : 0.f; }
#pragma unroll
    for (int j = 0; j < 31; ++j) w[j] = cw[j * 512 + ch];
    const float bias = cb[ch];
    __syncthreads();
#pragma unroll
    for (int i = 0; i < 32; ++i) { float acc = bias;
#pragma unroll
        for (int j = 0; j < 31; ++j) acc += w[j] * v[i + j];
        sc[i * 512 + ch] = acc; }
    __syncthreads();
#pragma unroll
    for (int q = 0; q < 4; ++q) {
        const int i = c.wave * 4 + q; float x[8]; float sm = 0.f;
#pragma unroll
        for (int m = 0; m < 8; ++m) { x[m] = sc[i * 512 + c.lane + 64 * m]; sm += x[m]; }
        const float mean = wave_sum(sm) * (1.0f / 512.0f); float sq = 0.f;
#pragma unroll
        for (int m = 0; m < 8; ++m) { x[m] -= mean; sq += x[m] * x[m]; }
        const float rstd = 1.0f / sqrtf(wave_sum(sq) * (1.0f / 512.0f) + EPS);
#pragma unroll
        for (int m = 0; m < 8; ++m) { const int cc = c.lane + 64 * m; const float y = x[m] * rstd * lng[cc] + lnb[cc];
            ycat[(size_t)(t0 + i) * D + cc] = (bf16)f2bf(y * sigmoidf_(y)); }
    }
}

template <bool WIN>
DI void attn_item(const Ctx& c, int item, const bf16* qb, const bf16* kb, const bf16* vt, bf16* ycat, int ycol0, const float* sink) {
    const int qblk = item & 63, kvh = (item >> 6) & 1, b = item >> 7;
    const int tid = c.tid, lane = c.lane, l31 = lane & 31, h = lane >> 5;
    const int head = kvh * 4 + (c.wave & 3), q0 = qblk * 64 + (c.wave >> 2) * 32;
    const bf16* qrow = qb + ((size_t)(b * 8 + head) * SEQ + q0 + l31) * 64;
    bf16x8 qf[4];
#pragma unroll
    for (int kk = 0; kk < 4; ++kk) qf[kk] = *(const bf16x8*)(qrow + 16 * kk + 8 * h);
    f32x16 o0, o1;
#pragma unroll
    for (int i = 0; i < 16; ++i) { o0[i] = 0.f; o1[i] = 0.f; }
    float m, l;
    if (WIN) { m = sink[head] * LOG2E; l = (h == 0) ? 1.f : 0.f; } else { m = -1e30f; l = 0.f; }
    const bf16* kbase = kb + (size_t)(b * 2 + kvh) * SEQ * 64;
    const bf16* vbase = vt + (size_t)(b * 2 + kvh) * SEQ * 64;
    int t_lo = 0, t_hi = 63;
    if (WIN) { t_lo = qblk - 2 < 0 ? 0 : qblk - 2; t_hi = qblk + 2 > 63 ? 63 : qblk + 2; }
    LAS unsigned char* sK = c.lds; LAS unsigned char* sV = c.lds + 64 * 144;
    const int qpos = q0 + l31;
    u32x4 rk = *(const u32x4*)(kbase + (size_t)(t_lo * 64 + (tid >> 3)) * 64 + (tid & 7) * 8);
    u32x4 rv = *(const u32x4*)(vbase + (size_t)(t_lo * 64 + (tid >> 3)) * 64 + (tid & 7) * 8);
    for (int kt = t_lo; kt <= t_hi; ++kt) {
        __syncthreads();
        *(LAS u32x4*)(sK + (tid >> 3) * 144 + (tid & 7) * 16) = rk;
        *(LAS u32x4*)(sV + (tid >> 3) * 192 + (tid & 7) * 16) = rv;
        __syncthreads();
        { const int kn = kt < t_hi ? kt + 1 : kt;
          rk = *(const u32x4*)(kbase + (size_t)(kn * 64 + (tid >> 3)) * 64 + (tid & 7) * 8);
          rv = *(const u32x4*)(vbase + (size_t)(kn * 64 + (tid >> 3)) * 64 + (tid & 7) * 8); }
        f32x16 s0, s1;
#pragma unroll
        for (int i = 0; i < 16; ++i) { s0[i] = 0.f; s1[i] = 0.f; }
#pragma unroll
        for (int kk = 0; kk < 4; ++kk) {
            const bf16x8 k0 = *(const LAS bf16x8*)(sK + l31 * 144 + (16 * kk + 8 * h) * 2);
            const bf16x8 k1 = *(const LAS bf16x8*)(sK + (32 + l31) * 144 + (16 * kk + 8 * h) * 2);
            s0 = MFMA32(k0, qf[kk], s0); s1 = MFMA32(k1, qf[kk], s1);
        }
        if (WIN) {
#pragma unroll
            for (int r = 0; r < 16; ++r) {
                const int kp0 = kt * 64 + crow(r, h), kp1 = kp0 + 32;
                const int d0 = kp0 - qpos, d1 = kp1 - qpos;
                if (d0 > 128 || d0 < -128) s0[r] = -1e30f;
                if (d1 > 128 || d1 < -128) s1[r] = -1e30f;
            }
        }
        float mx = s0[0];
#pragma unroll
        for (int r = 1; r < 16; ++r) mx = fmaxf(mx, s0[r]);
#pragma unroll
        for (int r = 0; r < 16; ++r) mx = fmaxf(mx, s1[r]);
        mx = fmaxf(mx, __shfl_xor(mx, 32));
        const float mn = fmaxf(m, mx), alpha = __builtin_amdgcn_exp2f(m - mn); m = mn;
        float ls = 0.f;
#pragma unroll
        for (int r = 0; r < 16; ++r) { s0[r] = __builtin_amdgcn_exp2f(s0[r] - mn); s1[r] = __builtin_amdgcn_exp2f(s1[r] - mn); ls += s0[r] + s1[r]; }
        l = l * alpha + ls;
        if (__any(alpha != 1.0f)) {
#pragma unroll
            for (int i = 0; i < 16; ++i) { o0[i] *= alpha; o1[i] *= alpha; }
        }
#pragma unroll
        for (int tl = 0; tl < 2; ++tl)
#pragma unroll
            for (int st = 0; st < 2; ++st) {
                u32x4 pp;
                if (tl == 0) { pp.x = pk2(s0[8 * st], s0[8 * st + 1]); pp.y = pk2(s0[8 * st + 2], s0[8 * st + 3]); pp.z = pk2(s0[8 * st + 4], s0[8 * st + 5]); pp.w = pk2(s0[8 * st + 6], s0[8 * st + 7]); }
                else         { pp.x = pk2(s1[8 * st], s1[8 * st + 1]); pp.y = pk2(s1[8 * st + 2], s1[8 * st + 3]); pp.z = pk2(s1[8 * st + 4], s1[8 * st + 5]); pp.w = pk2(s1[8 * st + 6], s1[8 * st + 7]); }
                const bf16x8 pf = __builtin_bit_cast(bf16x8, pp);
                const int gi = lane & 15, gg = lane >> 4;
                const int vaddr = (tl * 32 + 16 * st + 4 * h + (gi >> 2)) * 192 + (16 * (gg & 1) + 4 * (gi & 3)) * 2;
                typedef short v4i16_t __attribute__((ext_vector_type(4)));
                {
                    const v4i16_t lo = __builtin_amdgcn_ds_read_tr16_b64_v4i16((LAS v4i16_t*)(sV + vaddr)), hi = __builtin_amdgcn_ds_read_tr16_b64_v4i16((LAS v4i16_t*)(sV + vaddr + 8 * 192));
                    const bf16x8 vf = {lo[0], lo[1], lo[2], lo[3], hi[0], hi[1], hi[2], hi[3]};
                    o0 = MFMA32(vf, pf, o0);
                }
                {
                    const v4i16_t lo = __builtin_amdgcn_ds_read_tr16_b64_v4i16((LAS v4i16_t*)(sV + vaddr + 64)), hi = __builtin_amdgcn_ds_read_tr16_b64_v4i16((LAS v4i16_t*)(sV + vaddr + 64 + 8 * 192));
                    const bf16x8 vf = {lo[0], lo[1], lo[2], lo[3], hi[0], hi[1], hi[2], hi[3]};
                    o1 = MFMA32(vf, pf, o1);
                }
            }
    }
    const float lt = l + __shfl_xor(l, 32), inv = 1.0f / lt;
    bf16* orow = ycat + (size_t)(b * SEQ + q0 + l31) * D + ycol0 + head * 64;
#pragma unroll
    for (int g = 0; g < 4; ++g) {
        u32x2 w0; w0.x = pk2(o0[4 * g] * inv, o0[4 * g + 1] * inv); w0.y = pk2(o0[4 * g + 2] * inv, o0[4 * g + 3] * inv);
        u32x2 w1; w1.x = pk2(o1[4 * g] * inv, o1[4 * g + 1] * inv); w1.y = pk2(o1[4 * g + 2] * inv, o1[4 * g + 3] * inv);
        *(u32x2*)(orow + 8 * g + 4 * h) = w0; *(u32x2*)(orow + 32 + 8 * g + 4 * h) = w1;
    }
    __syncthreads();
}

DI void sgu_item(const Ctx& c, int item, const float* sw, const float* sb, const bf16* vn, const float* lnp, const float* lng, const float* lnb, const float* ug, bf16* ycat) {
    const int g = item & 3, n = (item >> 2) & 31, b = item >> 7;
    const int tid = c.tid, lane = c.lane, l31 = lane & 31, h = lane >> 5;
    LAS unsigned char* sW = c.lds; LAS unsigned char* sV = c.lds + 128 * 272;
    const float* wg = sw + (size_t)g * 128 * 128;
    __syncthreads();
#pragma unroll
    for (int i = 0; i < 4; ++i) { const int idx = tid + NT * i, row = idx >> 4, ch = idx & 15;
        const f32x4 a = *(const f32x4*)(wg + row * 128 + ch * 8), bq = *(const f32x4*)(wg + row * 128 + ch * 8 + 4);
        u32x4 o; o.x = pk2(a.x, a.y); o.y = pk2(a.z, a.w); o.z = pk2(bq.x, bq.y); o.w = pk2(bq.z, bq.w);
        *(LAS u32x4*)(sW + row * 272 + ch * 16) = o;
        const size_t tk = (size_t)b * SEQ + n * 128 + row;
        const u32x4 vv = *(const u32x4*)(vn + tk * 512 + g * 128 + ch * 8);
        float s1 = 0.f, s2 = 0.f;
#pragma unroll
        for (int p = 0; p < 4; ++p) { const f32x4 t4 = ((const f32x4*)(lnp + tk * 16))[p]; s1 += t4.x + t4.z; s2 += t4.y + t4.w; }
        const float mean = s1 * (1.0f / 512.0f), rstd = 1.0f / sqrtf(fmaxf(s2 * (1.0f / 512.0f) - mean * mean, 0.f) + EPS);
        const f32x4 ga = *(const f32x4*)(lng + g * 128 + ch * 8), gb = *(const f32x4*)(lng + g * 128 + ch * 8 + 4), ba = *(const f32x4*)(lnb + g * 128 + ch * 8), bb = *(const f32x4*)(lnb + g * 128 + ch * 8 + 4);
        u32x4 vo;
        vo.x = pk2((bf_lo(vv.x) - mean) * rstd * ga.x + ba.x, (bf_hi(vv.x) - mean) * rstd * ga.y + ba.y); vo.y = pk2((bf_lo(vv.y) - mean) * rstd * ga.z + ba.z, (bf_hi(vv.y) - mean) * rstd * ga.w + ba.w);
        vo.z = pk2((bf_lo(vv.z) - mean) * rstd * gb.x + bb.x, (bf_hi(vv.z) - mean) * rstd * gb.y + bb.y); vo.w = pk2((bf_lo(vv.w) - mean) * rstd * gb.z + bb.z, (bf_hi(vv.w) - mean) * rstd * gb.w + bb.w);
        *(LAS u32x4*)(sV + row * 272 + ch * 16) = vo; }
    __syncthreads();
    const int ct = c.wave & 3, pt0 = (c.wave >> 2) * 2;
    f32x16 acc[2];
#pragma unroll
    for (int j = 0; j < 2; ++j)
#pragma unroll
        for (int i = 0; i < 16; ++i) acc[j][i] = 0.f;
#pragma unroll
    for (int kk = 0; kk < 8; ++kk) {
        bf16x8 bfr;
#pragma unroll
        for (int j = 0; j < 8; ++j) bfr[j] = *(const LAS short*)(sV + (16 * kk + 8 * h + j) * 272 + (ct * 32 + l31) * 2);
#pragma unroll
        for (int j = 0; j < 2; ++j) {
            const bf16x8 af = *(const LAS bf16x8*)(sW + ((pt0 + j) * 32 + l31) * 272 + (16 * kk + 8 * h) * 2);
            acc[j] = MFMA32(af, bfr, acc[j]);
        }
    }
#pragma unroll
    for (int j = 0; j < 2; ++j)
#pragma unroll
        for (int r = 0; r < 16; ++r) {
            const int p = (pt0 + j) * 32 + crow(r, h), cc = ct * 32 + l31; const size_t t = (size_t)b * SEQ + n * 128 + p;
            const float mixed = acc[j][r] + sb[g * 128 + p];
            ycat[t * D + 512 + g * 128 + cc] = (bf16)f2bf(ug[t * 512 + g * 128 + cc] * mixed);
        }
}

DI unsigned fkey(float f, unsigned code, unsigned mask) { const unsigned b = __float_as_uint(f); const unsigned s = b ^ ((unsigned)((int)b >> 31) | 0x80000000u); return (s & ~mask) | code; }
DI float keyval(unsigned k, unsigned mask, unsigned mid) { const unsigned s = (k & ~mask) | mid; const unsigned b = (s & 0x80000000u) ? (s ^ 0x80000000u) : ~s; return __uint_as_float(b); }
#define CE_DESC(x, y) do { const unsigned mx_ = (x) > (y) ? (x) : (y), mn_ = (x) > (y) ? (y) : (x); (x) = mx_; (y) = mn_; } while (0)
DI void sort16_desc(unsigned (&a)[16]) {
    CE_DESC(a[0], a[1]); CE_DESC(a[2], a[3]); CE_DESC(a[0], a[2]); CE_DESC(a[1], a[3]); CE_DESC(a[1], a[2]); CE_DESC(a[4], a[5]); CE_DESC(a[6], a[7]);
    CE_DESC(a[4], a[6]); CE_DESC(a[5], a[7]); CE_DESC(a[5], a[6]); CE_DESC(a[0], a[4]); CE_DESC(a[2], a[6]); CE_DESC(a[2], a[4]); CE_DESC(a[1], a[5]);
    CE_DESC(a[3], a[7]); CE_DESC(a[3], a[5]); CE_DESC(a[1], a[2]); CE_DESC(a[3], a[4]); CE_DESC(a[5], a[6]); CE_DESC(a[8], a[9]); CE_DESC(a[10], a[11]);
    CE_DESC(a[8], a[10]); CE_DESC(a[9], a[11]); CE_DESC(a[9], a[10]); CE_DESC(a[12], a[13]); CE_DESC(a[14], a[15]); CE_DESC(a[12], a[14]); CE_DESC(a[13], a[15]);
    CE_DESC(a[13], a[14]); CE_DESC(a[8], a[12]); CE_DESC(a[10], a[14]); CE_DESC(a[10], a[12]); CE_DESC(a[9], a[13]); CE_DESC(a[11], a[15]); CE_DESC(a[11], a[13]);
    CE_DESC(a[9], a[10]); CE_DESC(a[11], a[12]); CE_DESC(a[13], a[14]); CE_DESC(a[0], a[8]); CE_DESC(a[4], a[12]); CE_DESC(a[4], a[8]); CE_DESC(a[2], a[10]);
    CE_DESC(a[6], a[14]); CE_DESC(a[6], a[10]); CE_DESC(a[2], a[4]); CE_DESC(a[6], a[8]); CE_DESC(a[10], a[12]); CE_DESC(a[1], a[9]); CE_DESC(a[5], a[13]);
    CE_DESC(a[5], a[9]); CE_DESC(a[3], a[11]); CE_DESC(a[7], a[15]); CE_DESC(a[7], a[11]); CE_DESC(a[3], a[5]); CE_DESC(a[7], a[9]); CE_DESC(a[11], a[13]);
    CE_DESC(a[1], a[2]); CE_DESC(a[3], a[4]); CE_DESC(a[5], a[6]); CE_DESC(a[7], a[8]); CE_DESC(a[9], a[10]); CE_DESC(a[11], a[12]); CE_DESC(a[13], a[14]);
}
DI void merge16_desc(unsigned (&a)[16], const unsigned (&b)[16]) {
#pragma unroll
    for (int i = 0; i < 16; ++i) a[i] = a[i] > b[15 - i] ? a[i] : b[15 - i];
#pragma unroll
    for (int j = 8; j > 0; j >>= 1)
#pragma unroll
        for (int i = 0; i < 16; ++i) { const int l = i ^ j; if (l > i) CE_DESC(a[i], a[l]); }
}
DI void pair_merge16(unsigned (&a)[16]) {
    unsigned lo[16], hi[16];
#pragma unroll
    for (int i = 0; i < 16; ++i) { const auto r = __builtin_amdgcn_permlane32_swap(a[i], a[i], false, false); lo[i] = r[0]; hi[i] = r[1]; }
    merge16_desc(lo, hi);
#pragma unroll
    for (int i = 0; i < 16; ++i) a[i] = lo[i];
}
struct CandTab { int ci[64], cj[64]; constexpr CandTab() : ci(), cj() { int n = 0; for (int i = 0; i < 16; ++i) for (int j = 0; j < 16; ++j) if ((i + 1) * (j + 1) <= 16) { ci[n] = i; cj[n] = j; ++n; } for (; n < 64; ++n) { ci[n] = -1; cj[n] = -1; } } };
constexpr CandTab CAND{};
DI unsigned pick_byte(unsigned w0, unsigned w1, unsigned w2, unsigned w3, unsigned i) {
    const unsigned w = (i & 8u) ? ((i & 4u) ? w3 : w2) : ((i & 4u) ? w1 : w0);
    return (w >> ((i & 3u) * 8u)) & 0xFFu;
}
DI void route_item(const Ctx& c, int item, const bf16* qp, const bf16* sk, int* eidx, float* gate, bool stage, int lds_off = 0) {
    const int hd = item & 7, tb = item >> 3;
    const int tid = c.tid, lane = c.lane, l31 = lane & 31, h = lane >> 5;
    LAS unsigned char* sS = c.lds + lds_off;
    if (stage) {
    __syncthreads();
#pragma unroll
    for (int i = 0; i < 4; ++i) { const int idx = tid + NT * i, row = idx >> 3, ch = idx & 7;
        *(LAS u32x4*)(sS + row * 144 + ch * 16) = *(const u32x4*)(sk + (size_t)hd * 2 * 128 * 64 + (size_t)row * 64 + ch * 8); }
    }
    const int t = tb * 256 + c.wave * 32 + l31;
    const bf16* qrow = qp + (size_t)t * D + hd * 128;
    bf16x8 qf[8];
#pragma unroll
    for (int kk = 0; kk < 8; ++kk) qf[kk] = *(const bf16x8*)(qrow + 16 * kk + 8 * h);
    if (stage) __syncthreads();
    unsigned sv[2][16];
#pragma unroll
    for (int p = 0; p < 2; ++p) {
        unsigned top[16];
#pragma unroll
        for (int tl = 0; tl < 4; ++tl) {
            f32x16 acc;
#pragma unroll
            for (int i = 0; i < 16; ++i) acc[i] = 32.0f;
#pragma unroll
            for (int kk = 0; kk < 4; ++kk) {
                const bf16x8 af = *(const LAS bf16x8*)(sS + (p * 128 + tl * 32 + l31) * 144 + (16 * kk + 8 * h) * 2);
                acc = MFMA32(af, qf[p * 4 + kk], acc);
            }
            unsigned g[16];
#pragma unroll
            for (int r = 0; r < 16; ++r) g[r] = (__float_as_uint(acc[r]) & ~127u) | ((unsigned)(127 - (tl * 32 + (r & 3) + 8 * (r >> 2))) - 4u * (unsigned)h);
            sort16_desc(g);
            if (tl == 0) {
#pragma unroll
                for (int i = 0; i < 16; ++i) top[i] = g[i];
            } else merge16_desc(top, g);
        }
        pair_merge16(top);
#pragma unroll
        for (int i = 0; i < 16; ++i) sv[p][i] = top[i];
    }
    float v0[16], v1[16];
#pragma unroll
    for (int i = 0; i < 16; ++i) { v0[i] = __uint_as_float((sv[0][i] & ~127u) | 64u) - 32.0f; v1[i] = __uint_as_float((sv[1][i] & ~127u) | 64u) - 32.0f; }
    unsigned ca[16], cb[16];
#pragma unroll
    for (int m = 0; m < 32; ++m) {
        constexpr int dummy = 0; (void)dummy;
        const int ia = CAND.ci[m], ja = CAND.cj[m], ib = CAND.ci[32 + m], jb = CAND.cj[32 + m];
        const unsigned ka = fkey(v0[ia] + v1[ja], (unsigned)(255 - (ia * 16 + ja)), 255u);
        const int ibc = ib >= 0 ? ib : 0, jbc = jb >= 0 ? jb : 0;
        const unsigned kb2 = (ib >= 0) ? fkey(v0[ibc] + v1[jbc], (unsigned)(255 - (ibc * 16 + jbc)), 255u) : 0u;
        const unsigned kx = h ? kb2 : ka;
        if (m < 16) ca[m] = kx; else cb[m - 16] = kx;
    }
    sort16_desc(ca); sort16_desc(cb); merge16_desc(ca, cb);
    pair_merge16(ca);
    unsigned p0[4], p1[4];
#pragma unroll
    for (int w = 0; w < 4; ++w) { p0[w] = 0u; p1[w] = 0u;
#pragma unroll
        for (int q = 0; q < 4; ++q) { p0[w] |= (127u - (sv[0][4 * w + q] & 127u)) << (8 * q); p1[w] |= (127u - (sv[1][4 * w + q] & 127u)) << (8 * q); } }
    float fv[16]; int ex[16];
#pragma unroll
    for (int r = 0; r < 16; ++r) { const unsigned code = 255u - (ca[r] & 255u); fv[r] = keyval(ca[r], 255u, 128u);
        ex[r] = (int)(pick_byte(p0[0], p0[1], p0[2], p0[3], code >> 4) * 128u + pick_byte(p1[0], p1[1], p1[2], p1[3], code & 15u)); }
    float sum = 0.f; const float mxv = fv[0];
#pragma unroll
    for (int r = 0; r < 16; ++r) { fv[r] = __expf(fv[r] - mxv); sum += fv[r]; }
    const float inv = 1.0f / sum;
    int eo[8]; float go[8];
#pragma unroll
    for (int r = 0; r < 8; ++r) { eo[r] = h ? ex[8 + r] : ex[r]; go[r] = (h ? fv[8 + r] : fv[r]) * inv; }
    int* ep = eidx + (size_t)t * 128 + hd * 16 + 8 * h; float* gp = gate + (size_t)t * 128 + hd * 16 + 8 * h;
    typedef int i32x4 __attribute__((ext_vector_type(4)));
    i32x4 e0, e1; e0.x = eo[0]; e0.y = eo[1]; e0.z = eo[2]; e0.w = eo[3]; e1.x = eo[4]; e1.y = eo[5]; e1.z = eo[6]; e1.w = eo[7];
    f32x4 g0, g1; g0.x = go[0]; g0.y = go[1]; g0.z = go[2]; g0.w = go[3]; g1.x = go[4]; g1.y = go[5]; g1.z = go[6]; g1.w = go[7];
    *(i32x4*)ep = e0; *(i32x4*)(ep + 4) = e1; *(f32x4*)gp = g0; *(f32x4*)(gp + 4) = g1;
}

struct GuTok { u32x4 seg[16]; u32x4 h; };
DI void gu_issue(GuTok& k, int lane, int q, int t, int e0, int e1, const unsigned char* ub, const unsigned char* x8) {
    const int sub = lane >> 3, ch = lane & 7;
    k.h = *(const u32x4*)(x8 + ((unsigned)t * (unsigned)D + (unsigned)(q * 128 + ch * 16)));
#pragma unroll
    for (int i = 0; i < 16; ++i) { const int src = (8 * i + sub) & 63; const int e = __shfl(i < 8 ? e0 : e1, src);
        k.seg[i] = *(const u32x4*)(ub + (unsigned)(q * (PEER_E * 128) + e * 128 + ch * 16)); }
}
DI float lane_xor4(float v, bool b2) {
    int r = __builtin_amdgcn_update_dpp(0, __builtin_bit_cast(int, v), 0x104, 0xF, 0x5, false);
    r = __builtin_amdgcn_update_dpp(r, __builtin_bit_cast(int, v), 0x114, 0xF, 0xA, false);
    (void)b2; return __builtin_bit_cast(float, r);
}
DI void gu_finish(const GuTok& k, int lane, bf16* pa_t) {
    const int sub = lane >> 3;
    const bool b0 = lane & 1, b1 = lane & 2, b2 = lane & 4;
    float d[16];
#pragma unroll
    for (int i = 0; i < 16; ++i) { int di = __builtin_amdgcn_sdot4((int)k.seg[i].x, (int)k.h.x, 0, false); di = __builtin_amdgcn_sdot4((int)k.seg[i].y, (int)k.h.y, di, false);
        di = __builtin_amdgcn_sdot4((int)k.seg[i].z, (int)k.h.z, di, false); di = __builtin_amdgcn_sdot4((int)k.seg[i].w, (int)k.h.w, di, false); d[i] = (float)di; }
    float r8[8], r4[4], r2[2];
#pragma unroll
    for (int i = 0; i < 8; ++i) { const float mine = b0 ? d[8 + i] : d[i], send = b0 ? d[i] : d[8 + i];
        r8[i] = mine + __builtin_bit_cast(float, __builtin_amdgcn_update_dpp(0, __builtin_bit_cast(int, send), 0xB1, 0xF, 0xF, true)); }
#pragma unroll
    for (int i = 0; i < 4; ++i) { const float mine = b1 ? r8[4 + i] : r8[i], send = b1 ? r8[i] : r8[4 + i];
        r4[i] = mine + __builtin_bit_cast(float, __builtin_amdgcn_update_dpp(0, __builtin_bit_cast(int, send), 0x4E, 0xF, 0xF, true)); }
#pragma unroll
    for (int i = 0; i < 2; ++i) { const float mine = b2 ? r4[2 + i] : r4[i], send = b2 ? r4[i] : r4[2 + i]; r2[i] = mine + lane_xor4(send, b2); }
    const int i0 = (b0 ? 8 : 0) + (b1 ? 4 : 0) + (b2 ? 2 : 0);
    __builtin_nontemporal_store((bf16)f2bf(r2[0]), pa_t + 8 * i0 + sub); __builtin_nontemporal_store((bf16)f2bf(r2[1]), pa_t + 8 * (i0 + 1) + sub);
}
DI void gu_wave(const Ctx& c, int q, int t_first, int t_step, const unsigned char* hb, const int* eidx, const unsigned char* ub, bf16* pa,
                int cl, const float* usrc, const float* vsrc, const float* fg, unsigned char* ws) {
    const int lane = c.lane;
    const int n = (t_first < T) ? (T - t_first + t_step - 1) >> __builtin_ctz(t_step) : 0;
    if (n == 0) return;
#define GU_ROUTE(tt, E0, E1) do { const int t_ = (tt) < T ? (tt) : t_first; E0 = eidx[(size_t)t_ * 128 + lane]; E1 = eidx[(size_t)t_ * 128 + 64 + lane]; } while (0)
    int ea0, ea1, eb0, eb1;
    GU_ROUTE(t_first, ea0, ea1);
    GU_ROUTE(t_first + t_step, eb0, eb1);
    GuTok A, B;
    if (c.wave & 1) __builtin_amdgcn_s_sleep(32);
    gu_issue(A, lane, q, t_first, ea0, ea1, ub, hb);
    int i = 0;
    const int gwv = c.vid * NWAVES + c.wave, ngw = c.G * NWAVES;
    int cr = gwv; TabRow R;
    if (cl < DEPTH && cr < 2 * PEER_E) tabrow_load(R, lane, cl, cr, usrc, vsrc);
    for (; i + 1 < n; i += 2) {
        const int t = t_first + i * t_step;
        if (cl < DEPTH && cr < 2 * PEER_E) { tabrow_finish(R, lane, cl, cr, fg, ws); cr += ngw; if (cr < 2 * PEER_E) tabrow_load(R, lane, cl, cr, usrc, vsrc); }
        gu_issue(B, lane, q, t + t_step, eb0, eb1, ub, hb);
        GU_ROUTE(t + 2 * t_step, ea0, ea1);
        gu_finish(A, lane, pa + ((size_t)q * T + t) * 128);
        if (i + 2 < n) gu_issue(A, lane, q, t + 2 * t_step, ea0, ea1, ub, hb);
        GU_ROUTE(t + 3 * t_step, eb0, eb1);
        gu_finish(B, lane, pa + ((size_t)q * T + t + t_step) * 128);
    }
    if (i < n) gu_finish(A, lane, pa + ((size_t)q * T + t_first + i * t_step) * 128);
    while (cl < DEPTH && cr < 2 * PEER_E) { tabrow_finish(R, lane, cl, cr, fg, ws); cr += ngw; if (cr < 2 * PEER_E) tabrow_load(R, lane, cl, cr, usrc, vsrc); }
#undef GU_ROUTE
}
DI void phase_w(const Ctx& c, const bf16* pa, const int* eidx, const float* gate, const float* uinv, const float* vinv, const float* ssq, float* wbuf,
                int cl, const float* usrc, const float* vsrc, const float* fg, unsigned char* ws) {
    const unsigned gth = (unsigned)c.G * NT;
    for (unsigned i0 = (unsigned)c.vcu * NT + c.tid; i0 < (unsigned)T * 128; i0 += 8 * gth) {
        float a[8]; int e[8]; float g[8], sq[8];
#pragma unroll
        for (int j = 0; j < 8; ++j) { const unsigned i = i0 + j * gth < (unsigned)T * 128 ? i0 + j * gth : i0; a[j] = 0.f;
#pragma unroll
            for (int q = 0; q < 8; ++q) a[j] += __uint_as_float((unsigned)pa[(size_t)q * T * 128 + i] << 16);
            e[j] = eidx[i]; g[j] = gate[i];
            const unsigned tk = (unsigned)__builtin_amdgcn_readfirstlane((int)(i >> 7));
            sq[j] = rnorm16(ssq + (size_t)tk * 16); }
#pragma unroll
        for (int j = 0; j < 8; ++j) { const unsigned i = i0 + j * gth;
            if (i < (unsigned)T * 128) ((unsigned*)wbuf)[i] = (unsigned)e[j] | (f2bf(gelu_tanh(a[j] * uinv[e[j]] * sq[j] * 0.0625f) * g[j] * vinv[e[j]]) << 16); }
    }
    if (cl < DEPTH) {
        const int gw = c.vcu * NWAVES + c.wave, NGW = c.G * NWAVES;
        for (int r0 = gw; r0 < 2 * PEER_E; r0 += 4 * NGW) {
            TabRow R[4];
#pragma unroll
            for (int k = 0; k < 4; ++k) tabrow_load(R[k], c.lane, cl, r0 + k * NGW < 2 * PEER_E ? r0 + k * NGW : r0, usrc, vsrc);
#pragma unroll
            for (int k = 0; k < 4; ++k) if (r0 + k * NGW < 2 * PEER_E) tabrow_finish(R[k], c.lane, cl, r0 + k * NGW, fg, ws);
        }
    }
}
DI float lane_xor16(float v, bool odd_row) { const auto r = __builtin_amdgcn_permlane16_swap(__float_as_uint(v), __float_as_uint(v), false, false); return __uint_as_float(odd_row ? r[0] : r[1]); }
DI float lane_xor32(float v, bool hi) { const auto r = __builtin_amdgcn_permlane32_swap(__float_as_uint(v), __float_as_uint(v), false, false); return __uint_as_float(hi ? r[0] : r[1]); }
struct GmHalf { u32x4 seg[8]; };
DI void gm_issue(GmHalf& k, int lane, int q, unsigned ew, const unsigned char* vb, int emask) {
    const int sub = lane >> 3, ch = lane & 7;
#pragma unroll
    for (int i = 0; i < 8; ++i) { const int ei = (int)(__shfl(ew, 8 * i + sub) & 0xFFFFu) & emask; k.seg[i] = *(const u32x4*)(vb + (unsigned)(q * (PEER_E * 128) + ei * 128 + ch * 16)); }
}
DI float gm_prep(unsigned ew0, unsigned ew1, LAS unsigned char* wslot, int lane) {
    const float w0 = __uint_as_float(ew0 & 0xFFFF0000u), w1 = __uint_as_float(ew1 & 0xFFFF0000u);
    float m = fmaxf(fabsf(w0), fabsf(w1));
    m = fmaxf(m, __builtin_bit_cast(float, __builtin_amdgcn_update_dpp(0, __builtin_bit_cast(int, m), 0xB1, 0xF, 0xF, true)));
    m = fmaxf(m, __builtin_bit_cast(float, __builtin_amdgcn_update_dpp(0, __builtin_bit_cast(int, m), 0x4E, 0xF, 0xF, true)));
    m = fmaxf(m, __builtin_bit_cast(float, __builtin_amdgcn_update_dpp(0, __builtin_bit_cast(int, m), 0x141, 0xF, 0xF, true)));
    m = fmaxf(m, __builtin_bit_cast(float, __builtin_amdgcn_update_dpp(0, __builtin_bit_cast(int, m), 0x140, 0xF, 0xF, true)));
    { const auto p = __builtin_amdgcn_permlane16_swap(__float_as_uint(m), __float_as_uint(m), false, false); m = fmaxf(__uint_as_float(p[0]), __uint_as_float(p[1])); }
    { const auto p = __builtin_amdgcn_permlane32_swap(__float_as_uint(m), __float_as_uint(m), false, false); m = fmaxf(__uint_as_float(p[0]), __uint_as_float(p[1])); }
    unsigned em = (__float_as_uint(m) >> 23) & 0xFFu; em = em < 16u ? 16u : em;
    const float S = __uint_as_float((261u - em) << 23);
    const int p = __builtin_amdgcn_cvt_pk_fp8_f32(w0 * S, w1 * S, 0, false);
    wslot[lane] = (unsigned char)(p & 0xFF); wslot[64 + lane] = (unsigned char)((p >> 8) & 0xFF);
    return __uint_as_float((em - 7u) << 23);
}
DI void gm_accum(const GmHalf& k, const LAS unsigned char* wh, int lane, f32x4& alo, f32x4& ahi) {
    const unsigned sub = (unsigned)lane >> 3, sh = 8u * ((unsigned)lane & 7u), sel = 0x0C0C0C00u | sub;
    u32x4 W[4];
#pragma unroll
    for (int j = 0; j < 4; ++j) W[j] = *(const LAS u32x4*)(wh + 16 * j);
#pragma unroll
    for (int i = 0; i < 8; ++i) { const unsigned lo = (i & 1) ? W[i >> 1].z : W[i >> 1].x, hi = (i & 1) ? W[i >> 1].w : W[i >> 1].y;
        const long A = (long)((unsigned long long)__builtin_amdgcn_perm(hi, lo, sel) << sh);
        alo = __builtin_amdgcn_mfma_f32_16x16x32_fp8_fp8(A, (long)(((unsigned long long)k.seg[i].y << 32) | k.seg[i].x), alo, 0, 0, 0);
        ahi = __builtin_amdgcn_mfma_f32_16x16x32_fp8_fp8(A, (long)(((unsigned long long)k.seg[i].w << 32) | k.seg[i].z), ahi, 0, 0, 0); }
}
DI void gm_store(const f32x4 alo, const f32x4 ahi, float invS, int lane, int q, int t, bf16* xb, float* xf, float* ssq) {
    const int j = lane & 15, g = lane >> 4;
    float v[8];
#pragma unroll
    for (int r = 0; r < 4; ++r) { v[r] = alo[r]; v[4 + r] = ahi[r]; }
#pragma unroll
    for (int r = 0; r < 8; ++r) { const float p8 = __builtin_bit_cast(float, __builtin_amdgcn_update_dpp(0, __builtin_bit_cast(int, v[r]), 0x128, 0xF, 0xF, true));
        v[r] = (v[r] + lane_xor32(p8, lane >= 32)) * invS; }
    const bool own = (j < 8) && (g < 2);
    float sq = 0.f;
    if (own) { const unsigned off = (unsigned)t * (unsigned)D + (unsigned)(q * 128 + 16 * j + 4 * g);
        const u32x2 xa = *(const u32x2*)(xb + off), xc = *(const u32x2*)(xb + off + 8);
        f32x4 a = {bf_lo(xa.x) + v[0], bf_hi(xa.x) + v[1], bf_lo(xa.y) + v[2], bf_hi(xa.y) + v[3]}, b = {bf_lo(xc.x) + v[4], bf_hi(xc.x) + v[5], bf_lo(xc.y) + v[6], bf_hi(xc.y) + v[7]};
        if (xf) { *(f32x4*)(xf + off) = a; *(f32x4*)(xf + off + 8) = b; }
        if (ssq) { u32x2 w0; w0.x = pk2(a.x, a.y); w0.y = pk2(a.z, a.w); u32x2 w1; w1.x = pk2(b.x, b.y); w1.y = pk2(b.z, b.w); *(u32x2*)(xb + off) = w0; *(u32x2*)(xb + off + 8) = w1; }
        sq = (a.x * a.x + a.y * a.y) + (a.z * a.z + a.w * a.w) + (b.x * b.x + b.y * b.y) + (b.z * b.z + b.w * b.w); }
    if (ssq) { sq = wave_sum_fast(sq); if (lane == 0) ssq[(unsigned)t * 8u + (unsigned)q] = sq; }
}
DI void gv_wave(const Ctx& c, int q, int t_first, int t_step, const int* eidx, const float* wbuf, const unsigned char* vb, int emask, bf16* xb, float* xf, float* ssq) {
    const int lane = c.lane;
    const int n = (t_first < T) ? (T - t_first + t_step - 1) >> __builtin_ctz(t_step) : 0;
    if (n == 0) return;
    (void)eidx;
    LAS unsigned char* wl = c.lds + c.wave * 512;
#define TOK(k) (t_first + (k) * t_step)
#define GV_RT(k, E0, E1) do { const unsigned o_ = (unsigned)TOK(k) * 128u + (unsigned)lane; E0 = ewb[o_]; E1 = ewb[o_ + 64u]; } while (0)
    const unsigned* ewb = (const unsigned*)wbuf;
    unsigned r00, r01, rx0, rx1, ry0, ry1, rz0, rz1;
    GV_RT(0, r00, r01); GV_RT(1, rx0, rx1); GV_RT(2, ry0, ry1); GV_RT(3, rz0, rz1);
    float is0 = gm_prep(r00, r01, wl + 0, lane), is1 = gm_prep(rx0, rx1, wl + 128, lane);
    GmHalf U0, U1, U2, U3;
    gm_issue(U0, lane, q, r00, vb, emask); gm_issue(U1, lane, q, r01, vb, emask); gm_issue(U2, lane, q, rx0, vb, emask);
    for (int i = 0; i < n; i += 2) {
        unsigned rn0, rn1;
        GV_RT(i + 4, rn0, rn1);
        const float is2 = gm_prep(ry0, ry1, wl + 128 * ((i + 2) & 3), lane);
        f32x4 alo = {0.f, 0.f, 0.f, 0.f}, ahi = {0.f, 0.f, 0.f, 0.f};
        gm_issue(U3, lane, q, rx1, vb, emask);
        gm_accum(U0, wl + 128 * (i & 3), lane, alo, ahi);
        gm_issue(U0, lane, q, ry0, vb, emask);
        gm_accum(U1, wl + 128 * (i & 3) + 64, lane, alo, ahi);
        gm_store(alo, ahi, is0, lane, q, TOK(i), xb, xf, ssq);
        gm_issue(U1, lane, q, ry1, vb, emask);
        unsigned rm0, rm1;
        GV_RT(i + 5, rm0, rm1);
        const float is3 = gm_prep(rz0, rz1, wl + 128 * ((i + 3) & 3), lane);
        alo = (f32x4){0.f, 0.f, 0.f, 0.f}; ahi = (f32x4){0.f, 0.f, 0.f, 0.f};
        gm_accum(U2, wl + 128 * ((i + 1) & 3), lane, alo, ahi);
        gm_issue(U2, lane, q, rz0, vb, emask);
        gm_accum(U3, wl + 128 * ((i + 1) & 3) + 64, lane, alo, ahi);
        if (i + 1 < n) gm_store(alo, ahi, is1, lane, q, TOK(i + 1), xb, xf, ssq);
        rx1 = rz1; ry0 = rn0; ry1 = rn1; rz0 = rm0; rz1 = rm1; is0 = is2; is1 = is3;
    }
#undef GV_RT
#undef TOK
}

namespace attn_body {
using bf16=__hip_bfloat16;
using bf16x8=__attribute__((ext_vector_type(8)))short;
using s16x4=__attribute__((ext_vector_type(4)))short;
using f32x16=__attribute__((ext_vector_type(16)))float;
using u32x4=__attribute__((ext_vector_type(4)))unsigned;
constexpr int BATCH=4,NHEAD=8,NKV=2,SEQ=4096,D=64;
constexpr int QP=64,KP=64,VP=64,OP=1024;
constexpr int NW=8,QBLK=32,QB=QBLK*NW,KVBLK=64,NQB=SEQ/QB;
constexpr int ATTN_UNIT_ROWS=QB;
__device__ __forceinline__ int crow(int r,int hi){return (r&3)+8*(r>>2)+4*hi;}
#define SBAR() __builtin_amdgcn_sched_barrier(0)
__device__ __forceinline__ void cmask(f32x16&p0,f32x16&p1,int jb,int qrel,int hi){
  const float NEG=-INFINITY; int kb=64*jb+4*hi;
  #pragma unroll
  for(int r=0;r<16;++r){int kv=kb+(r&3)+8*(r>>2); if(kv>qrel)p0[r]=NEG; if(kv+32>qrel)p1[r]=NEG;}
}

constexpr int NSLOT=3, SLOTB=8192;
constexpr int LDS_K=0, LDS_V=NSLOT*SLOTB, LDS_WS=2*NSLOT*SLOTB, LDS_OST=LDS_WS+NW*64*4, LDS_BYTES=LDS_OST+NW*4096;
constexpr float C2=0.125f*1.4426950408889634f;
__device__ __forceinline__ void glds16(const void*gsrc,unsigned lds_dst){unsigned keep;
  asm volatile("s_mov_b32 %0, m0\n\ts_mov_b32 m0, %2\n\ts_nop 0\n\tglobal_load_lds_dwordx4 %1, off\n\ts_mov_b32 m0, %0":"=&s"(keep):"v"(gsrc),"s"(lds_dst):"memory");}
__device__ __forceinline__ float max3f(float a,float b,float c){float r;asm("v_max3_f32 %0, %1, %2, %3":"=v"(r):"v"(a),"v"(b),"v"(c));return r;}
__device__ __forceinline__ float max2f(float a,float b){float r;asm("v_max_f32_e32 %0, %1, %2":"=v"(r):"v"(a),"v"(b));return r;}
__device__ __forceinline__ float fadd_s(float a,float b){float r;asm("v_add_f32_e32 %0, %1, %2":"=v"(r):"v"(a),"v"(b));return r;}
__device__ __forceinline__ float fsub_s(float a,float b){float r;asm("v_sub_f32_e32 %0, %1, %2":"=v"(r):"v"(a),"v"(b));return r;}
typedef float f32x2_t __attribute__((ext_vector_type(2))); typedef __bf16 bf16x2_t __attribute__((ext_vector_type(2)));
__device__ __forceinline__ unsigned cvtpk_s(float lo,float hi){f32x2_t v={lo,hi};bf16x2_t b=__builtin_convertvector(v,bf16x2_t);return __builtin_bit_cast(unsigned,b);}
#define WAIT_BAR(N) asm volatile("s_waitcnt vmcnt(" #N ") lgkmcnt(0)\n\ts_barrier":::"memory")

__device__ __forceinline__ void qkt(f32x16&p0,f32x16&p1,const char*Kslot,const bf16x8*qr,const f32x16&negm,int r32,int hi){
  const char*kb=Kslot+hi*1024+r32*16;
  #pragma unroll
  for(int d0=0;d0<4;++d0){
    const bf16x8 b0=*reinterpret_cast<const bf16x8*>(kb+d0*2048);
    const bf16x8 b1=*reinterpret_cast<const bf16x8*>(kb+d0*2048+512);
    if(d0==0){p0=__builtin_amdgcn_mfma_f32_32x32x16_bf16(b0,qr[0],negm,0,0,0);p1=__builtin_amdgcn_mfma_f32_32x32x16_bf16(b1,qr[0],negm,0,0,0);}
    else{p0=__builtin_amdgcn_mfma_f32_32x32x16_bf16(b0,qr[d0],p0,0,0,0);p1=__builtin_amdgcn_mfma_f32_32x32x16_bf16(b1,qr[d0],p1,0,0,0);}}
}
typedef __attribute__((address_space(3))) const char* lds_cptr;
typedef short v4i16_t __attribute__((ext_vector_type(4)));
__device__ __forceinline__ void kload8(bf16x8*kf,lds_cptr kp){
  kf[0]=*(const __attribute__((address_space(3))) bf16x8*)(kp);      kf[1]=*(const __attribute__((address_space(3))) bf16x8*)(kp+512);
  kf[2]=*(const __attribute__((address_space(3))) bf16x8*)(kp+2048); kf[3]=*(const __attribute__((address_space(3))) bf16x8*)(kp+2560);
  kf[4]=*(const __attribute__((address_space(3))) bf16x8*)(kp+4096); kf[5]=*(const __attribute__((address_space(3))) bf16x8*)(kp+4608);
  kf[6]=*(const __attribute__((address_space(3))) bf16x8*)(kp+6144); kf[7]=*(const __attribute__((address_space(3))) bf16x8*)(kp+6656);
}
__device__ __forceinline__ void kload2(bf16x8*kf,lds_cptr kp,int j){ kf[2*j]=*(const __attribute__((address_space(3))) bf16x8*)(kp+j*2048); kf[2*j+1]=*(const __attribute__((address_space(3))) bf16x8*)(kp+j*2048+512); }
__device__ __forceinline__ s16x4 vtr(lds_cptr p){ return __builtin_bit_cast(s16x4,__builtin_amdgcn_ds_read_tr16_b64_v4i16((__attribute__((address_space(3))) v4i16_t*)p)); }
__device__ __forceinline__ float rowmax(const f32x16&p0,const f32x16&p1){
  float a=max3f(p0[0],p0[1],p1[0]),b=max3f(p0[2],p0[3],p1[1]);a=max3f(a,p1[2],p1[3]);
  #pragma unroll
  for(int r=4;r<16;r+=4){a=max3f(a,p0[r],p0[r+1]);b=max3f(b,p0[r+2],p0[r+3]);a=max3f(a,p1[r],p1[r+1]);b=max3f(b,p1[r+2],p1[r+3]);}
  const float m=max2f(a,b);
  auto rr=__builtin_amdgcn_permlane32_swap(__float_as_uint(m),__float_as_uint(m),false,false);
  return max2f(__uint_as_float(rr[0]),__uint_as_float(rr[1]));
}
__device__ __forceinline__ void pv(f32x16*o,int vb,bf16x8 pa0,bf16x8 pa1,bf16x8 pa2,bf16x8 pa3){
  #pragma unroll
  for(int d0=0;d0<2;++d0){s16x4 lo[4],hi[4];
    #pragma unroll
    for(int ks=0;ks<4;++ks){
      asm volatile("ds_read_b64_tr_b16 %0,%1 offset:%c2":"=&v"(lo[ks]):"v"(vb),"i"(d0*4096+ks*1024):"memory");
      asm volatile("ds_read_b64_tr_b16 %0,%1 offset:%c2":"=&v"(hi[ks]):"v"(vb),"i"(d0*4096+ks*1024+512):"memory");}
    asm volatile("s_waitcnt lgkmcnt(0)":::"memory");SBAR();
    #define PK(k) (bf16x8){lo[k][0],lo[k][1],lo[k][2],lo[k][3],hi[k][0],hi[k][1],hi[k][2],hi[k][3]}
    o[d0]=__builtin_amdgcn_mfma_f32_32x32x16_bf16(pa0,PK(0),o[d0],0,0,0);
    o[d0]=__builtin_amdgcn_mfma_f32_32x32x16_bf16(pa1,PK(1),o[d0],0,0,0);
    o[d0]=__builtin_amdgcn_mfma_f32_32x32x16_bf16(pa2,PK(2),o[d0],0,0,0);
    o[d0]=__builtin_amdgcn_mfma_f32_32x32x16_bf16(pa3,PK(3),o[d0],0,0,0);
    #undef PK
  }
}

#ifndef ATTN_STORE16
#define ATTN_STORE16(p,v) (*(u32x4*)(p)=(v))
#endif
template<int THRL> __device__ __forceinline__ void attn_unit(int b,int h,int qb,const bf16*Q,const bf16*K,const bf16*V,bf16*O,char*shm,const int tid){
  const int lane=tid&63,r32=lane&31,hi=lane>>5; const int wid=__builtin_amdgcn_readfirstlane(tid>>6);
  const long rowbase=(long)b*SEQ; const int q0=qb*QB;
  const bf16*Qw=Q+(((long)b*NHEAD+h)*SEQ+q0+wid*QBLK)*QP;
  const bf16*Kh=K+((long)b*NKV+(h>>2))*SEQ*KP,*Vh=V+((long)b*NKV+(h>>2))*SEQ*VP;
  const unsigned lds0=(unsigned)(uintptr_t)shm;
  float*wsf=(float*)(shm+LDS_WS)+wid*64;
  const bf16*ksrc=Kh+(long)lane*KP+wid*8;
  const bf16*vsrc=Vh+(long)(16*(wid&3)+(lane>>2))*VP+(wid>>2)*32+(lane&3)*8;
  const unsigned kdst=lds0+LDS_K+wid*1024, vdst=lds0+LDS_V+wid*1024;
  #define DMA_K(t,slot) glds16(ksrc+(long)(t)*KVBLK*KP,(unsigned)__builtin_amdgcn_readfirstlane(kdst+(slot)))
  #define DMA_V(t,slot) glds16(vsrc+(long)(t)*KVBLK*VP,(unsigned)__builtin_amdgcn_readfirstlane(vdst+(slot)))
  const int vb0=(int)(lds0+LDS_V)+((lane>>4)&1)*32+(lane&3)*8+(4*hi+((lane&15)>>2))*64;
  const char*Kbase=shm+LDS_K; bf16x8 kf[8];
  const lds_cptr shm3=(lds_cptr)shm; const lds_cptr kp0=shm3+LDS_K+hi*1024+r32*16; const lds_cptr vp0=shm3+LDS_V+((lane>>4)&1)*32+(lane&3)*8+(4*hi+((lane&15)>>2))*64;
  const int NT=SEQ/KVBLK;
  DMA_K(0,0);DMA_V(0,0);DMA_K(1,SLOTB);
  bf16x8 qr[4];
  #pragma unroll
  for(int d0=0;d0<4;++d0)qr[d0]=*reinterpret_cast<const bf16x8*>(&Qw[(long)r32*QP+d0*16+hi*8]);
  float mhat=0.f,l_reg=0.f;f32x16 o[2],negm;{float z0=(float)(tid>>12);asm volatile("":"+v"(z0));
  _Pragma("unroll") for(int r=0;r<16;++r){o[0][r]=z0;o[1][r]=z0;negm[r]=z0;}}asm volatile("":"+v"(negm));
  const int qrel=wid*QBLK+r32;
  #define CMASK(P0,P1,t) do{}while(0)
  bool resc=false;
  #define START(P0,P1) do{ const float rm=rowmax(P0,P1); resc=false; \
    { const float dl=rm; mhat=fadd_s(mhat,dl); \
      _Pragma("unroll") for(int r=0;r<16;++r){P0[r]=fsub_s(P0[r],dl);P1[r]=fsub_s(P1[r],dl);} \
      _Pragma("unroll") for(int r=0;r<16;++r)negm[r]=-mhat; asm volatile("":"+v"(negm)); } \
    _Pragma("unroll") for(int r=0;r<16;++r)P0[r]=__builtin_amdgcn_exp2f(P0[r]); }while(0)
  #define RESC() do{ if(resc){ asm volatile("s_waitcnt lgkmcnt(0)":::"memory"); \
      _Pragma("unroll") for(int d_=0;d_<2;++d_) _Pragma("unroll") for(int r=0;r<16;++r)o[d_][r]*=wsf[crow(r,hi)]; } }while(0)
  f32x16 pA0,pA1,pB0,pB1;
  int sl_prev=0,sl_cur=0,sl_next=SLOTB;
  #define ROT() do{sl_prev=sl_cur;sl_cur=sl_next;sl_next=(sl_next==(NSLOT-1)*SLOTB)?0:sl_next+SLOTB;}while(0)
  DMA_K(2,2*SLOTB);
  WAIT_BAR(3);
  qkt(pA0,pA1,Kbase,qr,negm,r32,hi);asm volatile("s_nop 15\n\ts_nop 7":"+v"(pA0),"+v"(pA1));CMASK(pA0,pA1,0);
  START(pA0,pA1);
  _Pragma("unroll") for(int r=0;r<16;++r)pA1[r]=__builtin_amdgcn_exp2f(pA1[r]);
  WAIT_BAR(0);
  DMA_K(3,0);DMA_V(1,SLOTB);
  ROT();
  kload8(kf,kp0+sl_cur);
  WAIT_BAR(2);
  s16x4 vlo[8],vhi[8]; u32x4 pw0,pw1,pw2,pw3;
  #define PKW(P,B) cvtpk_s(P[B],P[B+1])
  #define PAF(k) __builtin_bit_cast(bf16x8,pw##k)
  #define VFR(i) (bf16x8){vlo[i][0],vlo[i][1],vlo[i][2],vlo[i][3],vhi[i][0],vhi[i][1],vhi[i][2],vhi[i][3]}
  #define PIN(x) asm volatile("":"+v"(x))
  #define MX3(a,b,c) __builtin_fmaxf(__builtin_fmaxf((a),(b)),(c))
  #define GAPA(MF,A0,A1,A2,A3,W0,W1,PW) do{ MF; sacc+=A0; sacc+=A1; sacc+=A2; sacc+=A3; PIN(sacc); W0; W1; PIN(PW); SBAR(); }while(0)
  #define EX(v) __builtin_amdgcn_exp2f(v)
  #define GAPB(MF,X,B) do{ MF; X[B]=EX(X[B]); X[B+1]=EX(X[B+1]); X[B+2]=EX(X[B+2]); X[B+3]=EX(X[B+3]); PIN(X); SBAR(); }while(0)
  #define VRD(i) do{ vlo[i]=vtr(vp_+(((i)>>2)*4096+((i)&3)*1024)); vhi[i]=vtr(vp_+(((i)>>2)*4096+((i)&3)*1024+512)); }while(0)
  #define KRD(G,j) do{ if(G){ kload2(kf,kp0+sl_next,j); SBAR(); } }while(0)
  #define STEP(C0,C1,P0,P1,t,GK,GV,GL) do{ SBAR(); \
    const lds_cptr vp_=vp0+sl_prev; \
    VRD(0); SBAR(); float sacc=(P0[0]+P0[1]); \
    GAPA(C0=__builtin_amdgcn_mfma_f32_32x32x16_bf16(kf[0],qr[0],negm,0,0,0), P0[2],P0[3],P0[4],P0[5],     pw0[0]=PKW(P0,0), pw0[1]=PKW(P0,2), pw0); \
    VRD(4); SBAR(); GAPA(C1=__builtin_amdgcn_mfma_f32_32x32x16_bf16(kf[1],qr[0],negm,0,0,0), P0[6],P0[7],P0[8],P0[9],     pw0[2]=PKW(P0,4), pw0[3]=PKW(P0,6), pw0); \
    VRD(1); SBAR(); GAPA(C0=__builtin_amdgcn_mfma_f32_32x32x16_bf16(kf[2],qr[1],C0,0,0,0),   P0[10],P0[11],P0[12],P0[13], pw1[0]=PKW(P0,8), pw1[1]=PKW(P0,10), pw1); \
    VRD(5); SBAR(); GAPA(C1=__builtin_amdgcn_mfma_f32_32x32x16_bf16(kf[3],qr[1],C1,0,0,0),   P0[14],P0[15],P1[0],P1[1],   pw1[2]=PKW(P0,12),pw1[3]=PKW(P0,14), pw1); \
    VRD(2); SBAR(); GAPA(C0=__builtin_amdgcn_mfma_f32_32x32x16_bf16(kf[4],qr[2],C0,0,0,0),   P1[2],P1[3],P1[4],P1[5],     pw2[0]=PKW(P1,0), pw2[1]=PKW(P1,2), pw2); \
    VRD(6); SBAR(); GAPA(C1=__builtin_amdgcn_mfma_f32_32x32x16_bf16(kf[5],qr[2],C1,0,0,0),   P1[6],P1[7],P1[8],P1[9],     pw2[2]=PKW(P1,4), pw2[3]=PKW(P1,6), pw2); \
    VRD(3); SBAR(); GAPA(C0=__builtin_amdgcn_mfma_f32_32x32x16_bf16(kf[6],qr[3],C0,0,0,0),   P1[10],P1[11],P1[12],P1[13], pw3[0]=PKW(P1,8), pw3[1]=PKW(P1,10), pw3); \
    VRD(7); SBAR(); GAPA(C1=__builtin_amdgcn_mfma_f32_32x32x16_bf16(kf[7],qr[3],C1,0,0,0),   P1[14],P1[15],0.f,0.f,       pw3[2]=PKW(P1,12),pw3[3]=PKW(P1,14), pw3); \
    l_reg+=sacc; \
    if(GK){DMA_K((t)+3,sl_cur);} if(GV){DMA_V((t)+1,sl_next);} \
    CMASK(C0,C1,t); \
    { float a=MX3(C0[0],C0[1],C1[0]),b=MX3(C0[2],C0[3],C1[1]); a=MX3(a,C1[2],C1[3]); \
      _Pragma("unroll") for(int r=4;r<16;r+=4){a=MX3(a,C0[r],C0[r+1]);b=MX3(b,C0[r+2],C0[r+3]);a=MX3(a,C1[r],C1[r+1]);b=MX3(b,C1[r+2],C1[r+3]);} \
      float rm=__builtin_fmaxf(a,b); { auto rr=__builtin_amdgcn_permlane32_swap(__float_as_uint(rm),__float_as_uint(rm),false,false); rm=__builtin_fmaxf(__uint_as_float(rr[0]),__uint_as_float(rr[1])); } \
      resc=false; \
      if(__builtin_expect(__any(rm>(float)THRL),0)){ const float dl=__builtin_fmaxf(rm,0.f); mhat+=dl; \
        _Pragma("unroll") for(int r=0;r<16;++r){C0[r]-=dl;C1[r]-=dl;} \
        _Pragma("unroll") for(int r=0;r<16;++r)negm[r]=-mhat; asm volatile("":"+v"(negm)); \
        const float f=__builtin_amdgcn_exp2f(-dl); l_reg*=f; if(hi==0)wsf[r32]=f; resc=true; } } \
    SBAR(); \
    GAPB(o[0]=__builtin_amdgcn_mfma_f32_32x32x16_bf16(PAF(0),VFR(0),o[0],0,0,0), C0,0); \
    GAPB(o[1]=__builtin_amdgcn_mfma_f32_32x32x16_bf16(PAF(0),VFR(4),o[1],0,0,0), C0,4); \
    KRD(GL,0); GAPB(o[0]=__builtin_amdgcn_mfma_f32_32x32x16_bf16(PAF(1),VFR(1),o[0],0,0,0), C0,8); \
    KRD(GL,1); GAPB(o[1]=__builtin_amdgcn_mfma_f32_32x32x16_bf16(PAF(1),VFR(5),o[1],0,0,0), C0,12); \
    KRD(GL,2); GAPB(o[0]=__builtin_amdgcn_mfma_f32_32x32x16_bf16(PAF(2),VFR(2),o[0],0,0,0), C1,0); \
    KRD(GL,3); GAPB(o[1]=__builtin_amdgcn_mfma_f32_32x32x16_bf16(PAF(2),VFR(6),o[1],0,0,0), C1,4); \
    GAPB(o[0]=__builtin_amdgcn_mfma_f32_32x32x16_bf16(PAF(3),VFR(3),o[0],0,0,0), C1,8); \
    GAPB(o[1]=__builtin_amdgcn_mfma_f32_32x32x16_bf16(PAF(3),VFR(7),o[1],0,0,0), C1,12); \
    }while(0)
  int t=1;
  #undef CMASK
  #define CMASK(P0,P1,t) do{}while(0)
  for(;t+5<NT;t+=2){
    STEP(pB0,pB1,pA0,pA1,t,true,true,true);     WAIT_BAR(2); RESC(); ROT();
    STEP(pA0,pA1,pB0,pB1,t+1,true,true,true);   WAIT_BAR(2); RESC(); ROT();
  }
  #undef CMASK
  #define CMASK(P0,P1,t) do{}while(0)
  #define ENDW(tt) do{ if((tt)+3<NT){WAIT_BAR(2);} else if((tt)+2<NT){WAIT_BAR(1);} else {WAIT_BAR(0);} }while(0)
  for(;t+1<NT;t+=2){
    STEP(pB0,pB1,pA0,pA1,t,(t+3<NT),(t+1<NT),(t+1<NT));       ENDW(t);   RESC(); ROT();
    STEP(pA0,pA1,pB0,pB1,t+1,(t+4<NT),(t+2<NT),(t+2<NT));     ENDW(t+1); RESC(); ROT();
  }
  STEP(pB0,pB1,pA0,pA1,NT-1,false,false,false); RESC();
  { float sacc=pB0[0]+pB0[1]; _Pragma("unroll") for(int r=2;r<16;++r)sacc+=pB0[r]; _Pragma("unroll") for(int r=0;r<16;++r)sacc+=pB1[r]; l_reg+=sacc;
    pw0=(u32x4){PKW(pB0,0),PKW(pB0,2),PKW(pB0,4),PKW(pB0,6)};pw1=(u32x4){PKW(pB0,8),PKW(pB0,10),PKW(pB0,12),PKW(pB0,14)};pw2=(u32x4){PKW(pB1,0),PKW(pB1,2),PKW(pB1,4),PKW(pB1,6)};pw3=(u32x4){PKW(pB1,8),PKW(pB1,10),PKW(pB1,12),PKW(pB1,14)};
    SBAR(); pv(o,vb0+sl_cur,PAF(0),PAF(1),PAF(2),PAF(3)); }
  #undef PKW
  #undef PAF
  #undef VFR
  #undef PIN
  #undef MX3
  #undef GAPA
  #undef GAPB
  #undef EX
  #undef VRD
  #undef KRD
  #undef STEP
  #undef ENDW
  {auto rr=__builtin_amdgcn_permlane32_swap(__float_as_uint(l_reg),__float_as_uint(l_reg),false,false);l_reg=__uint_as_float(rr[0])+__uint_as_float(rr[1]);}
  if(hi==0)wsf[32+r32]=l_reg;asm volatile("s_waitcnt lgkmcnt(0)":::"memory");
  float rli[16];
  #pragma unroll
  for(int r=0;r<16;++r)rli[r]=__builtin_amdgcn_rcpf(wsf[32+crow(r,hi)]);
  bf16*Ow=O+(rowbase+q0+wid*QBLK)*OP+h*D;
  { bf16*stg=(bf16*)(shm+LDS_OST)+wid*2048;
    #pragma unroll
    for(int r=0;r<16;++r){const int orow=crow(r,hi);
      #pragma unroll
      for(int d0=0;d0<2;++d0)stg[orow*64+d0*32+r32]=__float2bfloat16(o[d0][r]*rli[r]);}
    asm volatile("s_waitcnt lgkmcnt(0)":::"memory");
    #pragma unroll
    for(int i=0;i<4;++i){const int row=i*8+(lane>>3),ch=lane&7; const u32x4 v=*(const u32x4*)(stg+row*64+ch*8); ATTN_STORE16(Ow+(long)row*OP+ch*8,v);} }
  asm volatile("s_waitcnt lgkmcnt(0)\n\ts_barrier":::"memory");
  #undef DMA_K
  #undef DMA_V
  #undef CMASK
  #undef START
  #undef RESC
  #undef ROT
}
constexpr int ATTN_LDS_BYTES=LDS_BYTES;
__device__ __forceinline__ void attn_phase_dense(char*lds,const bf16*Q,const bf16*K,const bf16*V,bf16*O,int vcu,int G,const int tid){
  for(int u=vcu;u<512;u+=G){ const int x=u>>6, j=u&63; attn_unit<8>(x>>1, 4*(x&1)+(j>>4), j&15, Q,K,V,O,lds,tid); }
}
#undef SBAR
#undef WAIT_BAR
}

constexpr int STEPS_PER_LAYER = 7;
constexpr int NPHASES = 1 + DEPTH * STEPS_PER_LAYER + 1;

__global__ void __launch_bounds__(NT, 2) mk_fwd(Args args) {
    extern __shared__ __attribute__((aligned(16))) unsigned char lds_raw[];
    Ctx c0;
    c0.lds = (LAS unsigned char*)lds_raw;
    c0.tid = threadIdx.x; c0.lane = c0.tid & 63; c0.wave = __builtin_amdgcn_readfirstlane(c0.tid >> 6);
    c0.G = gridDim.x; { const int bx = blockIdx.x; c0.vcu = (c0.G % 8 == 0) ? (bx % 8) * (c0.G / 8) + bx / 8 : bx; }
    volatile LAS unsigned* misc = (volatile LAS unsigned*)(c0.lds + LDS_BYTES - 64);
    if (c0.tid < 16) misc[c0.tid] = 0u;
    if (c0.tid < 25) { const unsigned long long v = (c0.tid < 23) ? (unsigned long long)args.in[c0.tid] : (c0.tid == 23 ? (unsigned long long)args.out : (unsigned long long)args.ws);
        volatile LAS unsigned* p = (volatile LAS unsigned*)(c0.lds + ARGS_OFF) + 2 * c0.tid; p[0] = (unsigned)v; p[1] = (unsigned)(v >> 32); }
    __syncthreads();
    const int ph_lo = args.ph_lo, ph_hi = args.ph_hi;
    XcdBarrier bar; bar.bar = nullptr; bar.x = 0; bar.st = misc;
    const bool multi = (ph_hi - ph_lo) > 1;
    bool vid_done = false; c0.vid = c0.vcu;
    if (multi) bar = xcd_barrier_post((unsigned*)((unsigned char*)inp(c0, 24) + WS_CTL) + 4096, misc);

    for (int pc = 2 * ph_lo; pc < 2 * ph_hi; ++pc) {
        const int ph = pc >> 1, rep = pc & 1;
        const int st_ = (ph == 0) ? 20 : ((ph == NPHASES - 1) ? 21 : (ph - 1) % STEPS_PER_LAYER);
        if (rep && (st_ != PROBE_STEP || (PROBE_PARITY >= 0 && st_ < 20 && (((ph - 1) / STEPS_PER_LAYER) & 1) != PROBE_PARITY))) continue;
        if (pc > 2 * ph_lo) {
            xcd_barrier(bar);
            if (PROBE_STEP == 30) { xcd_barrier(bar); xcd_barrier(bar); xcd_barrier(bar); }
            if (!vid_done) {
                if (c0.tid == 0) { unsigned before = 0u;
#pragma unroll
                    for (unsigned j = 0; j < 16; ++j) { const unsigned n = xb_ld(&bar.bar[XB_XCNT(j)]); before += (j < bar.x) ? n : 0u; }
                    misc[3] = before + misc[2]; }
                __syncthreads();
                c0.vid = __builtin_amdgcn_readfirstlane((int)misc[3]); vid_done = true;
            }
        }
        Ctx c = c0;
        int zero_ = 0;
        asm volatile("" : "+s"(c.wave), "+s"(c.vcu), "+s"(c.vid), "+s"(zero_));
        c.lane = (int)__builtin_amdgcn_mbcnt_hi(~0u, __builtin_amdgcn_mbcnt_lo(~0u, (unsigned)zero_)); c.tid = c.wave * 64 + c.lane;
        unsigned char* ws = (unsigned char*)inp(c, 24);
#define xres ((float*)(ws + WS_XRES))
#define hb ((bf16*)(ws + WS_HB))
#define ycat ((bf16*)(ws + WS_YCAT))
#define z ((float*)(ws + WS_Z))
#define qp ((bf16*)(ws + WS_QP))
#define qb ((bf16*)(ws + WS_QB))
#define kb ((bf16*)(ws + WS_KB))
#define vt ((bf16*)(ws + WS_VT))
#define glu ((float*)(ws + WS_GLU))
#define vn ((bf16*)(ws + WS_VN))
#define eidx ((int*)(ws + WS_EIDX))
#define gate ((float*)(ws + WS_GATE))
#define rope ((const float*)(ws + WS_ROPE))
#define SSQA(l_) ((float*)(ws + WS_SSQ) + (size_t)(l_) * T * 8)
#define SSQB(l_) ((float*)(ws + WS_SSQ) + (size_t)5 * T * 8 + (size_t)(l_) * T * 16)
        if (ph == 0) phase_prologue(c, ws);
        else if (ph == NPHASES - 1) phase_final(c, xres, inp(c, 3), (float*)inp(c, 23));
        else {
            const int l = (ph - 1) / STEPS_PER_LAYER, st = (ph - 1) % STEPS_PER_LAYER, i = l >> 1; const bool odd = l & 1;
            switch (st) {
            case 0: { pg8::Gemm g{hb, (const bf16*)(ws + WS_WIN) + (size_t)l * NIN * D, T, NIN, D}; pg8::StaticOrder S; S.init(T, NIN, c.G, (int)blockIdx.x);
                if (!odd) { pg8::EpiEven E{SSQA(l), rope, glu, qb, kb, vt}; pg8::gemm_phase<pg8::EpiEven, pg8::StaticOrder, true, true>(c.lds, g, S, E, c.tid); }
                else { pg8::EpiOdd E{SSQA(l), rope + (size_t)2 * SEQ * 32, inp(c, 13) + i * 64, inp(c, 14) + i * 64, glu, vn, (float*)(ws + WS_LNP), qb, kb, vt, c.lane};
                       pg8::gemm_phase<pg8::EpiOdd, pg8::StaticOrder, true, true>(c.lds, g, S, E, c.tid); } } break;
            case 1:
                if (!odd) {
                    for (int it = c.vcu; it < 512; it += c.G) attn_item<true>(c, it, qb, kb, vt, ycat, 512, inp(c, 10) + i * 8);
                    for (int it = c.vcu; it < 512; it += c.G) conv_item(c, it, glu, inp(c, 6) + (size_t)i * 31 * 512, inp(c, 7) + i * 512, inp(c, 8) + i * 512, inp(c, 9) + i * 512, ycat);
                } else {
                    attn_body::attn_phase_dense((char*)lds_raw, (const __hip_bfloat16*)qb, (const __hip_bfloat16*)kb, (const __hip_bfloat16*)vt, (__hip_bfloat16*)ycat, c.vcu, c.G, c.tid);
                    for (int it = c.vcu; it < 512; it += c.G) sgu_item(c, it, inp(c, 17) + (size_t)i * 4 * 128 * 128, inp(c, 18) + i * 512, vn, (const float*)(ws + WS_LNP), inp(c, 15) + i * 512, inp(c, 16) + i * 512, glu, ycat);
                }
                break;
            case 2: { pg8::Gemm g{ycat, (const bf16*)(ws + WS_WOUT) + (size_t)l * D * D, T, D, D}; pg8::StaticOrder S; S.init(T, D, c.G, (int)blockIdx.x);
                if (rep) { pg8::EpiF32 E{z, D, nullptr}; pg8::gemm_phase<pg8::EpiF32, pg8::StaticOrder, true, true>(c.lds, g, S, E, c.tid); }
                else { pg8::EpiRes E{D, hb, SSQB(l), ws + WS_X8}; pg8::gemm_phase<pg8::EpiRes, pg8::StaticOrder, false, true>(c.lds, g, S, E, c.tid); } } break;
            case 3: { pg8::Gemm g{hb, (const bf16*)(ws + WS_WQ) + (size_t)l * D * D, T, D, D}; pg8::StaticOrder S; S.init(T, D, c.G, (int)blockIdx.x); pg8::EpiBf16Scale E{qp, D, SSQB(l)};
                pg8::gemm_phase<pg8::EpiBf16Scale, pg8::StaticOrder, true, true>(c.lds, g, S, E, c.tid);
                pg8::Unit u;
                for (int ui = 0; S.next(ui, u); ++ui) {
                    const bf16* skl = (const bf16*)(ws + WS_SK) + (size_t)l * 16 * 128 * 64;
                    __syncthreads();
#pragma unroll
                    for (int i2 = 0; i2 < 8; ++i2) { const int idx = c.tid + NT * i2, row = idx >> 3, ch = idx & 7;
                        *(LAS u32x4*)(c.lds + row * 144 + ch * 16) = *(const u32x4*)(skl + (size_t)(2 * u.pn) * 2 * 128 * 64 + (size_t)row * 64 + ch * 8); }
                    __syncthreads();
                    for (int hh = 0; hh < 2; ++hh) route_item(c, u.pm * 8 + 2 * u.pn + hh, qp, skl, eidx, gate, false, hh * 256 * 144);
                } } break;
            case 4: { const int lg = __builtin_ctz(c.G) - 3, nq = 1 << lg, q = c.vid >> lg, rq = c.vid & (nq - 1);
                gu_wave(c, q, rq * NWAVES + c.wave, nq * NWAVES, ws + WS_X8, eidx, ws + WS_UB + (size_t)l * PEER_E * D, (bf16*)z, DEPTH, inp(c, 21), inp(c, 22), inp(c, 2), ws); } break;
            case 5: phase_w(c, (const bf16*)z, eidx, gate, (const float*)(ws + WS_SCL) + (size_t)l * PEER_E, (const float*)(ws + WS_SCL) + (size_t)(DEPTH + l) * PEER_E, SSQB(l), (float*)(ws + WS_WB), rep ? DEPTH : l + 1, inp(c, 21), inp(c, 22), inp(c, 2), ws); break;
            case 6: { const int lg = __builtin_ctz(c.G) - 3, nq = 1 << lg, q = c.vid >> lg, rq = c.vid & (nq - 1);
                gv_wave(c, q, rq * NWAVES + c.wave, nq * NWAVES, eidx, (const float*)(ws + WS_WB), ws + WS_VB + (size_t)l * PEER_E * D, rep ? PROBE_EMASK : -1, hb, (!rep && l == DEPTH - 1) ? xres : nullptr, rep ? nullptr : SSQA(l + 1)); } break;
            }
        }
    }
}
#undef xres
#undef hb
#undef ycat
#undef z
#undef qp
#undef qb
#undef kb
#undef vt
#undef glu
#undef vn
#undef eidx
#undef gate
#undef rope
#undef SSQA
#undef SSQB
}

extern "C" void kernel_launch(void* const* d_in, const int* in_sizes, int n_in, void* d_out, int out_size, void* d_ws, size_t ws_size, hipStream_t stream) {
    static int grid = 0;
    if (grid == 0) {
        if (n_in != 23 || out_size != T * D || ws_size < WS_END) { fprintf(stderr, "kernel_launch: unexpected shapes n_in %d out %d ws %zu (need %zu)\n", n_in, out_size, ws_size, (size_t)WS_END); grid = -1; return; }
        int dev = 0, cus = 0;
        if (hipGetDevice(&dev) != hipSuccess || hipDeviceGetAttribute(&cus, hipDeviceAttributeMultiprocessorCount, dev) != hipSuccess) { grid = -1; return; }
        if (hipFuncSetAttribute((const void*)mk_fwd, hipFuncAttributeMaxDynamicSharedMemorySize, LDS_BYTES) != hipSuccess) { fprintf(stderr, "kernel_launch: hipFuncSetAttribute failed\n"); grid = -1; return; }
        (void)hipGetLastError();
        grid = 8; while (grid * 2 <= cus) grid *= 2;
    }
    if (grid < 0) return;
    (void)hipMemsetAsync((char*)d_ws + WS_CTL, 0, 1 * MiB, stream);
    Args a{};
    for (int i = 0; i < 23; ++i) a.in[i] = (const float*)d_in[i];
    a.out = (float*)d_out; a.ws = (unsigned char*)d_ws;
#if MK_ONE_LAUNCH
    a.ph_lo = 0; a.ph_hi = NPHASES;
    hipLaunchKernelGGL(mk_fwd, dim3(grid), dim3(NT), LDS_BYTES, stream, a);
#else
    for (int p = 0; p < NPHASES; ++p) { a.ph_lo = p; a.ph_hi = p + 1; hipLaunchKernelGGL(mk_fwd, dim3(grid), dim3(NT), LDS_BYTES, stream, a); }
#endif
}
```

```cpp
#include <hip/hip_runtime.h>
#include <hip/hip_bf16.h>
#include <cmath>
#include <cstdio>
#include <cstdint>

#ifndef MK_ONE_LAUNCH
#define MK_ONE_LAUNCH 1
#endif
#ifndef PROBE_EMASK
#define PROBE_EMASK -1
#endif
#ifndef PROBE_PARITY
#define PROBE_PARITY -1
#endif
#ifndef PROBE_LITE
#define PROBE_LITE 0
#endif
#ifndef CONV_SITE
#define CONV_SITE 1
#endif
#ifndef TABLES0_IN_MIXER
#define TABLES0_IN_MIXER 1
#endif
#ifndef CONV_SHADOW
#define CONV_SHADOW 1
#endif
constexpr int SHADOW_RR = 12 * 2048;
#ifndef W_PREFETCH
#define W_PREFETCH 1
#endif
#ifndef PROBE_STEP
#define PROBE_STEP -1
#endif

namespace {
constexpr int D = 1024, BATCH = 4, SEQ = 4096, T = BATCH * SEQ, DEPTH = 4;
constexpr int NIN = 1792, HD = 64, NQH = 8, NKVH = 2;
constexpr int PEER_E = 16384;
constexpr float EPS = 1e-6f;
constexpr float LOG2E = 1.4426950408889634f;
constexpr int NWAVES = 8, NT = NWAVES * 64;

constexpr size_t MiB = 1u << 20;
constexpr size_t WS_CTL = 0;
constexpr size_t WS_XRES = 1 * MiB;
constexpr size_t WS_HB = WS_XRES + 64 * MiB;
constexpr size_t WS_YCAT = WS_HB + 32 * MiB;
constexpr size_t WS_Z = WS_YCAT + 32 * MiB;
constexpr size_t WS_QP = WS_Z + 128 * MiB;
constexpr size_t WS_QB = WS_QP + 32 * MiB;
constexpr size_t WS_KB = WS_QB + 16 * MiB;
constexpr size_t WS_VT = WS_KB + 4 * MiB;
constexpr size_t WS_GLU = WS_VT + 4 * MiB;
constexpr size_t WS_VN = WS_GLU + 32 * MiB;
constexpr size_t WS_EIDX = WS_VN + 16 * MiB;
constexpr size_t WS_GATE = WS_EIDX + 8 * MiB;
constexpr size_t WS_WIN = WS_GATE + 8 * MiB;
constexpr size_t WS_WOUT = WS_WIN + 14 * MiB;
constexpr size_t WS_WQ = WS_WOUT + 8 * MiB;
constexpr size_t WS_SK = WS_WQ + 8 * MiB;
constexpr size_t WS_ROPE = WS_SK + 1 * MiB;
constexpr size_t WS_SCL = WS_ROPE + 2 * MiB;
constexpr size_t WS_X8 = WS_SCL + 1 * MiB;
constexpr size_t WS_SSQ = WS_X8 + 16 * MiB;
constexpr size_t WS_LNP = WS_SSQ + 8 * MiB;
constexpr size_t WS_WB = WS_LNP + 1 * MiB;
constexpr size_t WS_UB = WS_WB + 8 * MiB;
constexpr size_t WS_VB = WS_UB + 128 * MiB;
constexpr size_t WS_END = WS_VB + 128 * MiB;

constexpr int LDS_BYTES = 147456;

#define LAS __attribute__((address_space(3)))
typedef unsigned short bf16;
typedef short bf16x8 __attribute__((ext_vector_type(8)));
typedef float f32x4 __attribute__((ext_vector_type(4)));
typedef float f32x16 __attribute__((ext_vector_type(16)));
typedef unsigned u32x4 __attribute__((ext_vector_type(4)));
typedef unsigned u32x2 __attribute__((ext_vector_type(2)));
#define DI __device__ __forceinline__
#define MFMA32(a, b, c) __builtin_amdgcn_mfma_f32_32x32x16_bf16((a), (b), (c), 0, 0, 0)

typedef float f32x2 __attribute__((ext_vector_type(2)));
typedef __bf16 bf16x2_t __attribute__((ext_vector_type(2)));
DI unsigned f2bf(float f) { return (unsigned)__builtin_bit_cast(unsigned short, (__bf16)f); }
DI unsigned pk2(float lo, float hi) { const f32x2 v = {lo, hi}; return __builtin_bit_cast(unsigned, __builtin_convertvector(v, bf16x2_t)); }
DI float bf_lo(unsigned w) { return __uint_as_float(w << 16); }
DI float bf_hi(unsigned w) { return __uint_as_float(w & 0xffff0000u); }
DI float wave_sum(float v) {
#pragma unroll
    for (int o = 1; o < 64; o <<= 1) v += __shfl_xor(v, o);
    return v;
}
#define DPP_ADD(v, ctrl) ((v) + __builtin_bit_cast(float, __builtin_amdgcn_update_dpp(0, __builtin_bit_cast(int, (v)), (ctrl), 0xF, 0xF, true)))
DI float swap16_sum(float v) { const auto r = __builtin_amdgcn_permlane16_swap(__float_as_uint(v), __float_as_uint(v), false, false); return __uint_as_float(r[0]) + __uint_as_float(r[1]); }
DI float swap32_sum(float v) { const auto r = __builtin_amdgcn_permlane32_swap(__float_as_uint(v), __float_as_uint(v), false, false); return __uint_as_float(r[0]) + __uint_as_float(r[1]); }
DI float wave_sum_fast(float v) {
    v = DPP_ADD(v, 0xB1); v = DPP_ADD(v, 0x4E); v = DPP_ADD(v, 0x141); v = DPP_ADD(v, 0x140);
    v = swap16_sum(v); v = swap32_sum(v);
    return v;
}
DI float xor32f(float v, int lane) { const auto r = __builtin_amdgcn_permlane32_swap(__float_as_uint(v), __float_as_uint(v), false, false); return __uint_as_float((lane & 32) ? r[0] : r[1]); }
DI unsigned pack_i8x4(float a, float b, float c_, float d) {
    unsigned p = __builtin_amdgcn_cvt_pk_u8_f32(__builtin_rintf(a + 128.0f), 0, 0u);
    p = __builtin_amdgcn_cvt_pk_u8_f32(__builtin_rintf(b + 128.0f), 1, p);
    p = __builtin_amdgcn_cvt_pk_u8_f32(__builtin_rintf(c_ + 128.0f), 2, p);
    p = __builtin_amdgcn_cvt_pk_u8_f32(__builtin_rintf(d + 128.0f), 3, p);
    return p ^ 0x80808080u;
}
DI float sigmoidf_(float x) { return __builtin_amdgcn_rcpf(1.0f + __builtin_amdgcn_exp2f(-1.4426950408889634f * x)); }
DI float gelu_tanh(float x) {
    const float t = x * x, p = fmaf(t, -2.0f * 0.7978845608028654f * 1.4426950408889634f * 0.044715f, -2.0f * 0.7978845608028654f * 1.4426950408889634f);
    return x * __builtin_amdgcn_rcpf(1.0f + __builtin_amdgcn_exp2f(x * p));
}
DI int crow(int reg, int h) { return (reg & 3) + 8 * (reg >> 2) + 4 * h; }

struct Args {
    const float* in[23];
    float* out;
    unsigned char* ws;
    int ph_lo, ph_hi;
};

struct Ctx {
    LAS unsigned char* lds;
    int tid, lane, wave, vcu, G, vid;
};
constexpr int ARGS_OFF = 147456 - 512;
DI const float* inp(const Ctx& c, int k) {
    volatile LAS unsigned* p = (volatile LAS unsigned*)(c.lds + ARGS_OFF) + 2 * k;
    const unsigned lo = __builtin_amdgcn_readfirstlane(p[0]), hi = __builtin_amdgcn_readfirstlane(p[1]);
    return (const float*)(const float __attribute__((address_space(1)))*)(((unsigned long long)hi << 32) | lo);
}

#define XB_TMO      128
#define XB_XCNT(j)  (256  + 64 * (j))
#define XB_XSUB(j)  (1280 + 64 * (j))
#define XB_XGEN(j)  (2304 + 64 * (j))
#define XB_TOP      3328
#define XB_TOPGEN   3392
#define XCD_BAR_WORDS 3456
#define XB_SPIN_CAP (1u << 22)
DI unsigned xb_ld(unsigned* p) { return __hip_atomic_load(p, __ATOMIC_RELAXED, __HIP_MEMORY_SCOPE_AGENT); }
DI unsigned xb_add(unsigned* p, unsigned v) { return __hip_atomic_fetch_add(p, v, __ATOMIC_RELAXED, __HIP_MEMORY_SCOPE_AGENT); }
DI unsigned xb_xcc_id() { return (unsigned)__builtin_amdgcn_s_getreg((3 << 11) | 20) & 0xFu; }
#define XB_SPIN(cond, bar) do { unsigned _sp = 0; while (cond) { __builtin_amdgcn_s_sleep(1); \
    if ((++_sp & 255u) == 0u) { if (xb_ld(&(bar)[XB_TMO])) break; if (_sp > XB_SPIN_CAP) { atomicAdd(&(bar)[XB_TMO], 1u); break; } } } } while (0)
struct XcdBarrier { unsigned* bar; unsigned x; volatile LAS unsigned* st; };
DI XcdBarrier xcd_barrier_post(unsigned* bar, volatile LAS unsigned* st) {
    XcdBarrier b; b.bar = bar; b.x = xb_xcc_id(); b.st = st;
    if (threadIdx.x == 0) st[2] = xb_add(&bar[XB_XCNT(b.x)], 1u);
    return b;
}
DI void xcd_barrier_complete(unsigned* bar, unsigned x, unsigned& nloc, unsigned& nx) {
    const unsigned G = gridDim.x * gridDim.y * gridDim.z;
    unsigned sum, cnt, mine, sp = 0u;
    for (;;) {
        sum = 0u; cnt = 0u; mine = 0u;
#pragma unroll
        for (unsigned j = 0; j < 16; ++j) { const unsigned c = xb_ld(&bar[XB_XCNT(j)]); sum += c; cnt += (c > 0u) ? 1u : 0u; mine = (j == x) ? c : mine; }
        if (sum == G) break;
        __builtin_amdgcn_s_sleep(1);
        if ((++sp & 255u) == 0u) { if (xb_ld(&bar[XB_TMO])) break; if (sp > XB_SPIN_CAP) { atomicAdd(&bar[XB_TMO], 1u); break; } }
    }
    nloc = mine > 0u ? mine : 1u; nx = cnt > 0u ? cnt : 1u;
}
DI void xcd_barrier_thread0(const XcdBarrier& b) {
    {
        unsigned* bar = b.bar;
        __builtin_amdgcn_s_waitcnt(0);
        unsigned nloc = b.st[0], nx = b.st[1];
        if (nloc == 0u) { xcd_barrier_complete(bar, b.x, nloc, nx); b.st[0] = nloc; b.st[1] = nx; }
        const unsigned old = xb_add(&bar[XB_XSUB(b.x)], 1u);
        const unsigned gen = old / nloc;
        if (old + 1u == (gen + 1u) * nloc) {
            __builtin_amdgcn_fence(__ATOMIC_RELEASE, "agent");
            asm volatile("s_waitcnt vmcnt(0)" ::: "memory");
            const unsigned og = xb_add(&bar[XB_TOP], 1u);
            const unsigned tg = og / nx;
            if (og + 1u == (tg + 1u) * nx) xb_add(&bar[XB_TOPGEN], 1u);
            else XB_SPIN(xb_ld(&bar[XB_TOPGEN]) == tg, bar);
            __builtin_amdgcn_fence(__ATOMIC_ACQUIRE, "agent");
            xb_add(&bar[XB_XGEN(b.x)], 1u);
            asm volatile("s_waitcnt vmcnt(0)" ::: "memory");
        } else {
            XB_SPIN(xb_ld(&bar[XB_XGEN(b.x)]) == gen, bar);
            __builtin_amdgcn_fence(__ATOMIC_ACQUIRE, "agent");
            asm volatile("s_waitcnt vmcnt(0)" ::: "memory");
        }
    }
}
DI void xcd_barrier(const XcdBarrier& b) {
    asm volatile("s_waitcnt vmcnt(0)" ::: "memory");
    __syncthreads();
    if (threadIdx.x == 0) xcd_barrier_thread0(b);
    __syncthreads();
}

DI int blkperm_even(int nb) {
    if (nb < 16) return 8 * (nb >> 2) + (nb & 3);
    if (nb < 32) { const int x = nb - 16; return 8 * (x >> 2) + 4 + (x & 3); }
    if (nb < 48) { const int x = nb - 32, head = x >> 1, half = x & 1; return 8 * (4 + (head >> 2)) + 4 * half + (head & 3); }
    if (nb < 52) { const int x = nb - 48, head = x >> 1, half = x & 1; return 48 + 4 * half + head; }
    { const int x = nb - 52, head = x >> 1, part = x & 1; return 48 + 4 * head + 2 + part; }
}
DI int blkperm_odd(int nb) {
    if (nb < 16) { const int head = nb >> 1, half = nb & 1; return 8 * (head >> 2) + 4 * half + (head & 3); }
    if (nb < 20) { const int x = nb - 16, head = x >> 1, half = x & 1; return 16 + 4 * half + head; }
    if (nb < 24) { const int x = nb - 20, head = x >> 1, part = x & 1; return 16 + 4 * head + 2 + part; }
    return nb;
}
DI void transpose_item(const float* W, int K, int N, bf16* WT, LAS float* scr, int item, int lane, const float* gk, int perm) {
    const int nblk = N / 32, kb = item / nblk, nb = item % nblk, k0 = 64 * kb, n0 = 32 * nb, nd0 = 32 * (perm == 1 ? blkperm_even(nb) : perm == 2 ? blkperm_odd(nb) : nb);
#pragma unroll
    for (int i = 0; i < 8; ++i) { const int kk = 8 * i + (lane >> 3), nn = 4 * (lane & 7);
        const f32x4 w4 = *(const f32x4*)(W + (size_t)(k0 + kk) * N + n0 + nn) * (gk ? gk[k0 + kk] : 1.0f);
        scr[kk * 33 + nn] = w4.x; scr[kk * 33 + nn + 1] = w4.y; scr[kk * 33 + nn + 2] = w4.z; scr[kk * 33 + nn + 3] = w4.w; }
    asm volatile("s_waitcnt lgkmcnt(0)" ::: "memory");
    const int c = lane & 7;
#pragma unroll
    for (int j = 0; j < 4; ++j) { const int n = (lane >> 3) + 8 * j; const LAS float* s = scr + (8 * c) * 33 + n;
        u32x4 o; o.x = pk2(s[0 * 33], s[1 * 33]); o.y = pk2(s[2 * 33], s[3 * 33]); o.z = pk2(s[4 * 33], s[5 * 33]); o.w = pk2(s[6 * 33], s[7 * 33]);
        *(u32x4*)(WT + (size_t)(nd0 + n) * K + k0 + 8 * c) = o; }
    asm volatile("s_waitcnt lgkmcnt(0)" ::: "memory");
}
DI void cvt_stream(const float* src, bf16* dst, size_t n8, size_t gtid, size_t gthreads) {
    for (size_t i = gtid; i < n8; i += gthreads) {
        const f32x4 a = *(const f32x4*)(src + i * 8), b = *(const f32x4*)(src + i * 8 + 4);
        u32x4 o; o.x = pk2(a.x, a.y); o.y = pk2(a.z, a.w); o.z = pk2(b.x, b.y); o.w = pk2(b.z, b.w);
        *(u32x4*)(dst + i * 8) = o;
    }
}

struct TabRow { f32x4 v[4]; };
DI void tabrow_load(TabRow& k, int lane, int lyr, int r, const float* usrc, const float* vsrc) {
    const int tab = r >= PEER_E, er = tab ? r - PEER_E : r;
    const unsigned char* srow = (const unsigned char*)((tab ? vsrc : usrc) + ((size_t)lyr * PEER_E + er) * D);
#pragma unroll
    for (int j = 0; j < 4; ++j) k.v[j] = __builtin_nontemporal_load((const f32x4*)(srow + (unsigned)(lane * 16 + j * 1024)));
}
template <typename GP>
DI void tabrow_finish(TabRow& k, int lane, int lyr, int r, GP fgl, unsigned char* ws) {
    const int tab = r >= PEER_E, er = tab ? r - PEER_E : r;
    float am = 0.f;
    if (!tab) {
#pragma unroll
        for (int j = 0; j < 4; ++j) k.v[j] = k.v[j] * fgl[lane + 64 * j];
    }
#pragma unroll
    for (int j = 0; j < 4; ++j) am = fmaxf(am, fmaxf(fmaxf(fabsf(k.v[j].x), fabsf(k.v[j].y)), fmaxf(fabsf(k.v[j].z), fabsf(k.v[j].w))));
    am = fmaxf(am, __builtin_bit_cast(float, __builtin_amdgcn_update_dpp(0, __builtin_bit_cast(int, am), 0xB1, 0xF, 0xF, true)));
    am = fmaxf(am, __builtin_bit_cast(float, __builtin_amdgcn_update_dpp(0, __builtin_bit_cast(int, am), 0x4E, 0xF, 0xF, true)));
    am = fmaxf(am, __builtin_bit_cast(float, __builtin_amdgcn_update_dpp(0, __builtin_bit_cast(int, am), 0x141, 0xF, 0xF, true)));
    am = fmaxf(am, __builtin_bit_cast(float, __builtin_amdgcn_update_dpp(0, __builtin_bit_cast(int, am), 0x140, 0xF, 0xF, true)));
    { const auto p = __builtin_amdgcn_permlane16_swap(__float_as_uint(am), __float_as_uint(am), false, false); am = fmaxf(__uint_as_float(p[0]), __uint_as_float(p[1])); }
    { const auto p = __builtin_amdgcn_permlane32_swap(__float_as_uint(am), __float_as_uint(am), false, false); am = fmaxf(__uint_as_float(p[0]), __uint_as_float(p[1])); }
    float sc = 1.f;
    if (am > 0.f) sc = tab ? __uint_as_float(__float_as_uint(448.0f / am) & 0x7F800000u) : 127.0f / am;
    unsigned char* drow = ws + (tab ? WS_VB : WS_UB) + (size_t)lyr * PEER_E * D + (size_t)er * 128;
    const unsigned dlo = (unsigned)(((4 * lane) & 127) + (lane >> 5) * (PEER_E * 128));
    if (tab) {
#pragma unroll
        for (int j = 0; j < 4; ++j) { int p = __builtin_amdgcn_cvt_pk_fp8_f32(k.v[j].x * sc, k.v[j].y * sc, 0, false); p = __builtin_amdgcn_cvt_pk_fp8_f32(k.v[j].z * sc, k.v[j].w * sc, p, true);
            __builtin_nontemporal_store((unsigned)p, (unsigned*)(drow + (size_t)(2 * j) * (PEER_E * 128) + dlo)); }
    } else {
#pragma unroll
        for (int j = 0; j < 4; ++j) { const unsigned p = pack_i8x4(k.v[j].x * sc, k.v[j].y * sc, k.v[j].z * sc, k.v[j].w * sc);
            __builtin_nontemporal_store(p, (unsigned*)(drow + (size_t)(2 * j) * (PEER_E * 128) + dlo)); }
    }
    if (lane == 0) ((float*)(ws + WS_SCL))[(size_t)(tab * DEPTH + lyr) * PEER_E + er] = 1.0f / sc;
}
DI void phase_prologue(const Ctx& c, unsigned char* ws) {
    LAS float* scr = (LAS float*)(c.lds + c.wave * 8704);
    const int gw = c.vcu * NWAVES + c.wave, NGW = c.G * NWAVES;
    constexpr int I_IN = (D / 64) * (NIN / 32), I_SQ = (D / 64) * (D / 32), I_L = I_IN + 2 * I_SQ;
    for (int it = gw; it < DEPTH * I_L; it += NGW) {
        const int l = it / I_L; int r = it % I_L; const int i = l >> 1;
        if (r < I_IN) { const float* W = inp(c, (l & 1) ? 11 : 4) + (size_t)i * D * NIN;
            transpose_item(W, D, NIN, (bf16*)(ws + WS_WIN) + (size_t)l * NIN * D, scr, r, c.lane, inp(c, 1) + (size_t)l * D, (l & 1) ? 2 : 1); continue; }
        r -= I_IN;
        if (r < I_SQ) { const float* W = inp(c, (l & 1) ? 12 : 5) + (size_t)i * D * D;
            transpose_item(W, D, D, (bf16*)(ws + WS_WOUT) + (size_t)l * D * D, scr, r, c.lane, nullptr, 0); continue; }
        r -= I_SQ;
        transpose_item(inp(c, 19) + (size_t)l * D * D, D, D, (bf16*)(ws + WS_WQ) + (size_t)l * D * D, scr, r, c.lane, inp(c, 2) + (size_t)l * D, 0);
    }
    const size_t gtid = (size_t)c.vcu * NT + c.tid, gth = (size_t)c.G * NT;
    cvt_stream(inp(c, 20), (bf16*)(ws + WS_SK), (size_t)DEPTH * 16 * 128 * 64 / 8, gtid, gth);
    if (!TABLES0_IN_MIXER) {
        const float* usrc = inp(c, 21); const float* vsrc = inp(c, 22); const float* fg = inp(c, 2);
        for (int r0 = gw; r0 < 2 * PEER_E; r0 += 4 * NGW) {
            TabRow R[4];
#pragma unroll
            for (int k = 0; k < 4; ++k) tabrow_load(R[k], c.lane, 0, r0 + k * NGW < 2 * PEER_E ? r0 + k * NGW : r0, usrc, vsrc);
#pragma unroll
            for (int k = 0; k < 4; ++k) if (r0 + k * NGW < 2 * PEER_E) tabrow_finish(R[k], c.lane, 0, r0 + k * NGW, (const f32x4*)fg, ws);
        }
    }
    { const float* xin = inp(c, 0); float* ssq = (float*)(ws + WS_SSQ);
      for (int m = gw; m < T; m += NGW) {
          const f32x4* xr = (const f32x4*)(xin + (size_t)m * D) + c.lane;
          u32x2* o8 = (u32x2*)(ws + WS_HB + (size_t)m * D * 2) + c.lane; float sq = 0.f;
#pragma unroll
          for (int j = 0; j < 4; ++j) { const f32x4 v = xr[64 * j]; sq += (v.x * v.x + v.y * v.y) + (v.z * v.z + v.w * v.w);
              u32x2 o; o.x = pk2(v.x, v.y); o.y = pk2(v.z, v.w); o8[64 * j] = o; }
          sq = wave_sum_fast(sq); if (c.lane < 8) ssq[(size_t)m * 8 + c.lane] = c.lane ? 0.f : sq; } }
    float* rope = (float*)(ws + WS_ROPE);
    for (size_t i = gtid; i < (size_t)SEQ * 32; i += gth) {
        const int pos = (int)(i >> 5), fi = (int)(i & 31);
        const float inv = exp2f(-(float)(2 * fi) * (13.287712379549449f / 64.0f));
        const float ang = (float)pos * inv;
        const float rh = ang * 0.15915493667125702f, re = fmaf(ang, 0.15915493667125702f, -rh) + ang * 6.4206382432985265e-09f;
        const float fr = (rh - rintf(rh)) + re;
        rope[i] = __builtin_amdgcn_cosf(fr); rope[(size_t)SEQ * 32 + i] = __builtin_amdgcn_sinf(fr);
    }
    for (size_t i = gtid; i < 64 * 16; i += gth) {
        const int pos = (int)(i >> 4), fi = (int)(i & 15);
        const float inv = exp2f(-(float)(2 * fi) * (13.287712379549449f / 32.0f));
        const float ang = (float)pos * inv;
        const float rh = ang * 0.15915493667125702f, re = fmaf(ang, 0.15915493667125702f, -rh) + ang * 6.4206382432985265e-09f;
        const float fr = (rh - rintf(rh)) + re;
        rope[(size_t)2 * SEQ * 32 + i] = __builtin_amdgcn_cosf(fr); rope[(size_t)2 * SEQ * 32 + 1024 + i] = __builtin_amdgcn_sinf(fr);
    }
}

DI void phase_final(const Ctx& c, const bf16* xb, const float* g, float* out) {
    const int gw = c.vcu * NWAVES + c.wave, NGW = c.G * NWAVES;
    f32x4 gg[2][2];
#pragma unroll
    for (int j = 0; j < 2; ++j) { gg[j][0] = ((const f32x4*)g)[2 * (c.lane + 64 * j)]; gg[j][1] = ((const f32x4*)g)[2 * (c.lane + 64 * j) + 1]; }
    for (int m = gw; m < T; m += 2 * NGW) {
        u32x4 a[2][2];
#pragma unroll
        for (int k = 0; k < 2; ++k) { const int row = m + k * NGW < T ? m + k * NGW : m;
#pragma unroll
            for (int j = 0; j < 2; ++j) a[k][j] = ((const u32x4*)(xb + (size_t)row * D))[c.lane + 64 * j]; }
#pragma unroll
        for (int k = 0; k < 2; ++k) { const int row = m + k * NGW;
            f32x4 v[2][2]; float s = 0.f;
#pragma unroll
            for (int j = 0; j < 2; ++j) { v[j][0] = (f32x4){bf_lo(a[k][j].x), bf_hi(a[k][j].x), bf_lo(a[k][j].y), bf_hi(a[k][j].y)}; v[j][1] = (f32x4){bf_lo(a[k][j].z), bf_hi(a[k][j].z), bf_lo(a[k][j].w), bf_hi(a[k][j].w)};
                s += ((v[j][0].x * v[j][0].x + v[j][0].y * v[j][0].y) + (v[j][0].z * v[j][0].z + v[j][0].w * v[j][0].w)) + ((v[j][1].x * v[j][1].x + v[j][1].y * v[j][1].y) + (v[j][1].z * v[j][1].z + v[j][1].w * v[j][1].w)); }
            const float r = 1.0f / sqrtf(wave_sum(s) * (1.0f / D) + EPS);
            if (row < T) { f32x4* o = (f32x4*)(out + (size_t)row * D);
#pragma unroll
                for (int j = 0; j < 2; ++j) { o[2 * (c.lane + 64 * j)] = v[j][0] * r * gg[j][0]; o[2 * (c.lane + 64 * j) + 1] = v[j][1] * r * gg[j][1]; } }
        }
    }
}

DI float rnorm8(const float* p) { const f32x4 a = ((const f32x4*)p)[0], b = ((const f32x4*)p)[1];
    return 1.0f / sqrtf((((a.x + a.y) + (a.z + a.w)) + ((b.x + b.y) + (b.z + b.w))) * (1.0f / 1024.0f) + EPS); }
DI float rnorm16(const float* p) { float s = 0.f;
#pragma unroll
    for (int j = 0; j < 4; ++j) { const f32x4 a = ((const f32x4*)p)[j]; s += (a.x + a.y) + (a.z + a.w); }
    return 1.0f / sqrtf(s * (1.0f / 1024.0f) + EPS); }
namespace pg8 {
#define PG8_LAS __attribute__((address_space(3)))
typedef unsigned short bf16_t;
typedef short bf16x8 __attribute__((ext_vector_type(8)));
typedef float f32x4 __attribute__((ext_vector_type(4)));
typedef unsigned u32x4 __attribute__((ext_vector_type(4)));
constexpr int BM = 256, BK = 64, HALF = 128, HTB = HALF * BK * 2  , STAGE_BYTES = 8 * HTB, NXCD = 8, WGM = 8;

__host__ __device__ __forceinline__ int lds_byte(int r, int c) { const int st = (r >> 4) * 2 + (c >> 5), rr = r & 15, cc = c & 31, ob = rr * 64 + cc * 2; return st * 1024 + (ob ^ (((ob >> 9) & 1) << 5)); }
__host__ __device__ __forceinline__ void stage_rc(int b, int& R, int& C) { const int st = b / 1024, sb = b % 1024, swz = sb ^ (((sb >> 9) & 1) << 5); R = (st >> 1) * 16 + swz / 64; C = (st & 1) * 32 + (swz % 64) / 2; }
__host__ __device__ __forceinline__ int perm32(int rho) { const int n = rho >> 4, i = rho & 15; return 8 * (i >> 2) + 4 * n + (i & 3); }

struct Unit { int pm, pn; };
struct Gemm { const bf16_t* A; const bf16_t* Bt; int M, N, K; };

struct StaticOrder {
    int nM, nN, nwg, G, c;
    __host__ __device__ void init(int M, int N, int G_, int c_) { nM = M / BM; nN = N / BM; nwg = nM * nN; G = G_; c = c_; }
    __host__ __device__ __forceinline__ bool next(int i, Unit& u) const {
        const long L = (long)i * G + c; if (L >= nwg) return false;
        int wgid = (int)L; { const int q = nwg / NXCD, r = nwg % NXCD, xcd = wgid % NXCD, off = wgid / NXCD; wgid = (xcd < r ? xcd * (q + 1) : r * (q + 1) + (xcd - r) * q) + off; }
        const int nig = WGM * nN, gid = wgid / nig, fm = gid * WGM, gsz = (nM - fm) < WGM ? (nM - fm) : WGM;
        u.pm = fm + ((wgid % nig) % gsz); u.pn = (wgid % nig) / gsz; return true;
    }
    __device__ __forceinline__ void a_ready(const Unit&) const {}
    __device__ __forceinline__ void done(const Unit&) const {}
};

__device__ __forceinline__ unsigned cvt_pk_bf16(float lo, float hi) { unsigned r; asm volatile("v_cvt_pk_bf16_f32 %0, %1, %2" : "=v"(r) : "v"(lo), "v"(hi)); return r; }
typedef float f32x2 __attribute__((ext_vector_type(2)));
__device__ __forceinline__ f32x2 gelu_pk(f32x2 v) {
    const f32x2 av = __builtin_elementwise_abs(v), d = av * 0.2316418882f + 1.0f;
    f32x2 t; t.x = __builtin_amdgcn_rcpf(d.x); t.y = __builtin_amdgcn_rcpf(d.y);
    f32x2 q = t * 0.5307027145f + (-0.7265760135f); q = q * t + 0.7107068705f; q = q * t + (-0.142248368f); q = q * t + 0.127414796f; q = q * t;
    const f32x2 s = (v * v) * (-0.72134752044f);
    f32x2 e; e.x = __builtin_amdgcn_exp2f(s.x); e.y = __builtin_amdgcn_exp2f(s.y);
    const f32x2 m = v * (q * e), r = v - m;
    f32x2 o; o.x = v.x < 0.f ? m.x : r.x; o.y = v.y < 0.f ? m.y : r.y; return o;
}

template <int ACT  > struct EpiBf16 {
    static constexpr bool PERM = true, AFTER_DRAIN = false; static_assert(ACT == 0 || ACT == 1, "EpiBf16: ACT is 0 (none) or 1 (gelu_pk)");
    bf16_t* O; int ldc; const float* bias; int split_cols; size_t split_stride; float scale0;
    __device__ __forceinline__ void operator()(const f32x4 (&acc)[2][2][4][2], const Unit& u, int wr, int wc, int fr, int fq) const {
        const int row0 = u.pm * BM + wr * 64 + fr; int colt = u.pn * BM; bf16_t* base = O;
        float sc = 1.f; if (split_cols) { const int t = colt / split_cols; base += (size_t)t * split_stride; colt -= t * split_cols; if (t == 0) sc = scale0; }
        const int col0 = colt + wc * 32 + 8 * fq, bcol0 = u.pn * BM + wc * 32 + 8 * fq;
        f32x4 bv[2][2];
#pragma unroll
        for (int bj = 0; bj < 2; ++bj)
#pragma unroll
            for (int n = 0; n < 2; ++n) bv[bj][n] = bias ? *(const f32x4*)(bias + bcol0 + bj * HALF + 4 * n) : (f32x4){0.f, 0.f, 0.f, 0.f};
#pragma unroll
        for (int ai = 0; ai < 2; ++ai)
#pragma unroll
            for (int m = 0; m < 4; ++m) { bf16_t* rowp = base + (size_t)(row0 + ai * HALF + m * 16) * ldc + col0;
#pragma unroll
                for (int bj = 0; bj < 2; ++bj) { f32x4 v0 = acc[ai][bj][m][0] + bv[bj][0], v1 = acc[ai][bj][m][1] + bv[bj][1];
                    if (ACT == 1) { f32x2 a = gelu_pk((f32x2){v0[0], v0[1]}), b = gelu_pk((f32x2){v0[2], v0[3]}), c = gelu_pk((f32x2){v1[0], v1[1]}), d = gelu_pk((f32x2){v1[2], v1[3]});
                        v0 = (f32x4){a.x, a.y, b.x, b.y}; v1 = (f32x4){c.x, c.y, d.x, d.y}; }
                    v0 = v0 * sc; v1 = v1 * sc; u32x4 w; w.x = cvt_pk_bf16(v0[0], v0[1]); w.y = cvt_pk_bf16(v0[2], v0[3]); w.z = cvt_pk_bf16(v1[0], v1[1]); w.w = cvt_pk_bf16(v1[2], v1[3]);
                    *(u32x4*)(rowp + bj * HALF) = w; } }
    }
};

template <class Epi, class Sched, bool ALIGN_EPI = false, bool SP2 = false>
__device__ __forceinline__ void gemm_phase(PG8_LAS unsigned char* lds, const Gemm g, const Sched& S, const Epi& E, const int tid_in) {
    const int tid = tid_in, wid = __builtin_amdgcn_readfirstlane(tid >> 6), lane = tid & 63, wr = wid >> 2, wc = wid & 3, fr = lane & 15, fq = lane >> 4;
    const int K = g.K, nt = K / BK;
    unsigned voffA[2], voffB[2];
#pragma unroll
    for (int i = 0; i < 2; ++i) { int R, C; stage_rc(tid * 16 + i * 8192, R, C); const int Rb = Epi::PERM ? ((R & ~31) + perm32(R & 31)) : R;
        voffA[i] = (unsigned)(R * K + C) * 2u; voffB[i] = (unsigned)(Rb * K + C) * 2u; }
    const size_t kstep = (size_t)(BK * 2);
    const size_t hstep = (size_t)HALF * K * 2;
    const size_t tstep = 2 * hstep;
    const unsigned ldsw = (unsigned)wid * 1024u;
    const int aoff = lds_byte(wr * 64 + fr, fq * 8), boff = lds_byte(wc * 32 + fr, fq * 8);
#define PG8_SA(b, h) (((b) * 2 + (h)) * HTB)
#define PG8_SB(b, h) ((4 + (b) * 2 + (h)) * HTB)
#define PG8_STAGE(bufoff, gbase, voff) do { _Pragma("unroll") for (int _i = 0; _i < 2; ++_i) \
        __builtin_amdgcn_global_load_lds((const unsigned*)((const char*)(gbase) + (voff)[_i]), (PG8_LAS unsigned*)(lds + (bufoff) + ldsw + _i * 8192), 16, 0, 0); } while (0)
#define PG8_LDA(dst, b, h) do { _Pragma("unroll") for (int m = 0; m < 4; ++m) _Pragma("unroll") for (int k = 0; k < 2; ++k) dst[m][k] = *(const PG8_LAS bf16x8*)(lds + PG8_SA(b, h) + aoff + m * 2048 + k * 1024); } while (0)
#define PG8_LDB(dst, b, h) do { _Pragma("unroll") for (int n = 0; n < 2; ++n) _Pragma("unroll") for (int k = 0; k < 2; ++k) dst[n][k] = *(const PG8_LAS bf16x8*)(lds + PG8_SB(b, h) + boff + n * 2048 + k * 1024); } while (0)
#define PG8_MMA(ai, bj, At, Bt) do { __builtin_amdgcn_s_setprio(1); _Pragma("unroll") for (int m = 0; m < 4; ++m) _Pragma("unroll") for (int n = 0; n < 2; ++n) _Pragma("unroll") for (int k = 0; k < 2; ++k) \
        acc[ai][bj][m][n] = __builtin_amdgcn_mfma_f32_16x16x32_bf16(Bt[n][k], At[m][k], acc[ai][bj][m][n], 0, 0, 0); __builtin_amdgcn_s_setprio(0); } while (0)
#define PG8_WAIT_V(n) asm volatile("s_waitcnt vmcnt(" #n ")" ::: "memory")
#define PG8_WAIT_L(n) asm volatile("s_waitcnt lgkmcnt(" #n ")" ::: "memory")
#define PG8_BAR __builtin_amdgcn_s_barrier()
#define PG8_SCHED __builtin_amdgcn_sched_barrier(0)
    Unit cur, nxt; int ui = 0;
    if (!S.next(0, cur)) return;
    f32x4 acc[2][2][4][2];
#pragma unroll
    for (int a = 0; a < 2; ++a)
#pragma unroll
        for (int b = 0; b < 2; ++b)
#pragma unroll
            for (int m = 0; m < 4; ++m)
#pragma unroll
                for (int n = 0; n < 2; ++n) acc[a][b][m][n] = (f32x4){0.f, 0.f, 0.f, 0.f};
    bf16x8 At[4][2], B0[2][2], B1[2][2];
    const char* cA = (const char*)g.A + (size_t)cur.pm * tstep; const char* cB = (const char*)g.Bt + (size_t)cur.pn * tstep;
    S.a_ready(cur);
    if constexpr (SP2) {
        PG8_STAGE(PG8_SB(0, 0), cB, voffB); PG8_STAGE(PG8_SB(0, 1), cB + hstep, voffB); PG8_STAGE(PG8_SA(0, 0), cA, voffA); PG8_STAGE(PG8_SA(0, 1), cA + hstep, voffA);
        if (wr == 1) PG8_BAR;
        PG8_WAIT_V(2); PG8_BAR;
        PG8_STAGE(PG8_SB(1, 0), cB + kstep, voffB); PG8_STAGE(PG8_SA(1, 0), cA + kstep, voffA); PG8_STAGE(PG8_SB(1, 1), cB + hstep + kstep, voffB);
        PG8_WAIT_V(6); PG8_BAR;
    } else {
        PG8_STAGE(PG8_SB(0, 0), cB, voffB); PG8_STAGE(PG8_SA(0, 0), cA, voffA); PG8_STAGE(PG8_SB(0, 1), cB + hstep, voffB); PG8_STAGE(PG8_SA(0, 1), cA + hstep, voffA);
        if (wr == 1) PG8_BAR;
        PG8_WAIT_V(4); PG8_BAR;
        PG8_STAGE(PG8_SB(1, 0), cB + kstep, voffB); PG8_STAGE(PG8_SA(1, 0), cA + kstep, voffA); PG8_STAGE(PG8_SB(1, 1), cB + hstep + kstep, voffB);
        PG8_WAIT_V(6); PG8_BAR;
    }
    for (;;) {
        const bool has_next = S.next(ui + 1, nxt);
        const char* nA = has_next ? (const char*)g.A + (size_t)nxt.pm * tstep : cA; const char* nB = has_next ? (const char*)g.Bt + (size_t)nxt.pn * tstep : cB;
        for (int t = 0; t < nt; t += 2) {
            const bool last = (t == nt - 2);
            const char* a1 = cA + (size_t)(t + 1) * kstep;
            const char* a2 = last ? nA : cA + (size_t)(t + 2) * kstep; const char* b2 = last ? nB : cB + (size_t)(t + 2) * kstep;
            const char* a3 = a2 + kstep; const char* b3 = b2 + kstep;
            if (last && has_next) S.a_ready(nxt);
            if constexpr (SP2) {
            PG8_LDB(B0, 0, 0); PG8_LDB(B1, 0, 1); PG8_SCHED; PG8_LDA(At, 0, 0); PG8_STAGE(PG8_SA(1, 1), a1 + hstep, voffA);
            PG8_WAIT_V(8); PG8_WAIT_L(0); PG8_BAR; PG8_MMA(0, 0, At, B0); PG8_MMA(0, 1, At, B1); PG8_BAR; PG8_SCHED;
            PG8_LDA(At, 0, 1); PG8_STAGE(PG8_SB(0, 0), b2, voffB); PG8_STAGE(PG8_SB(0, 1), b2 + hstep, voffB); PG8_STAGE(PG8_SA(0, 0), a2, voffA);
            PG8_WAIT_V(8); PG8_WAIT_L(0); PG8_BAR; PG8_MMA(1, 0, At, B0); PG8_MMA(1, 1, At, B1); PG8_BAR; PG8_SCHED;
            PG8_LDB(B0, 1, 0); PG8_LDB(B1, 1, 1); PG8_SCHED; PG8_LDA(At, 1, 0); PG8_STAGE(PG8_SA(0, 1), a2 + hstep, voffA);
            PG8_WAIT_V(8); PG8_WAIT_L(0); PG8_BAR; PG8_MMA(0, 0, At, B0); PG8_MMA(0, 1, At, B1); PG8_BAR; PG8_SCHED;
            PG8_LDA(At, 1, 1); PG8_STAGE(PG8_SB(1, 0), b3, voffB); PG8_STAGE(PG8_SB(1, 1), b3 + hstep, voffB); PG8_STAGE(PG8_SA(1, 0), a3, voffA);
            PG8_WAIT_V(8); PG8_WAIT_L(0); PG8_BAR; PG8_MMA(1, 0, At, B0); PG8_MMA(1, 1, At, B1); PG8_BAR; PG8_SCHED;
            } else {
            PG8_LDB(B0, 0, 0); PG8_SCHED; PG8_LDA(At, 0, 0); PG8_STAGE(PG8_SA(1, 1), a1 + hstep, voffA);
            PG8_WAIT_L(8); PG8_BAR; PG8_WAIT_L(0); PG8_MMA(0, 0, At, B0); PG8_BAR; PG8_SCHED;
            PG8_LDB(B1, 0, 1); PG8_STAGE(PG8_SB(0, 0), b2, voffB);
            PG8_BAR; PG8_WAIT_L(0); PG8_MMA(0, 1, At, B1); PG8_BAR;
            PG8_LDA(At, 0, 1); PG8_STAGE(PG8_SA(0, 0), a2, voffA);
            PG8_BAR; PG8_WAIT_L(0); PG8_MMA(1, 0, At, B0); PG8_BAR; PG8_SCHED;
            PG8_STAGE(PG8_SB(0, 1), b2 + hstep, voffB);
            PG8_WAIT_V(6); PG8_BAR; PG8_MMA(1, 1, At, B1); PG8_BAR;
            PG8_LDB(B0, 1, 0); PG8_SCHED; PG8_LDA(At, 1, 0); PG8_STAGE(PG8_SA(0, 1), a2 + hstep, voffA);
            PG8_WAIT_L(8); PG8_BAR; PG8_WAIT_L(0); PG8_MMA(0, 0, At, B0); PG8_BAR; PG8_SCHED;
            PG8_LDB(B1, 1, 1); PG8_STAGE(PG8_SB(1, 0), b3, voffB);
            PG8_BAR; PG8_WAIT_L(0); PG8_MMA(0, 1, At, B1); PG8_BAR;
            PG8_LDA(At, 1, 1); PG8_STAGE(PG8_SA(1, 0), a3, voffA);
            PG8_BAR; PG8_WAIT_L(0); PG8_MMA(1, 0, At, B0); PG8_BAR; PG8_SCHED;
            PG8_STAGE(PG8_SB(1, 1), b3 + hstep, voffB);
            PG8_WAIT_V(6); PG8_BAR; PG8_MMA(1, 1, At, B1); PG8_BAR;
            }
        }
        if constexpr (ALIGN_EPI) { if (wr == 0) PG8_BAR; }
        if constexpr (!Epi::AFTER_DRAIN) { E(acc, cur, wr, wc, fr, fq); S.done(cur); }
        if (!has_next) break;
#pragma unroll
        for (int a = 0; a < 2; ++a)
#pragma unroll
            for (int b = 0; b < 2; ++b)
#pragma unroll
                for (int m = 0; m < 4; ++m)
#pragma unroll
                    for (int n = 0; n < 2; ++n) acc[a][b][m][n] = (f32x4){0.f, 0.f, 0.f, 0.f};
        cur = nxt; cA = nA; cB = nB; ++ui;
        if constexpr (ALIGN_EPI) { if (wr == 1) PG8_BAR; }
    }
    PG8_WAIT_V(0);
    if constexpr (!ALIGN_EPI) { if (wr == 0) PG8_BAR; }
    PG8_BAR;
    if constexpr (Epi::AFTER_DRAIN) { E.fused(acc, cur, wr, wc, fr, fq, lds, wid, lane); S.done(cur); }
#undef PG8_SA
#undef PG8_SB
#undef PG8_STAGE
#undef PG8_LDA
#undef PG8_LDB
#undef PG8_MMA
#undef PG8_WAIT_V
#undef PG8_WAIT_L
#undef PG8_BAR
#undef PG8_SCHED
}
}

namespace pg8 {
struct EpiF32 {
    static constexpr bool PERM = true, AFTER_DRAIN = false;
    float* C; int ldc; const float* ssq;
    __device__ __forceinline__ void operator()(const f32x4 (&acc)[2][2][4][2], const Unit& u, int wr, int wc, int fr, int fq) const {
        const int row0 = u.pm * BM + wr * 64 + fr, col0 = u.pn * BM + wc * 32 + 8 * fq;
#pragma unroll
        for (int ai = 0; ai < 2; ++ai)
#pragma unroll
            for (int m = 0; m < 4; ++m) { const int row = row0 + ai * HALF + m * 16; float* rowp = C + (size_t)row * ldc + col0;
                const float r = ssq ? rnorm8(ssq + (size_t)row * 8) : 1.0f;
#pragma unroll
                for (int bj = 0; bj < 2; ++bj) { *(f32x4*)(rowp + bj * HALF) = acc[ai][bj][m][0] * r; *(f32x4*)(rowp + bj * HALF + 4) = acc[ai][bj][m][1] * r; } }
    }
};
struct EpiRes {
    static constexpr bool PERM = true, AFTER_DRAIN = false;
    int ldc; bf16_t* Cb; float* ssq; unsigned char* X8;
    __device__ __forceinline__ void operator()(const f32x4 (&acc)[2][2][4][2], const Unit& u, int wr, int wc, int fr, int fq) const {
        const int row0 = u.pm * BM + wr * 64 + fr, col0 = u.pn * BM + wc * 32 + 8 * fq;
        u32x4 xin[2][4][2];
#pragma unroll
        for (int ai = 0; ai < 2; ++ai)
#pragma unroll
            for (int m = 0; m < 4; ++m)
#pragma unroll
                for (int bj = 0; bj < 2; ++bj) xin[ai][m][bj] = *(const u32x4*)(Cb + (size_t)(row0 + ai * HALF + m * 16) * ldc + col0 + bj * HALF);
#pragma unroll
        for (int ai = 0; ai < 2; ++ai)
#pragma unroll
            for (int m = 0; m < 4; ++m) { const int row = row0 + ai * HALF + m * 16; bf16_t* rowb = Cb + (size_t)row * ldc + col0; float sq = 0.f;
#pragma unroll
                for (int bj = 0; bj < 2; ++bj) { const u32x4 xi = xin[ai][m][bj];
                    const f32x4 o0 = (f32x4){__uint_as_float(xi.x << 16), __uint_as_float(xi.x & 0xffff0000u), __uint_as_float(xi.y << 16), __uint_as_float(xi.y & 0xffff0000u)} + acc[ai][bj][m][0],
                                o1 = (f32x4){__uint_as_float(xi.z << 16), __uint_as_float(xi.z & 0xffff0000u), __uint_as_float(xi.w << 16), __uint_as_float(xi.w & 0xffff0000u)} + acc[ai][bj][m][1];
                    sq += (o0[0] * o0[0] + o0[1] * o0[1]) + (o0[2] * o0[2] + o0[3] * o0[3]) + (o1[0] * o1[0] + o1[1] * o1[1]) + (o1[2] * o1[2] + o1[3] * o1[3]);
                    u32x4 w; w.x = cvt_pk_bf16(o0[0], o0[1]); w.y = cvt_pk_bf16(o0[2], o0[3]); w.z = cvt_pk_bf16(o1[0], o1[1]); w.w = cvt_pk_bf16(o1[2], o1[3]); *(u32x4*)(rowb + bj * HALF) = w;
                    typedef unsigned u32x2v __attribute__((ext_vector_type(2)));
                    *(u32x2v*)(X8 + (size_t)row * ldc + col0 + bj * HALF) = (u32x2v){pack_i8x4(o0[0] * 16.0f, o0[1] * 16.0f, o0[2] * 16.0f, o0[3] * 16.0f), pack_i8x4(o1[0] * 16.0f, o1[1] * 16.0f, o1[2] * 16.0f, o1[3] * 16.0f)}; }
                sq = swap16_sum(sq); sq = swap32_sum(sq);
                if (fq == 0) ssq[(size_t)row * 16 + u.pn * 4 + wc] = sq; }
    }
};
struct EpiEven {
    static constexpr bool PERM = true, AFTER_DRAIN = false;
    const float* ssq; const float* rope; float* glu; bf16_t* qb; bf16_t* kb; bf16_t* vb;
    __device__ __forceinline__ void operator()(const f32x4 (&acc)[2][2][4][2], const Unit& u, int wr, int wc, int fr, int fq) const {
        const int row0 = u.pm * BM + wr * 64 + fr, c8 = wc * 32 + 8 * fq;
#pragma unroll
        for (int ai = 0; ai < 2; ++ai)
#pragma unroll
            for (int m = 0; m < 4; ++m) { const int row = row0 + ai * HALF + m * 16, b = row / SEQ, sq = row % SEQ; const float r = rnorm8(ssq + (size_t)row * 8);
                float xa[8], xb[8];
#pragma unroll
                for (int e = 0; e < 4; ++e) { xa[e] = acc[ai][0][m][0][e] * r; xa[4 + e] = acc[ai][0][m][1][e] * r; xb[e] = acc[ai][1][m][0][e] * r; xb[4 + e] = acc[ai][1][m][1][e] * r; }
                if (u.pn < 4) {
                    float* gp = glu + (size_t)row * 512 + u.pn * 128 + c8; f32x4 o0, o1;
#pragma unroll
                    for (int e = 0; e < 4; ++e) { o0[e] = xa[e] * sigmoidf_(xb[e]); o1[e] = xa[4 + e] * sigmoidf_(xb[4 + e]); }
                    *(f32x4*)gp = o0; *(f32x4*)(gp + 4) = o1;
                } else if (u.pn < 6 || wc < 2) {
                    const float* cs = rope + (size_t)sq * 32 + 8 * fq; const float* sn = cs + (size_t)SEQ * 32;
                    const f32x4 c0 = *(const f32x4*)cs, c1 = *(const f32x4*)(cs + 4), s0 = *(const f32x4*)sn, s1 = *(const f32x4*)(sn + 4);
                    const float sc = (u.pn < 6) ? 0.125f * LOG2E : 1.0f; float o1[8], o2[8];
#pragma unroll
                    for (int e = 0; e < 8; ++e) { const float cc = e < 4 ? c0[e & 3] : c1[e & 3], ss = e < 4 ? s0[e & 3] : s1[e & 3]; o1[e] = (xa[e] * cc - xb[e] * ss) * sc; o2[e] = (xb[e] * cc + xa[e] * ss) * sc; }
                    bf16_t* dst = (u.pn < 6) ? qb + ((size_t)(b * 8 + 4 * (u.pn - 4) + wc) * SEQ + sq) * 64 + 8 * fq : kb + ((size_t)(b * 2 + wc) * SEQ + sq) * 64 + 8 * fq;
                    u32x4 w1, w2; w1.x = cvt_pk_bf16(o1[0], o1[1]); w1.y = cvt_pk_bf16(o1[2], o1[3]); w1.z = cvt_pk_bf16(o1[4], o1[5]); w1.w = cvt_pk_bf16(o1[6], o1[7]);
                    w2.x = cvt_pk_bf16(o2[0], o2[1]); w2.y = cvt_pk_bf16(o2[2], o2[3]); w2.z = cvt_pk_bf16(o2[4], o2[5]); w2.w = cvt_pk_bf16(o2[6], o2[7]);
                    *(u32x4*)dst = w1; *(u32x4*)(dst + 32) = w2;
                } else {
                    bf16_t* d0 = vb + ((size_t)(b * 2) * SEQ + sq) * 64 + 32 * (wc - 2) + 8 * fq; bf16_t* d1 = d0 + (size_t)SEQ * 64;
                    u32x4 w1, w2; w1.x = cvt_pk_bf16(xa[0], xa[1]); w1.y = cvt_pk_bf16(xa[2], xa[3]); w1.z = cvt_pk_bf16(xa[4], xa[5]); w1.w = cvt_pk_bf16(xa[6], xa[7]);
                    w2.x = cvt_pk_bf16(xb[0], xb[1]); w2.y = cvt_pk_bf16(xb[2], xb[3]); w2.z = cvt_pk_bf16(xb[4], xb[5]); w2.w = cvt_pk_bf16(xb[6], xb[7]);
                    *(u32x4*)d0 = w1; *(u32x4*)d1 = w2;
                } }
    }
};
struct EpiOdd {
    static constexpr bool PERM = true, AFTER_DRAIN = false;
    const float* ssq; const float* axc; const float* qg; const float* kg; float* ug; bf16_t* vraw; float* lnp; bf16_t* qb; bf16_t* kb; bf16_t* vb; int lane;
    __device__ __forceinline__ void operator()(const f32x4 (&acc)[2][2][4][2], const Unit& u, int wr, int wc, int fr, int fq) const {
        const int row0 = u.pm * BM + wr * 64 + fr, c8 = wc * 32 + 8 * fq; const float* axs = axc + 1024;
#pragma unroll
        for (int ai = 0; ai < 2; ++ai)
#pragma unroll
            for (int m = 0; m < 4; ++m) { const int row = row0 + ai * HALF + m * 16, b = row / SEQ, sq = row % SEQ; const float r = rnorm8(ssq + (size_t)row * 8);
                float xa[8], xb[8];
#pragma unroll
                for (int e = 0; e < 4; ++e) { xa[e] = acc[ai][0][m][0][e] * r; xa[4 + e] = acc[ai][0][m][1][e] * r; xb[e] = acc[ai][1][m][0][e] * r; xb[4 + e] = acc[ai][1][m][1][e] * r; }
                if (u.pn < 2 || (u.pn == 2 && wc < 2)) {
                    const bool isq = u.pn < 2; const float* g = isq ? qg : kg;
                    float ss = 0.f;
#pragma unroll
                    for (int e = 0; e < 8; ++e) ss += xa[e] * xa[e] + xb[e] * xb[e];
                    ss = swap16_sum(ss); ss = swap32_sum(ss);
                    const float rr = 1.0f / sqrtf(ss * (1.0f / 64.0f) + EPS);
                    const f32x4 g10 = *(const f32x4*)(g + 8 * fq), g11 = *(const f32x4*)(g + 8 * fq + 4), g20 = *(const f32x4*)(g + 32 + 8 * fq), g21 = *(const f32x4*)(g + 32 + 8 * fq + 4);
                    const int fi = 8 * (fq & 1), pr = sq >> 6, pc = sq & 63;
                    const f32x4 cr0 = *(const f32x4*)(axc + pr * 16 + fi), cr1 = *(const f32x4*)(axc + pr * 16 + fi + 4), sr0 = *(const f32x4*)(axs + pr * 16 + fi), sr1 = *(const f32x4*)(axs + pr * 16 + fi + 4);
                    const f32x4 cc0 = *(const f32x4*)(axc + pc * 16 + fi), cc1 = *(const f32x4*)(axc + pc * 16 + fi + 4), sc0 = *(const f32x4*)(axs + pc * 16 + fi), sc1 = *(const f32x4*)(axs + pc * 16 + fi + 4);
                    const float sgn = (fq < 2) ? -1.0f : 1.0f, sc = isq ? 0.125f * LOG2E : 1.0f; float o1[8], o2[8];
#pragma unroll
                    for (int e = 0; e < 8; ++e) { const float x1 = xa[e] * rr * (e < 4 ? g10[e & 3] : g11[e & 3]), x2 = xb[e] * rr * (e < 4 ? g20[e & 3] : g21[e & 3]);
                        const float p1 = xor32f(x1, lane), p2 = xor32f(x2, lane);
                        o1[e] = (x1 * (e < 4 ? cr0[e & 3] : cr1[e & 3]) + sgn * p1 * (e < 4 ? sr0[e & 3] : sr1[e & 3])) * sc;
                        o2[e] = (x2 * (e < 4 ? cc0[e & 3] : cc1[e & 3]) + sgn * p2 * (e < 4 ? sc0[e & 3] : sc1[e & 3])) * sc; }
                    bf16_t* dst = isq ? qb + ((size_t)(b * 8 + 4 * u.pn + wc) * SEQ + sq) * 64 + 8 * fq : kb + ((size_t)(b * 2 + wc) * SEQ + sq) * 64 + 8 * fq;
                    u32x4 w1, w2; w1.x = cvt_pk_bf16(o1[0], o1[1]); w1.y = cvt_pk_bf16(o1[2], o1[3]); w1.z = cvt_pk_bf16(o1[4], o1[5]); w1.w = cvt_pk_bf16(o1[6], o1[7]);
                    w2.x = cvt_pk_bf16(o2[0], o2[1]); w2.y = cvt_pk_bf16(o2[2], o2[3]); w2.z = cvt_pk_bf16(o2[4], o2[5]); w2.w = cvt_pk_bf16(o2[6], o2[7]);
                    *(u32x4*)dst = w1; *(u32x4*)(dst + 32) = w2;
                } else if (u.pn == 2) {
                    bf16_t* d0 = vb + ((size_t)(b * 2) * SEQ + sq) * 64 + 32 * (wc - 2) + 8 * fq; bf16_t* d1 = d0 + (size_t)SEQ * 64;
                    u32x4 w1, w2; w1.x = cvt_pk_bf16(xa[0], xa[1]); w1.y = cvt_pk_bf16(xa[2], xa[3]); w1.z = cvt_pk_bf16(xa[4], xa[5]); w1.w = cvt_pk_bf16(xa[6], xa[7]);
                    w2.x = cvt_pk_bf16(xb[0], xb[1]); w2.y = cvt_pk_bf16(xb[2], xb[3]); w2.z = cvt_pk_bf16(xb[4], xb[5]); w2.w = cvt_pk_bf16(xb[6], xb[7]);
                    *(u32x4*)d0 = w1; *(u32x4*)d1 = w2;
                } else if (u.pn < 5) {
                    float* up = ug + (size_t)row * 512 + 256 * (u.pn - 3) + c8; f32x4 o0, o1, o2, o3;
#pragma unroll
                    for (int e = 0; e < 4; ++e) { o0[e] = gelu_tanh(xa[e]); o1[e] = gelu_tanh(xa[4 + e]); o2[e] = gelu_tanh(xb[e]); o3[e] = gelu_tanh(xb[4 + e]); }
                    *(f32x4*)up = o0; *(f32x4*)(up + 4) = o1; *(f32x4*)(up + 128) = o2; *(f32x4*)(up + 132) = o3;
                } else {
                    float s1 = 0.f, s2 = 0.f;
#pragma unroll
                    for (int e = 0; e < 8; ++e) { xa[e] = gelu_tanh(xa[e]); xb[e] = gelu_tanh(xb[e]); s1 += xa[e] + xb[e]; s2 += xa[e] * xa[e] + xb[e] * xb[e]; }
                    bf16_t* vp = vraw + (size_t)row * 512 + 256 * (u.pn - 5) + c8;
                    u32x4 w1, w2; w1.x = cvt_pk_bf16(xa[0], xa[1]); w1.y = cvt_pk_bf16(xa[2], xa[3]); w1.z = cvt_pk_bf16(xa[4], xa[5]); w1.w = cvt_pk_bf16(xa[6], xa[7]);
                    w2.x = cvt_pk_bf16(xb[0], xb[1]); w2.y = cvt_pk_bf16(xb[2], xb[3]); w2.z = cvt_pk_bf16(xb[4], xb[5]); w2.w = cvt_pk_bf16(xb[6], xb[7]);
                    *(u32x4*)vp = w1; *(u32x4*)(vp + 128) = w2;
                    s1 = swap16_sum(s1); s1 = swap32_sum(s1); s2 = swap16_sum(s2); s2 = swap32_sum(s2);
                    if (fq == 0) { float* lp = lnp + ((size_t)row * 8 + (u.pn - 5) * 4 + wc) * 2; lp[0] = s1; lp[1] = s2; }
                } }
    }
};
struct EpiBf16Scale {
    static constexpr bool PERM = true, AFTER_DRAIN = false;
    bf16_t* O; int ldc; const float* ssq;
    __device__ __forceinline__ void operator()(const f32x4 (&acc)[2][2][4][2], const Unit& u, int wr, int wc, int fr, int fq) const {
        const int row0 = u.pm * BM + wr * 64 + fr, col0 = u.pn * BM + wc * 32 + 8 * fq;
#pragma unroll
        for (int ai = 0; ai < 2; ++ai)
#pragma unroll
            for (int m = 0; m < 4; ++m) { const int row = row0 + ai * HALF + m * 16; bf16_t* rowp = O + (size_t)row * ldc + col0;
                const float r = rnorm16(ssq + (size_t)row * 16);
#pragma unroll
                for (int bj = 0; bj < 2; ++bj) { const f32x4 v0 = acc[ai][bj][m][0] * r, v1 = acc[ai][bj][m][1] * r;
                    u32x4 w; w.x = cvt_pk_bf16(v0[0], v0[1]); w.y = cvt_pk_bf16(v0[2], v0[3]); w.z = cvt_pk_bf16(v1[0], v1[1]); w.w = cvt_pk_bf16(v1[2], v1[3]); *(u32x4*)(rowp + bj * HALF) = w; } }
    }
};
}

DI void conv_loadv(float (&v)[62], const Ctx& c, int item, const float* glu) {
    const int t0 = item * 32, b = t0 / SEQ, s0 = t0 % SEQ, ch = c.tid;
#pragma unroll
    for (int i = 0; i < 62; ++i) { const int s = s0 + i - 15; v[i] = (s >= 0 && s < SEQ) ? glu[((size_t)b * SEQ + s) * 512 + ch] : 0.f; }
}
DI void conv_compute(const float (&v)[62], const float (&w)[31], float bias, const Ctx& c, int item, const float* lng, const float* lnb, bf16* ycat) {
    const int t0 = item * 32, ch = c.tid;
    LAS float* sc = (LAS float*)c.lds;
    __syncthreads();
#pragma unroll
    for (int i = 0; i < 32; ++i) { float acc = bias;
#pragma unroll
        for (int j = 0; j < 31; ++j) acc += w[j] * v[i + j];
        sc[i * 512 + ch] = acc; }
    __syncthreads();
#pragma unroll
    for (int q = 0; q < 4; ++q) {
        const int i = c.wave * 4 + q; float x[8]; float sm = 0.f;
#pragma unroll
        for (int m = 0; m < 8; ++m) { x[m] = sc[i * 512 + c.lane + 64 * m]; sm += x[m]; }
        const float mean = wave_sum(sm) * (1.0f / 512.0f); float sq = 0.f;
#pragma unroll
        for (int m = 0; m < 8; ++m) { x[m] -= mean; sq += x[m] * x[m]; }
        const float rstd = 1.0f / sqrtf(wave_sum(sq) * (1.0f / 512.0f) + EPS);
#pragma unroll
        for (int m = 0; m < 8; ++m) { const int cc = c.lane + 64 * m; const float y = x[m] * rstd * lng[cc] + lnb[cc];
            ycat[(size_t)(t0 + i) * D + cc] = (bf16)f2bf(y * sigmoidf_(y)); }
    }
}
DI void conv_items(const Ctx& c, int first, int step, const float* glu, const float* cw, const float* cb, const float* lng, const float* lnb, bf16* ycat) {
    if (first >= 512) return;
    float w[31];
#pragma unroll
    for (int j = 0; j < 31; ++j) w[j] = cw[j * 512 + c.tid];
    const float bias = cb[c.tid];
    float va[62], vb[62];
    conv_loadv(va, c, first, glu);
    for (int it = first; it < 512; it += 2 * step) {
        const int itb = it + step, itn = itb + step;
        if (itb < 512) conv_loadv(vb, c, itb, glu);
        conv_compute(va, w, bias, c, it, lng, lnb, ycat);
        if (itb < 512) { if (itn < 512) conv_loadv(va, c, itn, glu); conv_compute(vb, w, bias, c, itb, lng, lnb, ycat); }
    }
}

template <bool WIN>
DI void attn_item(const Ctx& c, int item, const bf16* qb, const bf16* kb, const bf16* vt, bf16* ycat, int ycol0, const float* sink) {
    const int qblk = item & 63, kvh = (item >> 6) & 1, b = item >> 7;
    const int tid = c.tid, lane = c.lane, l31 = lane & 31, h = lane >> 5;
    const int head = kvh * 4 + (c.wave & 3), q0 = qblk * 64 + (c.wave >> 2) * 32;
    const bf16* qrow = qb + ((size_t)(b * 8 + head) * SEQ + q0 + l31) * 64;
    bf16x8 qf[4];
#pragma unroll
    for (int kk = 0; kk < 4; ++kk) qf[kk] = *(const bf16x8*)(qrow + 16 * kk + 8 * h);
    f32x16 o0, o1;
#pragma unroll
    for (int i = 0; i < 16; ++i) { o0[i] = 0.f; o1[i] = 0.f; }
    float m, l;
    if (WIN) { m = sink[head] * LOG2E; l = (h == 0) ? 1.f : 0.f; } else { m = -1e30f; l = 0.f; }
    const bf16* kbase = kb + (size_t)(b * 2 + kvh) * SEQ * 64;
    const bf16* vbase = vt + (size_t)(b * 2 + kvh) * SEQ * 64;
    int t_lo = 0, t_hi = 63;
    if (WIN) { t_lo = qblk - 2 < 0 ? 0 : qblk - 2; t_hi = qblk + 2 > 63 ? 63 : qblk + 2; }
    LAS unsigned char* sK = c.lds; LAS unsigned char* sV = c.lds + 64 * 144;
    const int qpos = q0 + l31;
    u32x4 rk = *(const u32x4*)(kbase + (size_t)(t_lo * 64 + (tid >> 3)) * 64 + (tid & 7) * 8);
    u32x4 rv = *(const u32x4*)(vbase + (size_t)(t_lo * 64 + (tid >> 3)) * 64 + (tid & 7) * 8);
    for (int kt = t_lo; kt <= t_hi; ++kt) {
        __syncthreads();
        *(LAS u32x4*)(sK + (tid >> 3) * 144 + (tid & 7) * 16) = rk;
        *(LAS u32x4*)(sV + (tid >> 3) * 192 + (tid & 7) * 16) = rv;
        __syncthreads();
        { const int kn = kt < t_hi ? kt + 1 : kt;
          rk = *(const u32x4*)(kbase + (size_t)(kn * 64 + (tid >> 3)) * 64 + (tid & 7) * 8);
          rv = *(const u32x4*)(vbase + (size_t)(kn * 64 + (tid >> 3)) * 64 + (tid & 7) * 8); }
        f32x16 s0, s1;
#pragma unroll
        for (int i = 0; i < 16; ++i) { s0[i] = 0.f; s1[i] = 0.f; }
#pragma unroll
        for (int kk = 0; kk < 4; ++kk) {
            const bf16x8 k0 = *(const LAS bf16x8*)(sK + l31 * 144 + (16 * kk + 8 * h) * 2);
            const bf16x8 k1 = *(const LAS bf16x8*)(sK + (32 + l31) * 144 + (16 * kk + 8 * h) * 2);
            s0 = MFMA32(k0, qf[kk], s0); s1 = MFMA32(k1, qf[kk], s1);
        }
        if (WIN && (kt < qblk - 1 || kt > qblk + 1)) {
#pragma unroll
            for (int r = 0; r < 16; ++r) {
                const int kp0 = kt * 64 + crow(r, h), kp1 = kp0 + 32;
                const int d0 = kp0 - qpos, d1 = kp1 - qpos;
                if (d0 > 128 || d0 < -128) s0[r] = -1e30f;
                if (d1 > 128 || d1 < -128) s1[r] = -1e30f;
            }
        }
        float mx = s0[0];
#pragma unroll
        for (int r = 1; r < 16; ++r) mx = fmaxf(mx, s0[r]);
#pragma unroll
        for (int r = 0; r < 16; ++r) mx = fmaxf(mx, s1[r]);
        mx = fmaxf(mx, __shfl_xor(mx, 32));
        const float mn = fmaxf(m, mx), alpha = __builtin_amdgcn_exp2f(m - mn); m = mn;
        float ls = 0.f;
#pragma unroll
        for (int r = 0; r < 16; ++r) { s0[r] = __builtin_amdgcn_exp2f(s0[r] - mn); s1[r] = __builtin_amdgcn_exp2f(s1[r] - mn); ls += s0[r] + s1[r]; }
        l = l * alpha + ls;
        if (__any(alpha != 1.0f)) {
#pragma unroll
            for (int i = 0; i < 16; ++i) { o0[i] *= alpha; o1[i] *= alpha; }
        }
#pragma unroll
        for (int tl = 0; tl < 2; ++tl)
#pragma unroll
            for (int st = 0; st < 2; ++st) {
                u32x4 pp;
                if (tl == 0) { pp.x = pk2(s0[8 * st], s0[8 * st + 1]); pp.y = pk2(s0[8 * st + 2], s0[8 * st + 3]); pp.z = pk2(s0[8 * st + 4], s0[8 * st + 5]); pp.w = pk2(s0[8 * st + 6], s0[8 * st + 7]); }
                else         { pp.x = pk2(s1[8 * st], s1[8 * st + 1]); pp.y = pk2(s1[8 * st + 2], s1[8 * st + 3]); pp.z = pk2(s1[8 * st + 4], s1[8 * st + 5]); pp.w = pk2(s1[8 * st + 6], s1[8 * st + 7]); }
                const bf16x8 pf = __builtin_bit_cast(bf16x8, pp);
                const int gi = lane & 15, gg = lane >> 4;
                const int vaddr = (tl * 32 + 16 * st + 4 * h + (gi >> 2)) * 192 + (16 * (gg & 1) + 4 * (gi & 3)) * 2;
                typedef short v4i16_t __attribute__((ext_vector_type(4)));
                {
                    const v4i16_t lo = __builtin_amdgcn_ds_read_tr16_b64_v4i16((LAS v4i16_t*)(sV + vaddr)), hi = __builtin_amdgcn_ds_read_tr16_b64_v4i16((LAS v4i16_t*)(sV + vaddr + 8 * 192));
                    const bf16x8 vf = {lo[0], lo[1], lo[2], lo[3], hi[0], hi[1], hi[2], hi[3]};
                    o0 = MFMA32(vf, pf, o0);
                }
                {
                    const v4i16_t lo = __builtin_amdgcn_ds_read_tr16_b64_v4i16((LAS v4i16_t*)(sV + vaddr + 64)), hi = __builtin_amdgcn_ds_read_tr16_b64_v4i16((LAS v4i16_t*)(sV + vaddr + 64 + 8 * 192));
                    const bf16x8 vf = {lo[0], lo[1], lo[2], lo[3], hi[0], hi[1], hi[2], hi[3]};
                    o1 = MFMA32(vf, pf, o1);
                }
            }
    }
    const float lt = l + __shfl_xor(l, 32), inv = 1.0f / lt;
    bf16* orow = ycat + (size_t)(b * SEQ + q0 + l31) * D + ycol0 + head * 64;
#pragma unroll
    for (int g = 0; g < 4; ++g) {
        u32x2 w0; w0.x = pk2(o0[4 * g] * inv, o0[4 * g + 1] * inv); w0.y = pk2(o0[4 * g + 2] * inv, o0[4 * g + 3] * inv);
        u32x2 w1; w1.x = pk2(o1[4 * g] * inv, o1[4 * g + 1] * inv); w1.y = pk2(o1[4 * g + 2] * inv, o1[4 * g + 3] * inv);
        *(u32x2*)(orow + 8 * g + 4 * h) = w0; *(u32x2*)(orow + 32 + 8 * g + 4 * h) = w1;
    }
    __syncthreads();
}

DI void sgu_item(const Ctx& c, int item, const float* sw, const float* sb, const bf16* vn, const float* lnp, const float* lng, const float* lnb, const float* ug, bf16* ycat) {
    const int g = item & 3, n = (item >> 2) & 31, b = item >> 7;
    const int tid = c.tid, lane = c.lane, l31 = lane & 31, h = lane >> 5;
    LAS unsigned char* sW = c.lds; LAS unsigned char* sV = c.lds + 128 * 272;
    const float* wg = sw + (size_t)g * 128 * 128;
    __syncthreads();
#pragma unroll
    for (int i = 0; i < 4; ++i) { const int idx = tid + NT * i, row = idx >> 4, ch = idx & 15;
        const f32x4 a = *(const f32x4*)(wg + row * 128 + ch * 8), bq = *(const f32x4*)(wg + row * 128 + ch * 8 + 4);
        u32x4 o; o.x = pk2(a.x, a.y); o.y = pk2(a.z, a.w); o.z = pk2(bq.x, bq.y); o.w = pk2(bq.z, bq.w);
        *(LAS u32x4*)(sW + row * 272 + ch * 16) = o;
        const size_t tk = (size_t)b * SEQ + n * 128 + row;
        const u32x4 vv = *(const u32x4*)(vn + tk * 512 + g * 128 + ch * 8);
        float s1 = 0.f, s2 = 0.f;
#pragma unroll
        for (int p = 0; p < 4; ++p) { const f32x4 t4 = ((const f32x4*)(lnp + tk * 16))[p]; s1 += t4.x + t4.z; s2 += t4.y + t4.w; }
        const float mean = s1 * (1.0f / 512.0f), rstd = 1.0f / sqrtf(fmaxf(s2 * (1.0f / 512.0f) - mean * mean, 0.f) + EPS);
        const f32x4 ga = *(const f32x4*)(lng + g * 128 + ch * 8), gb = *(const f32x4*)(lng + g * 128 + ch * 8 + 4), ba = *(const f32x4*)(lnb + g * 128 + ch * 8), bb = *(const f32x4*)(lnb + g * 128 + ch * 8 + 4);
        u32x4 vo;
        vo.x = pk2((bf_lo(vv.x) - mean) * rstd * ga.x + ba.x, (bf_hi(vv.x) - mean) * rstd * ga.y + ba.y); vo.y = pk2((bf_lo(vv.y) - mean) * rstd * ga.z + ba.z, (bf_hi(vv.y) - mean) * rstd * ga.w + ba.w);
        vo.z = pk2((bf_lo(vv.z) - mean) * rstd * gb.x + bb.x, (bf_hi(vv.z) - mean) * rstd * gb.y + bb.y); vo.w = pk2((bf_lo(vv.w) - mean) * rstd * gb.z + bb.z, (bf_hi(vv.w) - mean) * rstd * gb.w + bb.w);
        *(LAS u32x4*)(sV + row * 272 + ch * 16) = vo; }
    __syncthreads();
    const int ct = c.wave & 3, pt0 = (c.wave >> 2) * 2;
    float uv[2][16], bv[2][16];
    int l31e = l31, he = h; asm volatile("" : "+v"(l31e), "+v"(he));
#pragma unroll
    for (int j = 0; j < 2; ++j)
#pragma unroll
        for (int r = 0; r < 16; ++r) { const int p = (pt0 + j) * 32 + crow(r, he);
            uv[j][r] = (ug + ((size_t)b * SEQ + n * 128) * 512 + g * 128 + ct * 32)[(unsigned)(p * 512 + l31e)]; bv[j][r] = (sb + g * 128)[(unsigned)p]; }
    f32x16 acc[2];
#pragma unroll
    for (int j = 0; j < 2; ++j)
#pragma unroll
        for (int i = 0; i < 16; ++i) acc[j][i] = 0.f;
#pragma unroll
    for (int kk = 0; kk < 8; ++kk) {
        typedef short v4i16_t __attribute__((ext_vector_type(4)));
        const int gi = lane & 15, gg = lane >> 4;
        const int baddr = (16 * kk + 8 * h + (gi >> 2)) * 272 + (ct * 32 + 16 * (gg & 1) + 4 * (gi & 3)) * 2;
        const v4i16_t blo = __builtin_amdgcn_ds_read_tr16_b64_v4i16((LAS v4i16_t*)(sV + baddr)), bhi = __builtin_amdgcn_ds_read_tr16_b64_v4i16((LAS v4i16_t*)(sV + baddr + 4 * 272));
        const bf16x8 bfr = {blo[0], blo[1], blo[2], blo[3], bhi[0], bhi[1], bhi[2], bhi[3]};
#pragma unroll
        for (int j = 0; j < 2; ++j) {
            const bf16x8 af = *(const LAS bf16x8*)(sW + ((pt0 + j) * 32 + l31) * 272 + (16 * kk + 8 * h) * 2);
            acc[j] = MFMA32(af, bfr, acc[j]);
        }
    }
#pragma unroll
    for (int j = 0; j < 2; ++j)
#pragma unroll
        for (int r = 0; r < 16; ++r) {
            const int p = (pt0 + j) * 32 + crow(r, he);
            const float mixed = acc[j][r] + bv[j][r];
            (ycat + ((size_t)b * SEQ + n * 128) * D + 512 + g * 128 + ct * 32)[(unsigned)(p * D + l31e)] = (bf16)f2bf(uv[j][r] * mixed);
        }
}

DI unsigned fkey(float f, unsigned code, unsigned mask) { const unsigned b = __float_as_uint(f); const unsigned s = b ^ ((unsigned)((int)b >> 31) | 0x80000000u); return (s & ~mask) | code; }
DI float keyval(unsigned k, unsigned mask, unsigned mid) { const unsigned s = (k & ~mask) | mid; const unsigned b = (s & 0x80000000u) ? (s ^ 0x80000000u) : ~s; return __uint_as_float(b); }
#define CE_DESC(x, y) do { const unsigned mx_ = (x) > (y) ? (x) : (y), mn_ = (x) > (y) ? (y) : (x); (x) = mx_; (y) = mn_; } while (0)
DI void sort16_desc(unsigned (&a)[16]) {
    CE_DESC(a[0], a[1]); CE_DESC(a[2], a[3]); CE_DESC(a[0], a[2]); CE_DESC(a[1], a[3]); CE_DESC(a[1], a[2]); CE_DESC(a[4], a[5]); CE_DESC(a[6], a[7]);
    CE_DESC(a[4], a[6]); CE_DESC(a[5], a[7]); CE_DESC(a[5], a[6]); CE_DESC(a[0], a[4]); CE_DESC(a[2], a[6]); CE_DESC(a[2], a[4]); CE_DESC(a[1], a[5]);
    CE_DESC(a[3], a[7]); CE_DESC(a[3], a[5]); CE_DESC(a[1], a[2]); CE_DESC(a[3], a[4]); CE_DESC(a[5], a[6]); CE_DESC(a[8], a[9]); CE_DESC(a[10], a[11]);
    CE_DESC(a[8], a[10]); CE_DESC(a[9], a[11]); CE_DESC(a[9], a[10]); CE_DESC(a[12], a[13]); CE_DESC(a[14], a[15]); CE_DESC(a[12], a[14]); CE_DESC(a[13], a[15]);
    CE_DESC(a[13], a[14]); CE_DESC(a[8], a[12]); CE_DESC(a[10], a[14]); CE_DESC(a[10], a[12]); CE_DESC(a[9], a[13]); CE_DESC(a[11], a[15]); CE_DESC(a[11], a[13]);
    CE_DESC(a[9], a[10]); CE_DESC(a[11], a[12]); CE_DESC(a[13], a[14]); CE_DESC(a[0], a[8]); CE_DESC(a[4], a[12]); CE_DESC(a[4], a[8]); CE_DESC(a[2], a[10]);
    CE_DESC(a[6], a[14]); CE_DESC(a[6], a[10]); CE_DESC(a[2], a[4]); CE_DESC(a[6], a[8]); CE_DESC(a[10], a[12]); CE_DESC(a[1], a[9]); CE_DESC(a[5], a[13]);
    CE_DESC(a[5], a[9]); CE_DESC(a[3], a[11]); CE_DESC(a[7], a[15]); CE_DESC(a[7], a[11]); CE_DESC(a[3], a[5]); CE_DESC(a[7], a[9]); CE_DESC(a[11], a[13]);
    CE_DESC(a[1], a[2]); CE_DESC(a[3], a[4]); CE_DESC(a[5], a[6]); CE_DESC(a[7], a[8]); CE_DESC(a[9], a[10]); CE_DESC(a[11], a[12]); CE_DESC(a[13], a[14]);
}
DI void merge16_desc(unsigned (&a)[16], const unsigned (&b)[16]) {
#pragma unroll
    for (int i = 0; i < 16; ++i) a[i] = a[i] > b[15 - i] ? a[i] : b[15 - i];
#pragma unroll
    for (int j = 8; j > 0; j >>= 1)
#pragma unroll
        for (int i = 0; i < 16; ++i) { const int l = i ^ j; if (l > i) CE_DESC(a[i], a[l]); }
}
DI void pair_merge16(unsigned (&a)[16]) {
    unsigned lo[16], hi[16];
#pragma unroll
    for (int i = 0; i < 16; ++i) { const auto r = __builtin_amdgcn_permlane32_swap(a[i], a[i], false, false); lo[i] = r[0]; hi[i] = r[1]; }
    merge16_desc(lo, hi);
#pragma unroll
    for (int i = 0; i < 16; ++i) a[i] = lo[i];
}
struct CandTab { int ci[64], cj[64]; constexpr CandTab() : ci(), cj() { int n = 0; for (int i = 0; i < 16; ++i) for (int j = 0; j < 16; ++j) if ((i + 1) * (j + 1) <= 16) { ci[n] = i; cj[n] = j; ++n; } for (; n < 64; ++n) { ci[n] = -1; cj[n] = -1; } } };
constexpr CandTab CAND{};
DI unsigned pick_byte(unsigned w0, unsigned w1, unsigned w2, unsigned w3, unsigned i) {
    const unsigned w = (i & 8u) ? ((i & 4u) ? w3 : w2) : ((i & 4u) ? w1 : w0);
    return (w >> ((i & 3u) * 8u)) & 0xFFu;
}
constexpr int RC_GAIN_OFF = 512 * 144;
struct RConv { int cl, cr, ngw; const float* usrc; const float* vsrc; const LAS f32x4* fgl; unsigned char* ws; int hi; };
DI void rconv_slot(RConv& k, TabRow& R, int lane) {
    asm volatile("" : "+v"(lane));
    tabrow_finish(R, lane, k.cl, k.cr, k.fgl, k.ws);
    const int nx = k.cr + 2 * k.ngw;
    tabrow_load(R, lane, k.cl, nx < k.hi ? nx : 0, k.usrc, k.vsrc);
    k.cr += k.ngw;
}
template <int CONV>
DI void route_item(const Ctx& c, int item, const bf16* qp, const bf16* sk, int* eidx, float* gate, bool stage, int lds_off, RConv& rc, TabRow& R0, TabRow& R1) {
    const int hd = item & 7, tb = item >> 3;
    const int tid = c.tid, lane = c.lane, l31 = lane & 31, h = lane >> 5;
    LAS unsigned char* sS = c.lds + lds_off;
    if (stage) {
    __syncthreads();
#pragma unroll
    for (int i = 0; i < 4; ++i) { const int idx = tid + NT * i, row = idx >> 3, ch = idx & 7;
        *(LAS u32x4*)(sS + row * 144 + ch * 16) = *(const u32x4*)(sk + (size_t)hd * 2 * 128 * 64 + (size_t)row * 64 + ch * 8); }
    }
    const int t = tb * 256 + c.wave * 32 + l31;
    const bf16* qrow = qp + (size_t)t * D + hd * 128;
    bf16x8 qf[8];
#pragma unroll
    for (int kk = 0; kk < 8; ++kk) qf[kk] = *(const bf16x8*)(qrow + 16 * kk + 8 * h);
    if (stage) __syncthreads();
    unsigned sv[2][16];
#pragma unroll
    for (int p = 0; p < 2; ++p) {
        unsigned top[16];
#pragma unroll
        for (int tl = 0; tl < 4; ++tl) {
            if ((p * 4 + tl) < CONV) rconv_slot(rc, ((p * 4 + tl) & 1) ? R1 : R0, lane);
            f32x16 acc;
#pragma unroll
            for (int i = 0; i < 16; ++i) acc[i] = 32.0f;
#pragma unroll
            for (int kk = 0; kk < 4; ++kk) {
                const bf16x8 af = *(const LAS bf16x8*)(sS + (p * 128 + tl * 32 + l31) * 144 + (16 * kk + 8 * h) * 2);
                acc = MFMA32(af, qf[p * 4 + kk], acc);
            }
            unsigned g[16]; unsigned h4 = 4u * (unsigned)h; asm volatile("" : "+v"(h4));
#pragma unroll
            for (int r = 0; r < 16; ++r) g[r] = (__float_as_uint(acc[r]) & ~127u) | ((unsigned)(127 - (tl * 32 + (r & 3) + 8 * (r >> 2))) - h4);
            sort16_desc(g);
            if (tl == 0) {
#pragma unroll
                for (int i = 0; i < 16; ++i) top[i] = g[i];
            } else merge16_desc(top, g);
        }
        pair_merge16(top);
#pragma unroll
        for (int i = 0; i < 16; ++i) sv[p][i] = top[i];
    }
    float v0[16], v1[16];
#pragma unroll
    for (int i = 0; i < 16; ++i) { v0[i] = __uint_as_float((sv[0][i] & ~127u) | 64u) - 32.0f; v1[i] = __uint_as_float((sv[1][i] & ~127u) | 64u) - 32.0f; }
    unsigned ca[16], cb[16];
#pragma unroll
    for (int m = 0; m < 32; ++m) {
        constexpr int dummy = 0; (void)dummy;
        const int ia = CAND.ci[m], ja = CAND.cj[m], ib = CAND.ci[32 + m], jb = CAND.cj[32 + m];
        const unsigned ka = fkey(v0[ia] + v1[ja], (unsigned)(255 - (ia * 16 + ja)), 255u);
        const int ibc = ib >= 0 ? ib : 0, jbc = jb >= 0 ? jb : 0;
        const unsigned kb2 = (ib >= 0) ? fkey(v0[ibc] + v1[jbc], (unsigned)(255 - (ibc * 16 + jbc)), 255u) : 0u;
        const unsigned kx = h ? kb2 : ka;
        if (m < 16) ca[m] = kx; else cb[m - 16] = kx;
    }
    sort16_desc(ca); sort16_desc(cb); merge16_desc(ca, cb);
    pair_merge16(ca);
    unsigned p0[4], p1[4];
#pragma unroll
    for (int w = 0; w < 4; ++w) { p0[w] = 0u; p1[w] = 0u;
#pragma unroll
        for (int q = 0; q < 4; ++q) { p0[w] |= (127u - (sv[0][4 * w + q] & 127u)) << (8 * q); p1[w] |= (127u - (sv[1][4 * w + q] & 127u)) << (8 * q); } }
    float fv[16]; int ex[16];
#pragma unroll
    for (int r = 0; r < 16; ++r) { const unsigned code = 255u - (ca[r] & 255u); fv[r] = keyval(ca[r], 255u, 128u);
        ex[r] = (int)(pick_byte(p0[0], p0[1], p0[2], p0[3], code >> 4) * 128u + pick_byte(p1[0], p1[1], p1[2], p1[3], code & 15u)); }
    float sum = 0.f; const float mxv = fv[0];
#pragma unroll
    for (int r = 0; r < 16; ++r) { fv[r] = __expf(fv[r] - mxv); sum += fv[r]; }
    const float inv = 1.0f / sum;
    int eo[8]; float go[8];
#pragma unroll
    for (int r = 0; r < 8; ++r) { eo[r] = h ? ex[8 + r] : ex[r]; go[r] = (h ? fv[8 + r] : fv[r]) * inv; }
    int* ep = eidx + (size_t)t * 128 + hd * 16 + 8 * h; float* gp = gate + (size_t)t * 128 + hd * 16 + 8 * h;
    typedef int i32x4 __attribute__((ext_vector_type(4)));
    i32x4 e0, e1; e0.x = eo[0]; e0.y = eo[1]; e0.z = eo[2]; e0.w = eo[3]; e1.x = eo[4]; e1.y = eo[5]; e1.z = eo[6]; e1.w = eo[7];
    f32x4 g0, g1; g0.x = go[0]; g0.y = go[1]; g0.z = go[2]; g0.w = go[3]; g1.x = go[4]; g1.y = go[5]; g1.z = go[6]; g1.w = go[7];
    *(i32x4*)ep = e0; *(i32x4*)(ep + 4) = e1; *(f32x4*)gp = g0; *(f32x4*)(gp + 4) = g1;
}

struct GuTok { u32x4 seg[16]; u32x4 h; };
DI void gu_issue(GuTok& k, int lane, int q, int t, int e0, int e1, const unsigned char* ub, const unsigned char* x8) {
    const int sub = lane >> 3, ch = lane & 7;
    k.h = *(const u32x4*)(x8 + ((unsigned)t * (unsigned)D + (unsigned)(q * 128 + ch * 16)));
#pragma unroll
    for (int i = 0; i < 16; ++i) { const int src = (8 * i + sub) & 63; const int e = __shfl(i < 8 ? e0 : e1, src);
        k.seg[i] = *(const u32x4*)(ub + (unsigned)(q * (PEER_E * 128) + e * 128 + ch * 16)); }
    __builtin_amdgcn_sched_barrier(0);
}
DI float lane_xor4(float v, bool b2) {
    int r = __builtin_amdgcn_update_dpp(0, __builtin_bit_cast(int, v), 0x104, 0xF, 0x5, false);
    r = __builtin_amdgcn_update_dpp(r, __builtin_bit_cast(int, v), 0x114, 0xF, 0xA, false);
    (void)b2; return __builtin_bit_cast(float, r);
}
DI void gu_finish(const GuTok& k, int lane, bf16* pa_t) {
    const int sub = lane >> 3;
    const bool b0 = lane & 1, b1 = lane & 2, b2 = lane & 4;
    float d[16];
#pragma unroll
    for (int i = 0; i < 16; ++i) { int di = __builtin_amdgcn_sdot4((int)k.seg[i].x, (int)k.h.x, 0, false); di = __builtin_amdgcn_sdot4((int)k.seg[i].y, (int)k.h.y, di, false);
        di = __builtin_amdgcn_sdot4((int)k.seg[i].z, (int)k.h.z, di, false); di = __builtin_amdgcn_sdot4((int)k.seg[i].w, (int)k.h.w, di, false); d[i] = (float)di; }
    float r8[8], r4[4], r2[2];
#pragma unroll
    for (int i = 0; i < 8; ++i) { const float mine = b0 ? d[8 + i] : d[i], send = b0 ? d[i] : d[8 + i];
        r8[i] = mine + __builtin_bit_cast(float, __builtin_amdgcn_update_dpp(0, __builtin_bit_cast(int, send), 0xB1, 0xF, 0xF, true)); }
#pragma unroll
    for (int i = 0; i < 4; ++i) { const float mine = b1 ? r8[4 + i] : r8[i], send = b1 ? r8[i] : r8[4 + i];
        r4[i] = mine + __builtin_bit_cast(float, __builtin_amdgcn_update_dpp(0, __builtin_bit_cast(int, send), 0x4E, 0xF, 0xF, true)); }
#pragma unroll
    for (int i = 0; i < 2; ++i) { const float mine = b2 ? r4[2 + i] : r4[i], send = b2 ? r4[i] : r4[2 + i]; r2[i] = mine + lane_xor4(send, b2); }
    const int i0 = (b0 ? 8 : 0) + (b1 ? 4 : 0) + (b2 ? 2 : 0);
    __builtin_nontemporal_store((bf16)f2bf(r2[0]), pa_t + 8 * i0 + sub); __builtin_nontemporal_store((bf16)f2bf(r2[1]), pa_t + 8 * (i0 + 1) + sub);
}
template <bool CONV>
DI void gu_wave(const Ctx& c, int q, int t_first, int t_step, const unsigned char* hb, const int* eidx, const unsigned char* ub, bf16* pa,
                int cl, const float* usrc, const float* vsrc, const LAS f32x4* fgl, unsigned char* ws) {
    const int lane = c.lane;
    const int n = (t_first < T) ? (T - t_first + t_step - 1) >> __builtin_ctz(t_step) : 0;
    if (n == 0) return;
#define GU_ROUTE(tt, E0, E1) do { const int t_ = (tt) < T ? (tt) : t_first; E0 = eidx[(size_t)t_ * 128 + lane]; E1 = eidx[(size_t)t_ * 128 + 64 + lane]; } while (0)
    int ea0, ea1, eb0, eb1;
    const int gwv = c.vid * NWAVES + c.wave, ngw = c.G * NWAVES;
    int cr = gwv; TabRow R;
    if (CONV) tabrow_load(R, lane, cl, cr, usrc, vsrc);
    GU_ROUTE(t_first, ea0, ea1);
    GU_ROUTE(t_first + t_step, eb0, eb1);
    GuTok A, B;
    if (c.wave & 1) __builtin_amdgcn_s_sleep(32);
    gu_issue(A, lane, q, t_first, ea0, ea1, ub, hb);
    int i = 0;
    if (CONV) {
        for (; i + 3 < n && cr < 2 * PEER_E; i += 2) {
            const int t = t_first + i * t_step;
            { int ln = lane; asm volatile("" : "+v"(ln)); tabrow_finish(R, ln, cl, cr, fgl, ws); cr += ngw; tabrow_load(R, ln, cl, cr < 2 * PEER_E ? cr : 0, usrc, vsrc); }
            GU_ROUTE(t + 2 * t_step, ea0, ea1);
            gu_issue(B, lane, q, t + t_step, eb0, eb1, ub, hb);
            gu_finish(A, lane, pa + ((size_t)q * T + t) * 128);
            GU_ROUTE(t + 3 * t_step, eb0, eb1);
            gu_issue(A, lane, q, t + 2 * t_step, ea0, ea1, ub, hb);
            gu_finish(B, lane, pa + ((size_t)q * T + t + t_step) * 128);
        }
    }
    for (; i + 3 < n; i += 2) {
        const int t = t_first + i * t_step;
        GU_ROUTE(t + 2 * t_step, ea0, ea1);
        gu_issue(B, lane, q, t + t_step, eb0, eb1, ub, hb);
        gu_finish(A, lane, pa + ((size_t)q * T + t) * 128);
        GU_ROUTE(t + 3 * t_step, eb0, eb1);
        gu_issue(A, lane, q, t + 2 * t_step, ea0, ea1, ub, hb);
        gu_finish(B, lane, pa + ((size_t)q * T + t + t_step) * 128);
    }
    for (; i + 1 < n; i += 2) {
        const int t = t_first + i * t_step;
        GU_ROUTE(t + 2 * t_step, ea0, ea1);
        gu_issue(B, lane, q, t + t_step, eb0, eb1, ub, hb);
        gu_finish(A, lane, pa + ((size_t)q * T + t) * 128);
        GU_ROUTE(t + 3 * t_step, eb0, eb1);
        if (i + 2 < n) gu_issue(A, lane, q, t + 2 * t_step, ea0, ea1, ub, hb);
        gu_finish(B, lane, pa + ((size_t)q * T + t + t_step) * 128);
    }
    if (i < n) gu_finish(A, lane, pa + ((size_t)q * T + t_first + i * t_step) * 128);
    if (CONV) while (cr < 2 * PEER_E) { tabrow_finish(R, lane, cl, cr, fgl, ws); cr += ngw; tabrow_load(R, lane, cl, cr < 2 * PEER_E ? cr : 0, usrc, vsrc); }
#undef GU_ROUTE
}
DI void conv_rows(const Ctx& c, int cl, int first, int step, int hi, const float* usrc, const float* vsrc, const float* fg, unsigned char* ws) {
    int ln = c.lane; asm volatile("" : "+v"(ln));
    for (int r0 = first; r0 < hi; r0 += 4 * step) {
        TabRow R[4];
#pragma unroll
        for (int k = 0; k < 4; ++k) tabrow_load(R[k], ln, cl, r0 + k * step < hi ? r0 + k * step : r0, usrc, vsrc);
#pragma unroll
        for (int k = 0; k < 4; ++k) if (r0 + k * step < hi) tabrow_finish(R[k], ln, cl, r0 + k * step, (const f32x4*)(fg + (size_t)cl * D), ws);
    }
}
DI bool w_stash_ok(const Ctx& c) { return 16u * (unsigned)c.G * NT >= (unsigned)T * 128; }
DI void w_prefetch(const Ctx& c, const int* eidx, const float* gate, const float* uinv, const float* vinv, const float* ssq) {
    const unsigned gth = (unsigned)c.G * NT; typedef int i32x4 __attribute__((ext_vector_type(4)));
    const unsigned b0 = ((unsigned)c.vcu * NT + c.tid) * 8u;
    LAS unsigned* st = (LAS unsigned*)c.lds + c.tid;
    i32x4 e0[2], e1[2]; f32x4 g0[2], g1[2]; float sq[2];
#pragma unroll
    for (int k = 0; k < 2; ++k) { const unsigned bb = b0 + k * 8 * gth < (unsigned)T * 128 ? b0 + k * 8 * gth : b0;
        e0[k] = *(const i32x4*)(eidx + bb); e1[k] = *(const i32x4*)(eidx + bb + 4);
        g0[k] = *(const f32x4*)(gate + bb); g1[k] = *(const f32x4*)(gate + bb + 4);
        sq[k] = rnorm16(ssq + (size_t)(bb >> 7) * 16) * 0.0625f; }
#pragma unroll
    for (int k = 0; k < 2; ++k) { const int e[8] = {e0[k].x, e0[k].y, e0[k].z, e0[k].w, e1[k].x, e1[k].y, e1[k].z, e1[k].w}; const float g[8] = {g0[k].x, g0[k].y, g0[k].z, g0[k].w, g1[k].x, g1[k].y, g1[k].z, g1[k].w};
#pragma unroll
        for (int j = 0; j < 8; ++j) { st[(k * 24 + j) * NT] = (unsigned)e[j]; st[(k * 24 + 8 + j) * NT] = __float_as_uint(uinv[e[j]] * sq[k]); st[(k * 24 + 16 + j) * NT] = __float_as_uint(g[j] * vinv[e[j]]); } }
}
DI void phase_w(const Ctx& c, const bf16* pa, const int* eidx, const float* gate, const float* uinv, const float* vinv, const float* ssq, float* wbuf,
                int cl, const float* usrc, const float* vsrc, const float* fg, unsigned char* ws, bool pre) {
    const unsigned gth = (unsigned)c.G * NT;
    typedef int i32x4 __attribute__((ext_vector_type(4)));
    if (pre) {
        const unsigned b0 = ((unsigned)c.vcu * NT + c.tid) * 8u;
        const LAS unsigned* st = (const LAS unsigned*)c.lds + c.tid;
        float a[2][8];
#pragma unroll
        for (int k = 0; k < 2; ++k) { const unsigned bb = b0 + k * 8 * gth < (unsigned)T * 128 ? b0 + k * 8 * gth : b0;
#pragma unroll
            for (int j = 0; j < 8; ++j) a[k][j] = 0.f;
#pragma unroll
            for (int q = 0; q < 8; ++q) { const u32x4 w = *(const u32x4*)(pa + (size_t)q * T * 128 + bb);
                a[k][0] += bf_lo(w.x); a[k][1] += bf_hi(w.x); a[k][2] += bf_lo(w.y); a[k][3] += bf_hi(w.y); a[k][4] += bf_lo(w.z); a[k][5] += bf_hi(w.z); a[k][6] += bf_lo(w.w); a[k][7] += bf_hi(w.w); } }
#pragma unroll
        for (int k = 0; k < 2; ++k) { const unsigned bb = b0 + k * 8 * gth;
            unsigned w[8];
#pragma unroll
            for (int j = 0; j < 8; ++j) w[j] = st[(k * 24 + j) * NT] | (f2bf(gelu_tanh(a[k][j] * __uint_as_float(st[(k * 24 + 8 + j) * NT])) * __uint_as_float(st[(k * 24 + 16 + j) * NT])) << 16);
            if (bb < (unsigned)T * 128) { *(u32x4*)((unsigned*)wbuf + bb) = (u32x4){w[0], w[1], w[2], w[3]}; *(u32x4*)((unsigned*)wbuf + bb + 4) = (u32x4){w[4], w[5], w[6], w[7]}; } }
    } else
    for (unsigned b0 = ((unsigned)c.vcu * NT + c.tid) * 8u; b0 < (unsigned)T * 128; b0 += 16 * gth) {
        float a[2][8]; i32x4 e0[2], e1[2]; f32x4 g0[2], g1[2]; float sq[2];
#pragma unroll
        for (int k = 0; k < 2; ++k) { const unsigned bb = b0 + k * 8 * gth < (unsigned)T * 128 ? b0 + k * 8 * gth : b0;
#pragma unroll
            for (int j = 0; j < 8; ++j) a[k][j] = 0.f;
#pragma unroll
            for (int q = 0; q < 8; ++q) { const u32x4 w = *(const u32x4*)(pa + (size_t)q * T * 128 + bb);
                a[k][0] += bf_lo(w.x); a[k][1] += bf_hi(w.x); a[k][2] += bf_lo(w.y); a[k][3] += bf_hi(w.y); a[k][4] += bf_lo(w.z); a[k][5] += bf_hi(w.z); a[k][6] += bf_lo(w.w); a[k][7] += bf_hi(w.w); }
            e0[k] = *(const i32x4*)(eidx + bb); e1[k] = *(const i32x4*)(eidx + bb + 4);
            g0[k] = *(const f32x4*)(gate + bb); g1[k] = *(const f32x4*)(gate + bb + 4);
            sq[k] = rnorm16(ssq + (size_t)(bb >> 7) * 16) * 0.0625f; }
        float ui[2][8], vi[2][8];
#pragma unroll
        for (int k = 0; k < 2; ++k) { const int e[8] = {e0[k].x, e0[k].y, e0[k].z, e0[k].w, e1[k].x, e1[k].y, e1[k].z, e1[k].w};
#pragma unroll
            for (int j = 0; j < 8; ++j) { ui[k][j] = uinv[e[j]]; vi[k][j] = vinv[e[j]]; } }
#pragma unroll
        for (int k = 0; k < 2; ++k) { const unsigned bb = b0 + k * 8 * gth;
            const int e[8] = {e0[k].x, e0[k].y, e0[k].z, e0[k].w, e1[k].x, e1[k].y, e1[k].z, e1[k].w}; const float g[8] = {g0[k].x, g0[k].y, g0[k].z, g0[k].w, g1[k].x, g1[k].y, g1[k].z, g1[k].w};
            unsigned w[8];
#pragma unroll
            for (int j = 0; j < 8; ++j) w[j] = (unsigned)e[j] | (f2bf(gelu_tanh(a[k][j] * ui[k][j] * sq[k]) * g[j] * vi[k][j]) << 16);
            if (bb < (unsigned)T * 128) { *(u32x4*)((unsigned*)wbuf + bb) = (u32x4){w[0], w[1], w[2], w[3]}; *(u32x4*)((unsigned*)wbuf + bb + 4) = (u32x4){w[4], w[5], w[6], w[7]}; } }
    }
    if (cl < DEPTH) {
        const int gw = c.vcu * NWAVES + c.wave, NGW = c.G * NWAVES;
        for (int r0 = gw; r0 < 2 * PEER_E; r0 += 4 * NGW) {
            TabRow R[4];
#pragma unroll
            for (int k = 0; k < 4; ++k) tabrow_load(R[k], c.lane, cl, r0 + k * NGW < 2 * PEER_E ? r0 + k * NGW : r0, usrc, vsrc);
#pragma unroll
            for (int k = 0; k < 4; ++k) if (r0 + k * NGW < 2 * PEER_E) tabrow_finish(R[k], c.lane, cl, r0 + k * NGW, (const f32x4*)(fg + (size_t)cl * D), ws);
        }
    }
}
DI float lane_xor16(float v, bool odd_row) { const auto r = __builtin_amdgcn_permlane16_swap(__float_as_uint(v), __float_as_uint(v), false, false); return __uint_as_float(odd_row ? r[0] : r[1]); }
DI float lane_xor32(float v, bool hi) { const auto r = __builtin_amdgcn_permlane32_swap(__float_as_uint(v), __float_as_uint(v), false, false); return __uint_as_float(hi ? r[0] : r[1]); }
struct GmHalf { u32x4 seg[8]; };
DI void gm_issue(GmHalf& k, int lane, int q, const LAS unsigned* wp, const unsigned char* vb, int emask) {
    const int sub = lane >> 3, ch = lane & 7;
#pragma unroll
    for (int i = 0; i < 8; ++i) { const int ei = (int)(wp[8 * i + sub] & 0xFFFFu) & emask; k.seg[i] = *(const u32x4*)(vb + (unsigned)(q * (PEER_E * 128) + ei * 128 + ch * 16)); }
}
DI float gm_prep(unsigned ew0, unsigned ew1, LAS unsigned char* wslot, int lane) {
    const float w0 = __uint_as_float(ew0 & 0xFFFF0000u), w1 = __uint_as_float(ew1 & 0xFFFF0000u);
    float m = fmaxf(fabsf(w0), fabsf(w1));
    m = fmaxf(m, __builtin_bit_cast(float, __builtin_amdgcn_update_dpp(0, __builtin_bit_cast(int, m), 0xB1, 0xF, 0xF, true)));
    m = fmaxf(m, __builtin_bit_cast(float, __builtin_amdgcn_update_dpp(0, __builtin_bit_cast(int, m), 0x4E, 0xF, 0xF, true)));
    m = fmaxf(m, __builtin_bit_cast(float, __builtin_amdgcn_update_dpp(0, __builtin_bit_cast(int, m), 0x141, 0xF, 0xF, true)));
    m = fmaxf(m, __builtin_bit_cast(float, __builtin_amdgcn_update_dpp(0, __builtin_bit_cast(int, m), 0x140, 0xF, 0xF, true)));
    { const auto p = __builtin_amdgcn_permlane16_swap(__float_as_uint(m), __float_as_uint(m), false, false); m = fmaxf(__uint_as_float(p[0]), __uint_as_float(p[1])); }
    { const auto p = __builtin_amdgcn_permlane32_swap(__float_as_uint(m), __float_as_uint(m), false, false); m = fmaxf(__uint_as_float(p[0]), __uint_as_float(p[1])); }
    unsigned em = (__float_as_uint(m) >> 23) & 0xFFu; em = em < 16u ? 16u : em;
    const float S = __uint_as_float((261u - em) << 23);
    const int p = __builtin_amdgcn_cvt_pk_fp8_f32(w0 * S, w1 * S, 0, false);
    wslot[lane] = (unsigned char)(p & 0xFF); wslot[64 + lane] = (unsigned char)((p >> 8) & 0xFF);
    return __uint_as_float((em - 7u) << 23);
}
DI void gm_accum(const GmHalf& k, const LAS unsigned char* wh, int lane, f32x4& alo, f32x4& ahi) {
    const unsigned sub = (unsigned)lane >> 3, sh = 8u * ((unsigned)lane & 7u), sel = 0x0C0C0C00u | sub;
    u32x4 W[4];
#pragma unroll
    for (int j = 0; j < 4; ++j) W[j] = *(const LAS u32x4*)(wh + 16 * j);
#pragma unroll
    for (int i = 0; i < 8; ++i) { const unsigned lo = (i & 1) ? W[i >> 1].z : W[i >> 1].x, hi = (i & 1) ? W[i >> 1].w : W[i >> 1].y;
        const long A = (long)((unsigned long long)__builtin_amdgcn_perm(hi, lo, sel) << sh);
        alo = __builtin_amdgcn_mfma_f32_16x16x32_fp8_fp8(A, (long)(((unsigned long long)k.seg[i].y << 32) | k.seg[i].x), alo, 0, 0, 0);
        ahi = __builtin_amdgcn_mfma_f32_16x16x32_fp8_fp8(A, (long)(((unsigned long long)k.seg[i].w << 32) | k.seg[i].z), ahi, 0, 0, 0); }
}
DI void gm_xload(u32x2& xa, u32x2& xc, int lane, int q, int t, const bf16* xb) {
    const int j = lane & 15, g = lane >> 4;
    xa = (u32x2){0u, 0u}; xc = (u32x2){0u, 0u};
    if ((j < 8) && (g < 2)) { const unsigned off = (unsigned)t * (unsigned)D + (unsigned)(q * 128 + 16 * j + 4 * g); xa = *(const u32x2*)(xb + off); xc = *(const u32x2*)(xb + off + 8); }
}
DI void gm_store(const f32x4 alo, const f32x4 ahi, float invS, int lane, int q, int t, bf16* xb, float* xf, float* ssq, const u32x2 xa, const u32x2 xc) {
    const int j = lane & 15, g = lane >> 4;
    float v[8];
#pragma unroll
    for (int r = 0; r < 4; ++r) { v[r] = alo[r]; v[4 + r] = ahi[r]; }
#pragma unroll
    for (int r = 0; r < 8; ++r) { const float p8 = __builtin_bit_cast(float, __builtin_amdgcn_update_dpp(0, __builtin_bit_cast(int, v[r]), 0x128, 0xF, 0xF, true));
        v[r] = (v[r] + lane_xor32(p8, lane >= 32)) * invS; }
    const bool own = (j < 8) && (g < 2);
    float sq = 0.f;
    if (own) { const unsigned off = (unsigned)t * (unsigned)D + (unsigned)(q * 128 + 16 * j + 4 * g);
        f32x4 a = {bf_lo(xa.x) + v[0], bf_hi(xa.x) + v[1], bf_lo(xa.y) + v[2], bf_hi(xa.y) + v[3]}, b = {bf_lo(xc.x) + v[4], bf_hi(xc.x) + v[5], bf_lo(xc.y) + v[6], bf_hi(xc.y) + v[7]};
        if (xf) { *(f32x4*)(xf + off) = a; *(f32x4*)(xf + off + 8) = b; }
        if (ssq) { u32x2 w0; w0.x = pk2(a.x, a.y); w0.y = pk2(a.z, a.w); u32x2 w1; w1.x = pk2(b.x, b.y); w1.y = pk2(b.z, b.w); *(u32x2*)(xb + off) = w0; *(u32x2*)(xb + off + 8) = w1; }
        sq = (a.x * a.x + a.y * a.y) + (a.z * a.z + a.w * a.w) + (b.x * b.x + b.y * b.y) + (b.z * b.z + b.w * b.w); }
    if (ssq) { sq = wave_sum_fast(sq); if (lane == 0) ssq[(unsigned)t * 8u + (unsigned)q] = sq; }
}
DI void gv_wave(const Ctx& c, int q, int t_first, int t_step, const int* eidx, const float* wbuf, const unsigned char* vb, int emask, bf16* xb, float* xf, float* ssq) {
    const int lane = c.lane;
    const int n = (t_first < T) ? (T - t_first + t_step - 1) >> __builtin_ctz(t_step) : 0;
    if (n == 0) return;
    (void)eidx;
    LAS unsigned char* wl = c.lds + c.wave * 512;
    LAS unsigned* wr = (LAS unsigned*)(c.lds + 4096 + c.wave * 4096);
#define TOK(k) (t_first + (k) * t_step)
#define WS_(k) (wr + (((k) & 7) << 7))
#define GV_RT(k, E0, E1) do { const unsigned o_ = (unsigned)TOK(k) * 128u + (unsigned)lane; E0 = ewb[o_]; E1 = ewb[o_ + 64u]; } while (0)
    const unsigned* ewb = (const unsigned*)wbuf;
#pragma unroll
    for (int k = 0; k < 6; ++k) { unsigned a_, b_; GV_RT(k, a_, b_); WS_(k)[lane] = a_; WS_(k)[64 + lane] = b_; }
    float is0 = gm_prep(WS_(0)[lane], WS_(0)[64 + lane], wl + 0, lane), is1 = gm_prep(WS_(1)[lane], WS_(1)[64 + lane], wl + 128, lane);
    GmHalf U0, U1, U2, U3;
    gm_issue(U0, lane, q, WS_(0), vb, emask); __builtin_amdgcn_sched_barrier(0); gm_issue(U1, lane, q, WS_(0) + 64, vb, emask); __builtin_amdgcn_sched_barrier(0);
    gm_issue(U2, lane, q, WS_(1), vb, emask); __builtin_amdgcn_sched_barrier(0);
    for (int i = 0; i < n; i += 2) {
        unsigned n6a, n6b, n7a, n7b;
        GV_RT(i + 6, n6a, n6b); GV_RT(i + 7, n7a, n7b);
        u32x2 xa0, xc0; gm_xload(xa0, xc0, lane, q, TOK(i), xb);
        const float is2 = gm_prep(WS_(i + 2)[lane], WS_(i + 2)[64 + lane], wl + 128 * ((i + 2) & 3), lane);
        f32x4 alo = {0.f, 0.f, 0.f, 0.f}, ahi = {0.f, 0.f, 0.f, 0.f};
        gm_issue(U3, lane, q, WS_(i + 1) + 64, vb, emask);
        gm_accum(U0, wl + 128 * (i & 3), lane, alo, ahi);
        gm_issue(U0, lane, q, WS_(i + 2), vb, emask);
        gm_accum(U1, wl + 128 * (i & 3) + 64, lane, alo, ahi);
        gm_store(alo, ahi, is0, lane, q, TOK(i), xb, xf, ssq, xa0, xc0);
        u32x2 xa1, xc1; gm_xload(xa1, xc1, lane, q, TOK(i + 1), xb);
        gm_issue(U1, lane, q, WS_(i + 2) + 64, vb, emask);
        const float is3 = gm_prep(WS_(i + 3)[lane], WS_(i + 3)[64 + lane], wl + 128 * ((i + 3) & 3), lane);
        alo = (f32x4){0.f, 0.f, 0.f, 0.f}; ahi = (f32x4){0.f, 0.f, 0.f, 0.f};
        gm_accum(U2, wl + 128 * ((i + 1) & 3), lane, alo, ahi);
        gm_issue(U2, lane, q, WS_(i + 3), vb, emask);
        gm_accum(U3, wl + 128 * ((i + 1) & 3) + 64, lane, alo, ahi);
        if (i + 1 < n) gm_store(alo, ahi, is1, lane, q, TOK(i + 1), xb, xf, ssq, xa1, xc1);
        WS_(i + 6)[lane] = n6a; WS_(i + 6)[64 + lane] = n6b; WS_(i + 7)[lane] = n7a; WS_(i + 7)[64 + lane] = n7b;
        is0 = is2; is1 = is3;
    }
#undef WS_
#undef GV_RT
#undef TOK
}

namespace attn_body {
using bf16=__hip_bfloat16;
using bf16x8=__attribute__((ext_vector_type(8)))short;
using s16x4=__attribute__((ext_vector_type(4)))short;
using f32x16=__attribute__((ext_vector_type(16)))float;
using u32x4=__attribute__((ext_vector_type(4)))unsigned;
constexpr int BATCH=4,NHEAD=8,NKV=2,SEQ=4096,D=64;
constexpr int QP=64,KP=64,VP=64,OP=1024;
constexpr int NW=8,QBLK=32,QB=QBLK*NW,KVBLK=64,NQB=SEQ/QB;
constexpr int ATTN_UNIT_ROWS=QB;
__device__ __forceinline__ int crow(int r,int hi){return (r&3)+8*(r>>2)+4*hi;}
#define SBAR() __builtin_amdgcn_sched_barrier(0)
__device__ __forceinline__ void cmask(f32x16&p0,f32x16&p1,int jb,int qrel,int hi){
  const float NEG=-INFINITY; int kb=64*jb+4*hi;
  #pragma unroll
  for(int r=0;r<16;++r){int kv=kb+(r&3)+8*(r>>2); if(kv>qrel)p0[r]=NEG; if(kv+32>qrel)p1[r]=NEG;}
}

constexpr int NSLOT=3, SLOTB=8192;
constexpr int LDS_K=0, LDS_V=NSLOT*SLOTB, LDS_WS=2*NSLOT*SLOTB, LDS_OST=LDS_WS+NW*64*4, LDS_BYTES=LDS_OST+NW*4096;
constexpr float C2=0.125f*1.4426950408889634f;
__device__ __forceinline__ void glds16(const void*gsrc,unsigned lds_dst){unsigned keep;
  asm volatile("s_mov_b32 %0, m0\n\ts_mov_b32 m0, %2\n\ts_nop 0\n\tglobal_load_lds_dwordx4 %1, off\n\ts_mov_b32 m0, %0":"=&s"(keep):"v"(gsrc),"s"(lds_dst):"memory");}
__device__ __forceinline__ float max3f(float a,float b,float c){float r;asm("v_max3_f32 %0, %1, %2, %3":"=v"(r):"v"(a),"v"(b),"v"(c));return r;}
__device__ __forceinline__ float max2f(float a,float b){float r;asm("v_max_f32_e32 %0, %1, %2":"=v"(r):"v"(a),"v"(b));return r;}
__device__ __forceinline__ float fadd_s(float a,float b){float r;asm("v_add_f32_e32 %0, %1, %2":"=v"(r):"v"(a),"v"(b));return r;}
__device__ __forceinline__ float fsub_s(float a,float b){float r;asm("v_sub_f32_e32 %0, %1, %2":"=v"(r):"v"(a),"v"(b));return r;}
typedef float f32x2_t __attribute__((ext_vector_type(2))); typedef __bf16 bf16x2_t __attribute__((ext_vector_type(2)));
__device__ __forceinline__ unsigned cvtpk_s(float lo,float hi){f32x2_t v={lo,hi};bf16x2_t b=__builtin_convertvector(v,bf16x2_t);return __builtin_bit_cast(unsigned,b);}
#define WAIT_BAR(N) asm volatile("s_waitcnt vmcnt(" #N ") lgkmcnt(0)\n\ts_barrier":::"memory")

__device__ __forceinline__ void qkt(f32x16&p0,f32x16&p1,const char*Kslot,const bf16x8*qr,const f32x16&negm,int r32,int hi){
  const char*kb=Kslot+hi*1024+r32*16;
  #pragma unroll
  for(int d0=0;d0<4;++d0){
    const bf16x8 b0=*reinterpret_cast<const bf16x8*>(kb+d0*2048);
    const bf16x8 b1=*reinterpret_cast<const bf16x8*>(kb+d0*2048+512);
    if(d0==0){p0=__builtin_amdgcn_mfma_f32_32x32x16_bf16(b0,qr[0],negm,0,0,0);p1=__builtin_amdgcn_mfma_f32_32x32x16_bf16(b1,qr[0],negm,0,0,0);}
    else{p0=__builtin_amdgcn_mfma_f32_32x32x16_bf16(b0,qr[d0],p0,0,0,0);p1=__builtin_amdgcn_mfma_f32_32x32x16_bf16(b1,qr[d0],p1,0,0,0);}}
}
typedef __attribute__((address_space(3))) const char* lds_cptr;
typedef short v4i16_t __attribute__((ext_vector_type(4)));
__device__ __forceinline__ void kload8(bf16x8*kf,lds_cptr kp){
  kf[0]=*(const __attribute__((address_space(3))) bf16x8*)(kp);      kf[1]=*(const __attribute__((address_space(3))) bf16x8*)(kp+512);
  kf[2]=*(const __attribute__((address_space(3))) bf16x8*)(kp+2048); kf[3]=*(const __attribute__((address_space(3))) bf16x8*)(kp+2560);
  kf[4]=*(const __attribute__((address_space(3))) bf16x8*)(kp+4096); kf[5]=*(const __attribute__((address_space(3))) bf16x8*)(kp+4608);
  kf[6]=*(const __attribute__((address_space(3))) bf16x8*)(kp+6144); kf[7]=*(const __attribute__((address_space(3))) bf16x8*)(kp+6656);
}
__device__ __forceinline__ void kload2(bf16x8*kf,lds_cptr kp,int j){ kf[2*j]=*(const __attribute__((address_space(3))) bf16x8*)(kp+j*2048); kf[2*j+1]=*(const __attribute__((address_space(3))) bf16x8*)(kp+j*2048+512); }
__device__ __forceinline__ s16x4 vtr(lds_cptr p){ return __builtin_bit_cast(s16x4,__builtin_amdgcn_ds_read_tr16_b64_v4i16((__attribute__((address_space(3))) v4i16_t*)p)); }
__device__ __forceinline__ float rowmax(const f32x16&p0,const f32x16&p1){
  float a=max3f(p0[0],p0[1],p1[0]),b=max3f(p0[2],p0[3],p1[1]);a=max3f(a,p1[2],p1[3]);
  #pragma unroll
  for(int r=4;r<16;r+=4){a=max3f(a,p0[r],p0[r+1]);b=max3f(b,p0[r+2],p0[r+3]);a=max3f(a,p1[r],p1[r+1]);b=max3f(b,p1[r+2],p1[r+3]);}
  const float m=max2f(a,b);
  auto rr=__builtin_amdgcn_permlane32_swap(__float_as_uint(m),__float_as_uint(m),false,false);
  return max2f(__uint_as_float(rr[0]),__uint_as_float(rr[1]));
}
__device__ __forceinline__ void pv(f32x16*o,int vb,bf16x8 pa0,bf16x8 pa1,bf16x8 pa2,bf16x8 pa3){
  #pragma unroll
  for(int d0=0;d0<2;++d0){s16x4 lo[4],hi[4];
    #pragma unroll
    for(int ks=0;ks<4;++ks){
      asm volatile("ds_read_b64_tr_b16 %0,%1 offset:%c2":"=&v"(lo[ks]):"v"(vb),"i"(d0*4096+ks*1024):"memory");
      asm volatile("ds_read_b64_tr_b16 %0,%1 offset:%c2":"=&v"(hi[ks]):"v"(vb),"i"(d0*4096+ks*1024+512):"memory");}
    asm volatile("s_waitcnt lgkmcnt(0)":::"memory");SBAR();
    #define PK(k) (bf16x8){lo[k][0],lo[k][1],lo[k][2],lo[k][3],hi[k][0],hi[k][1],hi[k][2],hi[k][3]}
    o[d0]=__builtin_amdgcn_mfma_f32_32x32x16_bf16(pa0,PK(0),o[d0],0,0,0);
    o[d0]=__builtin_amdgcn_mfma_f32_32x32x16_bf16(pa1,PK(1),o[d0],0,0,0);
    o[d0]=__builtin_amdgcn_mfma_f32_32x32x16_bf16(pa2,PK(2),o[d0],0,0,0);
    o[d0]=__builtin_amdgcn_mfma_f32_32x32x16_bf16(pa3,PK(3),o[d0],0,0,0);
    #undef PK
  }
}

#ifndef ATTN_STORE16
#define ATTN_STORE16(p,v) (*(u32x4*)(p)=(v))
#endif
template<int THRL> __device__ __forceinline__ void attn_unit(int b,int h,int qb,const bf16*Q,const bf16*K,const bf16*V,bf16*O,char*shm,const int tid){
  const int lane=tid&63,r32=lane&31,hi=lane>>5; const int wid=__builtin_amdgcn_readfirstlane(tid>>6);
  const long rowbase=(long)b*SEQ; const int q0=qb*QB;
  const bf16*Qw=Q+(((long)b*NHEAD+h)*SEQ+q0+wid*QBLK)*QP;
  const bf16*Kh=K+((long)b*NKV+(h>>2))*SEQ*KP,*Vh=V+((long)b*NKV+(h>>2))*SEQ*VP;
  const unsigned lds0=(unsigned)(uintptr_t)shm;
  float*wsf=(float*)(shm+LDS_WS)+wid*64;
  const bf16*ksrc=Kh+(long)lane*KP+wid*8;
  const bf16*vsrc=Vh+(long)(16*(wid&3)+(lane>>2))*VP+(wid>>2)*32+(lane&3)*8;
  const unsigned kdst=lds0+LDS_K+wid*1024, vdst=lds0+LDS_V+wid*1024;
  #define DMA_K(t,slot) glds16(ksrc+(long)(t)*KVBLK*KP,(unsigned)__builtin_amdgcn_readfirstlane(kdst+(slot)))
  #define DMA_V(t,slot) glds16(vsrc+(long)(t)*KVBLK*VP,(unsigned)__builtin_amdgcn_readfirstlane(vdst+(slot)))
  const int vb0=(int)(lds0+LDS_V)+((lane>>4)&1)*32+(lane&3)*8+(4*hi+((lane&15)>>2))*64;
  const char*Kbase=shm+LDS_K; bf16x8 kf[8];
  const lds_cptr shm3=(lds_cptr)shm; const lds_cptr kp0=shm3+LDS_K+hi*1024+r32*16; const lds_cptr vp0=shm3+LDS_V+((lane>>4)&1)*32+(lane&3)*8+(4*hi+((lane&15)>>2))*64;
  const int NT=SEQ/KVBLK;
  DMA_K(0,0);DMA_V(0,0);DMA_K(1,SLOTB);
  bf16x8 qr[4];
  #pragma unroll
  for(int d0=0;d0<4;++d0)qr[d0]=*reinterpret_cast<const bf16x8*>(&Qw[(long)r32*QP+d0*16+hi*8]);
  float mhat=0.f,l_reg=0.f;f32x16 o[2],negm;{float z0=(float)(tid>>12);asm volatile("":"+v"(z0));
  _Pragma("unroll") for(int r=0;r<16;++r){o[0][r]=z0;o[1][r]=z0;negm[r]=z0;}}asm volatile("":"+v"(negm));
  const int qrel=wid*QBLK+r32;
  #define CMASK(P0,P1,t) do{}while(0)
  bool resc=false;
  #define START(P0,P1) do{ const float rm=rowmax(P0,P1); resc=false; \
    { const float dl=rm; mhat=fadd_s(mhat,dl); \
      _Pragma("unroll") for(int r=0;r<16;++r){P0[r]=fsub_s(P0[r],dl);P1[r]=fsub_s(P1[r],dl);} \
      _Pragma("unroll") for(int r=0;r<16;++r)negm[r]=-mhat; asm volatile("":"+v"(negm)); } \
    _Pragma("unroll") for(int r=0;r<16;++r)P0[r]=__builtin_amdgcn_exp2f(P0[r]); }while(0)
  #define RESC() do{ if(resc){ asm volatile("s_waitcnt lgkmcnt(0)":::"memory"); \
      _Pragma("unroll") for(int d_=0;d_<2;++d_) _Pragma("unroll") for(int r=0;r<16;++r)o[d_][r]*=wsf[crow(r,hi)]; } }while(0)
  f32x16 pA0,pA1,pB0,pB1;
  int sl_prev=0,sl_cur=0,sl_next=SLOTB;
  #define ROT() do{sl_prev=sl_cur;sl_cur=sl_next;sl_next=(sl_next==(NSLOT-1)*SLOTB)?0:sl_next+SLOTB;}while(0)
  DMA_K(2,2*SLOTB);
  WAIT_BAR(3);
  qkt(pA0,pA1,Kbase,qr,negm,r32,hi);asm volatile("s_nop 15\n\ts_nop 7":"+v"(pA0),"+v"(pA1));CMASK(pA0,pA1,0);
  START(pA0,pA1);
  _Pragma("unroll") for(int r=0;r<16;++r)pA1[r]=__builtin_amdgcn_exp2f(pA1[r]);
  WAIT_BAR(0);
  DMA_K(3,0);DMA_V(1,SLOTB);
  ROT();
  kload8(kf,kp0+sl_cur);
  WAIT_BAR(2);
  s16x4 vlo[8],vhi[8]; u32x4 pw0,pw1,pw2,pw3;
  #define PKW(P,B) cvtpk_s(P[B],P[B+1])
  #define PAF(k) __builtin_bit_cast(bf16x8,pw##k)
  #define VFR(i) (bf16x8){vlo[i][0],vlo[i][1],vlo[i][2],vlo[i][3],vhi[i][0],vhi[i][1],vhi[i][2],vhi[i][3]}
  #define PIN(x) asm volatile("":"+v"(x))
  #define MX3(a,b,c) __builtin_fmaxf(__builtin_fmaxf((a),(b)),(c))
  #define GAPA(MF,A0,A1,A2,A3,W0,W1,PW) do{ MF; sacc+=A0; sacc+=A1; sacc+=A2; sacc+=A3; PIN(sacc); W0; W1; PIN(PW); SBAR(); }while(0)
  #define EX(v) __builtin_amdgcn_exp2f(v)
  #define GAPB(MF,X,B) do{ MF; X[B]=EX(X[B]); X[B+1]=EX(X[B+1]); X[B+2]=EX(X[B+2]); X[B+3]=EX(X[B+3]); PIN(X); SBAR(); }while(0)
  #define VRD(i) do{ vlo[i]=vtr(vp_+(((i)>>2)*4096+((i)&3)*1024)); vhi[i]=vtr(vp_+(((i)>>2)*4096+((i)&3)*1024+512)); }while(0)
  #define KRD(G,j) do{ if(G){ kload2(kf,kp0+sl_next,j); SBAR(); } }while(0)
  #define STEP(C0,C1,P0,P1,t,GK,GV,GL) do{ SBAR(); \
    const lds_cptr vp_=vp0+sl_prev; \
    VRD(0); SBAR(); float sacc=(P0[0]+P0[1]); \
    GAPA(C0=__builtin_amdgcn_mfma_f32_32x32x16_bf16(kf[0],qr[0],negm,0,0,0), P0[2],P0[3],P0[4],P0[5],     pw0[0]=PKW(P0,0), pw0[1]=PKW(P0,2), pw0); \
    VRD(4); SBAR(); GAPA(C1=__builtin_amdgcn_mfma_f32_32x32x16_bf16(kf[1],qr[0],negm,0,0,0), P0[6],P0[7],P0[8],P0[9],     pw0[2]=PKW(P0,4), pw0[3]=PKW(P0,6), pw0); \
    VRD(1); SBAR(); GAPA(C0=__builtin_amdgcn_mfma_f32_32x32x16_bf16(kf[2],qr[1],C0,0,0,0),   P0[10],P0[11],P0[12],P0[13], pw1[0]=PKW(P0,8), pw1[1]=PKW(P0,10), pw1); \
    VRD(5); SBAR(); GAPA(C1=__builtin_amdgcn_mfma_f32_32x32x16_bf16(kf[3],qr[1],C1,0,0,0),   P0[14],P0[15],P1[0],P1[1],   pw1[2]=PKW(P0,12),pw1[3]=PKW(P0,14), pw1); \
    VRD(2); SBAR(); GAPA(C0=__builtin_amdgcn_mfma_f32_32x32x16_bf16(kf[4],qr[2],C0,0,0,0),   P1[2],P1[3],P1[4],P1[5],     pw2[0]=PKW(P1,0), pw2[1]=PKW(P1,2), pw2); \
    VRD(6); SBAR(); GAPA(C1=__builtin_amdgcn_mfma_f32_32x32x16_bf16(kf[5],qr[2],C1,0,0,0),   P1[6],P1[7],P1[8],P1[9],     pw2[2]=PKW(P1,4), pw2[3]=PKW(P1,6), pw2); \
    VRD(3); SBAR(); GAPA(C0=__builtin_amdgcn_mfma_f32_32x32x16_bf16(kf[6],qr[3],C0,0,0,0),   P1[10],P1[11],P1[12],P1[13], pw3[0]=PKW(P1,8), pw3[1]=PKW(P1,10), pw3); \
    VRD(7); SBAR(); GAPA(C1=__builtin_amdgcn_mfma_f32_32x32x16_bf16(kf[7],qr[3],C1,0,0,0),   P1[14],P1[15],0.f,0.f,       pw3[2]=PKW(P1,12),pw3[3]=PKW(P1,14), pw3); \
    l_reg+=sacc; \
    if(GK){DMA_K((t)+3,sl_cur);} if(GV){DMA_V((t)+1,sl_next);} \
    CMASK(C0,C1,t); \
    { float a=MX3(C0[0],C0[1],C1[0]),b=MX3(C0[2],C0[3],C1[1]); a=MX3(a,C1[2],C1[3]); \
      _Pragma("unroll") for(int r=4;r<16;r+=4){a=MX3(a,C0[r],C0[r+1]);b=MX3(b,C0[r+2],C0[r+3]);a=MX3(a,C1[r],C1[r+1]);b=MX3(b,C1[r+2],C1[r+3]);} \
      float rm=__builtin_fmaxf(a,b); { auto rr=__builtin_amdgcn_permlane32_swap(__float_as_uint(rm),__float_as_uint(rm),false,false); rm=__builtin_fmaxf(__uint_as_float(rr[0]),__uint_as_float(rr[1])); } \
      resc=false; \
      if(__builtin_expect(__any(rm>(float)THRL),0)){ const float dl=__builtin_fmaxf(rm,0.f); mhat+=dl; \
        _Pragma("unroll") for(int r=0;r<16;++r){C0[r]-=dl;C1[r]-=dl;} \
        _Pragma("unroll") for(int r=0;r<16;++r)negm[r]=-mhat; asm volatile("":"+v"(negm)); \
        const float f=__builtin_amdgcn_exp2f(-dl); l_reg*=f; if(hi==0)wsf[r32]=f; resc=true; } } \
    SBAR(); \
    GAPB(o[0]=__builtin_amdgcn_mfma_f32_32x32x16_bf16(PAF(0),VFR(0),o[0],0,0,0), C0,0); \
    GAPB(o[1]=__builtin_amdgcn_mfma_f32_32x32x16_bf16(PAF(0),VFR(4),o[1],0,0,0), C0,4); \
    KRD(GL,0); GAPB(o[0]=__builtin_amdgcn_mfma_f32_32x32x16_bf16(PAF(1),VFR(1),o[0],0,0,0), C0,8); \
    KRD(GL,1); GAPB(o[1]=__builtin_amdgcn_mfma_f32_32x32x16_bf16(PAF(1),VFR(5),o[1],0,0,0), C0,12); \
    KRD(GL,2); GAPB(o[0]=__builtin_amdgcn_mfma_f32_32x32x16_bf16(PAF(2),VFR(2),o[0],0,0,0), C1,0); \
    KRD(GL,3); GAPB(o[1]=__builtin_amdgcn_mfma_f32_32x32x16_bf16(PAF(2),VFR(6),o[1],0,0,0), C1,4); \
    GAPB(o[0]=__builtin_amdgcn_mfma_f32_32x32x16_bf16(PAF(3),VFR(3),o[0],0,0,0), C1,8); \
    GAPB(o[1]=__builtin_amdgcn_mfma_f32_32x32x16_bf16(PAF(3),VFR(7),o[1],0,0,0), C1,12); \
    }while(0)
  int t=1;
  #undef CMASK
  #define CMASK(P0,P1,t) do{}while(0)
  for(;t+5<NT;t+=2){
    STEP(pB0,pB1,pA0,pA1,t,true,true,true);     WAIT_BAR(2); RESC(); ROT();
    STEP(pA0,pA1,pB0,pB1,t+1,true,true,true);   WAIT_BAR(2); RESC(); ROT();
  }
  #undef CMASK
  #define CMASK(P0,P1,t) do{}while(0)
  #define ENDW(tt) do{ if((tt)+3<NT){WAIT_BAR(2);} else if((tt)+2<NT){WAIT_BAR(1);} else {WAIT_BAR(0);} }while(0)
  for(;t+1<NT;t+=2){
    STEP(pB0,pB1,pA0,pA1,t,(t+3<NT),(t+1<NT),(t+1<NT));       ENDW(t);   RESC(); ROT();
    STEP(pA0,pA1,pB0,pB1,t+1,(t+4<NT),(t+2<NT),(t+2<NT));     ENDW(t+1); RESC(); ROT();
  }
  STEP(pB0,pB1,pA0,pA1,NT-1,false,false,false); RESC();
  { float sacc=pB0[0]+pB0[1]; _Pragma("unroll") for(int r=2;r<16;++r)sacc+=pB0[r]; _Pragma("unroll") for(int r=0;r<16;++r)sacc+=pB1[r]; l_reg+=sacc;
    pw0=(u32x4){PKW(pB0,0),PKW(pB0,2),PKW(pB0,4),PKW(pB0,6)};pw1=(u32x4){PKW(pB0,8),PKW(pB0,10),PKW(pB0,12),PKW(pB0,14)};pw2=(u32x4){PKW(pB1,0),PKW(pB1,2),PKW(pB1,4),PKW(pB1,6)};pw3=(u32x4){PKW(pB1,8),PKW(pB1,10),PKW(pB1,12),PKW(pB1,14)};
    SBAR(); pv(o,vb0+sl_cur,PAF(0),PAF(1),PAF(2),PAF(3)); }
  #undef PKW
  #undef PAF
  #undef VFR
  #undef PIN
  #undef MX3
  #undef GAPA
  #undef GAPB
  #undef EX
  #undef VRD
  #undef KRD
  #undef STEP
  #undef ENDW
  {auto rr=__builtin_amdgcn_permlane32_swap(__float_as_uint(l_reg),__float_as_uint(l_reg),false,false);l_reg=__uint_as_float(rr[0])+__uint_as_float(rr[1]);}
  if(hi==0)wsf[32+r32]=l_reg;asm volatile("s_waitcnt lgkmcnt(0)":::"memory");
  float rli[16];
  #pragma unroll
  for(int r=0;r<16;++r)rli[r]=__builtin_amdgcn_rcpf(wsf[32+crow(r,hi)]);
  bf16*Ow=O+(rowbase+q0+wid*QBLK)*OP+h*D;
  { bf16*stg=(bf16*)(shm+LDS_OST)+wid*2048;
    #pragma unroll
    for(int r=0;r<16;++r){const int orow=crow(r,hi);
      #pragma unroll
      for(int d0=0;d0<2;++d0)stg[orow*64+d0*32+r32]=__float2bfloat16(o[d0][r]*rli[r]);}
    asm volatile("s_waitcnt lgkmcnt(0)":::"memory");
    #pragma unroll
    for(int i=0;i<4;++i){const int row=i*8+(lane>>3),ch=lane&7; const u32x4 v=*(const u32x4*)(stg+row*64+ch*8); ATTN_STORE16(Ow+(long)row*OP+ch*8,v);} }
  asm volatile("s_waitcnt lgkmcnt(0)\n\ts_barrier":::"memory");
  #undef DMA_K
  #undef DMA_V
  #undef CMASK
  #undef START
  #undef RESC
  #undef ROT
}
constexpr int ATTN_LDS_BYTES=LDS_BYTES;
__device__ __forceinline__ void attn_phase_dense(char*lds,const bf16*Q,const bf16*K,const bf16*V,bf16*O,int vcu,int G,const int tid){
  for(int u=vcu;u<512;u+=G){ const int x=u>>6, j=u&63; attn_unit<8>(x>>1, 4*(x&1)+(j>>4), j&15, Q,K,V,O,lds,tid); }
}
#undef SBAR
#undef WAIT_BAR
}

constexpr int STEPS_PER_LAYER = 7;
constexpr int NPHASES = 1 + DEPTH * STEPS_PER_LAYER + 1;

__global__ void __launch_bounds__(NT, 2) mk_fwd(Args args) {
    extern __shared__ __attribute__((aligned(16))) unsigned char lds_raw[];
    Ctx c0;
    c0.lds = (LAS unsigned char*)lds_raw;
    c0.tid = threadIdx.x; c0.lane = c0.tid & 63; c0.wave = __builtin_amdgcn_readfirstlane(c0.tid >> 6);
    c0.G = gridDim.x; { const int bx = blockIdx.x; c0.vcu = (c0.G % 8 == 0) ? (bx % 8) * (c0.G / 8) + bx / 8 : bx; }
    volatile LAS unsigned* misc = (volatile LAS unsigned*)(c0.lds + LDS_BYTES - 64);
    if (c0.tid < 16) misc[c0.tid] = 0u;
    if (c0.tid < 25) { const unsigned long long v = (c0.tid < 23) ? (unsigned long long)args.in[c0.tid] : (c0.tid == 23 ? (unsigned long long)args.out : (unsigned long long)args.ws);
        volatile LAS unsigned* p = (volatile LAS unsigned*)(c0.lds + ARGS_OFF) + 2 * c0.tid; p[0] = (unsigned)v; p[1] = (unsigned)(v >> 32); }
    __syncthreads();
    const int ph_lo = args.ph_lo, ph_hi = args.ph_hi;
    XcdBarrier bar; bar.bar = nullptr; bar.x = 0; bar.st = misc;
    const bool multi = (ph_hi - ph_lo) > 1;
    bool vid_done = false; c0.vid = c0.vcu;
    if (multi) bar = xcd_barrier_post((unsigned*)((unsigned char*)inp(c0, 24) + WS_CTL) + 4096, misc);

    for (int pc = 2 * ph_lo; pc < 2 * ph_hi; ++pc) {
        const int ph = pc >> 1, rep = pc & 1;
        const int st_ = (ph == 0) ? 20 : ((ph == NPHASES - 1) ? 21 : (ph - 1) % STEPS_PER_LAYER);
        if (rep && (st_ != PROBE_STEP || (PROBE_PARITY >= 0 && st_ < 20 && (((ph - 1) / STEPS_PER_LAYER) & 1) != PROBE_PARITY))) continue;
        if (pc > 2 * ph_lo) {
            const int lbar = (ph - 1) / STEPS_PER_LAYER, tlay = (st_ == 0) ? lbar : lbar + 1, sslot = (st_ == 0) ? 4 : (st_ == 6 ? 3 : st_ - 2);
            const bool cshadow = CONV_SHADOW && CONV_SITE == 1 && !rep && st_ < 20 && st_ != 5 && st_ != 1 && ph > 1 && c0.G == 256 && tlay >= 1 && tlay < DEPTH;
            if ((W_PREFETCH && st_ == 5 && !rep && w_stash_ok(c0)) || cshadow) {
                asm volatile("s_waitcnt vmcnt(0)" ::: "memory");
                __syncthreads();
                if (threadIdx.x == 0) xcd_barrier_thread0(bar);
                { Ctx cb = c0; int zb = 0; asm volatile("" : "+s"(cb.wave), "+s"(cb.vcu), "+s"(zb));
                  cb.lane = (int)__builtin_amdgcn_mbcnt_hi(~0u, __builtin_amdgcn_mbcnt_lo(~0u, (unsigned)zb)); cb.tid = cb.wave * 64 + cb.lane;
                  unsigned char* wsb_ = (unsigned char*)inp(cb, 24);
                  if (st_ == 5) {
                      w_prefetch(cb, (const int*)(wsb_ + WS_EIDX), (const float*)(wsb_ + WS_GATE), (const float*)(wsb_ + WS_SCL) + (size_t)lbar * PEER_E, (const float*)(wsb_ + WS_SCL) + (size_t)(DEPTH + lbar) * PEER_E,
                                 (const float*)(wsb_ + WS_SSQ) + (size_t)T * 8 * (DEPTH + 1) + (size_t)lbar * T * 16);
                  } else if (cb.wave != 0) {
                      const int r0 = 2 * PEER_E - 1 - ((sslot * 7 + (cb.wave - 1)) * cb.G + cb.vcu);
                      if (r0 >= SHADOW_RR) { TabRow Ra; int ln = cb.lane; asm volatile("" : "+v"(ln));
                          tabrow_load(Ra, ln, tlay, r0, inp(cb, 21), inp(cb, 22)); tabrow_finish(Ra, ln, tlay, r0, (const f32x4*)(inp(cb, 2) + (size_t)tlay * D), wsb_); }
                  } }
                __syncthreads();
            } else
            xcd_barrier(bar);
            if (PROBE_STEP == 30) { xcd_barrier(bar); xcd_barrier(bar); xcd_barrier(bar); }
            if (!vid_done) {
                if (c0.tid == 0) { unsigned before = 0u;
#pragma unroll
                    for (unsigned j = 0; j < 16; ++j) { const unsigned n = xb_ld(&bar.bar[XB_XCNT(j)]); before += (j < bar.x) ? n : 0u; }
                    misc[3] = before + misc[2]; }
                __syncthreads();
                c0.vid = __builtin_amdgcn_readfirstlane((int)misc[3]); vid_done = true;
            }
        }
        Ctx c = c0;
        int zero_ = 0;
        asm volatile("" : "+s"(c.wave), "+s"(c.vcu), "+s"(c.vid), "+s"(zero_));
        c.lane = (int)__builtin_amdgcn_mbcnt_hi(~0u, __builtin_amdgcn_mbcnt_lo(~0u, (unsigned)zero_)); c.tid = c.wave * 64 + c.lane;
        unsigned char* ws = (unsigned char*)inp(c, 24);
#define xres ((float*)(ws + WS_XRES))
#define hb ((bf16*)(ws + WS_HB))
#define ycat ((bf16*)(ws + WS_YCAT))
#define z ((float*)(ws + WS_Z))
#define qp ((bf16*)(ws + WS_QP))
#define qb ((bf16*)(ws + WS_QB))
#define kb ((bf16*)(ws + WS_KB))
#define vt ((bf16*)(ws + WS_VT))
#define glu ((float*)(ws + WS_GLU))
#define vn ((bf16*)(ws + WS_VN))
#define eidx ((int*)(ws + WS_EIDX))
#define gate ((float*)(ws + WS_GATE))
#define rope ((const float*)(ws + WS_ROPE))
#define SSQA(l_) ((float*)(ws + WS_SSQ) + (size_t)(l_) * T * 8)
#define SSQB(l_) ((float*)(ws + WS_SSQ) + (size_t)5 * T * 8 + (size_t)(l_) * T * 16)
        if (ph == 0) phase_prologue(c, ws);
        else if (ph == NPHASES - 1) phase_final(c, hb, inp(c, 3), (float*)inp(c, 23));
        else {
            const int l = (ph - 1) / STEPS_PER_LAYER, st = (ph - 1) % STEPS_PER_LAYER, i = l >> 1; const bool odd = l & 1;
            switch (st) {
            case 0: { pg8::Gemm g{hb, (const bf16*)(ws + WS_WIN) + (size_t)l * NIN * D, T, NIN, D}; pg8::StaticOrder S; S.init(T, NIN, c.G, (int)blockIdx.x);
                if (!odd) { pg8::EpiEven E{SSQA(l), rope, glu, qb, kb, vt}; pg8::gemm_phase<pg8::EpiEven, pg8::StaticOrder, true, true>(c.lds, g, S, E, c.tid); }
                else { pg8::EpiOdd E{SSQA(l), rope + (size_t)2 * SEQ * 32, inp(c, 13) + i * 64, inp(c, 14) + i * 64, glu, vn, (float*)(ws + WS_LNP), qb, kb, vt, c.lane};
                       pg8::gemm_phase<pg8::EpiOdd, pg8::StaticOrder, true, true>(c.lds, g, S, E, c.tid); } } break;
            case 1:
                if (!odd) {
                    if (c.vcu & 1) conv_items(c, c.vcu, c.G, glu, inp(c, 6) + (size_t)i * 31 * 512, inp(c, 7) + i * 512, inp(c, 8) + i * 512, inp(c, 9) + i * 512, ycat);
                    if (c.vcu & 1) { if (TABLES0_IN_MIXER && l == 0 && !rep) conv_rows(c, 0, c.vcu * NWAVES + c.wave, c.G * NWAVES, 2 * PEER_E, inp(c, 21), inp(c, 22), inp(c, 2), ws); }
                    for (int it = c.vcu; it < 512; it += c.G) attn_item<true>(c, it, qb, kb, vt, ycat, 512, inp(c, 10) + i * 8);
                    if (!(c.vcu & 1)) { if (TABLES0_IN_MIXER && l == 0 && !rep) conv_rows(c, 0, c.vcu * NWAVES + c.wave, c.G * NWAVES, 2 * PEER_E, inp(c, 21), inp(c, 22), inp(c, 2), ws); }
                    if (!(c.vcu & 1)) conv_items(c, c.vcu, c.G, glu, inp(c, 6) + (size_t)i * 31 * 512, inp(c, 7) + i * 512, inp(c, 8) + i * 512, inp(c, 9) + i * 512, ycat);
                } else {
                    attn_body::attn_phase_dense((char*)lds_raw, (const __hip_bfloat16*)qb, (const __hip_bfloat16*)kb, (const __hip_bfloat16*)vt, (__hip_bfloat16*)ycat, c.vcu, c.G, c.tid);
                    for (int it = c.vcu; it < 512; it += c.G) sgu_item(c, it, inp(c, 17) + (size_t)i * 4 * 128 * 128, inp(c, 18) + i * 512, vn, (const float*)(ws + WS_LNP), inp(c, 15) + i * 512, inp(c, 16) + i * 512, glu, ycat);
                }
                break;
            case 2: { pg8::Gemm g{ycat, (const bf16*)(ws + WS_WOUT) + (size_t)l * D * D, T, D, D}; pg8::StaticOrder S; S.init(T, D, c.G, (int)blockIdx.x);
                if (rep) { pg8::EpiF32 E{z, D, nullptr}; pg8::gemm_phase<pg8::EpiF32, pg8::StaticOrder, true, true>(c.lds, g, S, E, c.tid); }
                else { pg8::EpiRes E{D, hb, SSQB(l), ws + WS_X8}; pg8::gemm_phase<pg8::EpiRes, pg8::StaticOrder, true, true>(c.lds, g, S, E, c.tid); } } break;
            case 3: { pg8::Gemm g{hb, (const bf16*)(ws + WS_WQ) + (size_t)l * D * D, T, D, D}; pg8::StaticOrder S; S.init(T, D, c.G, (int)blockIdx.x); pg8::EpiBf16Scale E{qp, D, SSQB(l)};
                pg8::gemm_phase<pg8::EpiBf16Scale, pg8::StaticOrder, true, true>(c.lds, g, S, E, c.tid);
                pg8::Unit u;
                const bool shad = CONV_SHADOW && c.G == 256;
                RConv rc{(CONV_SITE == 1 && !rep) ? l + 1 : DEPTH, c.vcu * NWAVES + c.wave, c.G * NWAVES, inp(c, 21), inp(c, 22), (const LAS f32x4*)(c.lds + RC_GAIN_OFF), ws, shad ? SHADOW_RR : 2 * PEER_E};
                const bf16* skl = (const bf16*)(ws + WS_SK) + (size_t)l * 16 * 128 * 64;
#define ROUTE_STAGE() do { typedef float f32x2v __attribute__((ext_vector_type(2))); u32x4 skr_[8]; f32x2v gnr_;     \
                    { const int cld = rc.cl < DEPTH ? rc.cl : DEPTH - 1; gnr_ = *(const f32x2v*)(inp(c, 2) + (size_t)cld * D + c.tid * 2); } \
                    _Pragma("unroll") for (int i2 = 0; i2 < 8; ++i2) { const int idx = c.tid + NT * i2, row = idx >> 3, ch = idx & 7; \
                        skr_[i2] = *(const u32x4*)(skl + (size_t)(2 * u.pn) * 2 * 128 * 64 + (size_t)row * 64 + ch * 8); } \
                    __syncthreads();    \
                    *(LAS f32x2v*)(c.lds + RC_GAIN_OFF + c.tid * 8) = gnr_; \
                    _Pragma("unroll") for (int i2 = 0; i2 < 8; ++i2) { const int idx = c.tid + NT * i2, row = idx >> 3, ch = idx & 7;     \
                        *(LAS u32x4*)(c.lds + row * 144 + ch * 16) = skr_[i2]; } \
                    __syncthreads(); } while (0)
                if (rc.cl < DEPTH) {
                    TabRow R0, R1;
                    tabrow_load(R0, c.lane, rc.cl, rc.cr, rc.usrc, rc.vsrc); tabrow_load(R1, c.lane, rc.cl, rc.cr + rc.ngw, rc.usrc, rc.vsrc);
                    if (shad) { for (int ui = 0; S.next(ui, u); ++ui) { ROUTE_STAGE();
                        route_item<8>(c, u.pm * 8 + 2 * u.pn, qp, skl, eidx, gate, false, 0, rc, R0, R1); route_item<4>(c, u.pm * 8 + 2 * u.pn + 1, qp, skl, eidx, gate, false, 256 * 144, rc, R0, R1); } }
                    else { for (int ui = 0; S.next(ui, u); ++ui) { ROUTE_STAGE();
                        for (int hh = 0; hh < 2; ++hh) route_item<8>(c, u.pm * 8 + 2 * u.pn + hh, qp, skl, eidx, gate, false, hh * 256 * 144, rc, R0, R1); } }
                    while (rc.cr < rc.hi) { rconv_slot(rc, R0, c.lane); rconv_slot(rc, R1, c.lane); }
                } else {
                    TabRow R0, R1;
                    for (int ui = 0; S.next(ui, u); ++ui) { ROUTE_STAGE();
                        for (int hh = 0; hh < 2; ++hh) route_item<0>(c, u.pm * 8 + 2 * u.pn + hh, qp, skl, eidx, gate, false, hh * 256 * 144, rc, R0, R1); }
                }
#undef ROUTE_STAGE
                } break;
            case 4: { const int lg = __builtin_ctz(c.G) - 3, nq = 1 << lg, q = c.vid >> lg, rq = c.vid & (nq - 1);
                const int cl = (CONV_SITE == 2 && !rep) ? l + 1 : DEPTH;
                if (cl < DEPTH) { typedef float f32x2v __attribute__((ext_vector_type(2)));
                    *(LAS f32x2v*)(c.lds + c.tid * 8) = *(const f32x2v*)(inp(c, 2) + (size_t)cl * D + c.tid * 2); __syncthreads();
                    gu_wave<true>(c, q, rq * NWAVES + c.wave, nq * NWAVES, ws + WS_X8, eidx, ws + WS_UB + (size_t)l * PEER_E * D, (bf16*)z, cl, inp(c, 21), inp(c, 22), (const LAS f32x4*)c.lds, ws); }
                else gu_wave<false>(c, q, rq * NWAVES + c.wave, nq * NWAVES, ws + WS_X8, eidx, ws + WS_UB + (size_t)l * PEER_E * D, (bf16*)z, DEPTH, inp(c, 21), inp(c, 22), (const LAS f32x4*)c.lds, ws); } break;
            case 5: phase_w(c, (const bf16*)z, eidx, gate, (const float*)(ws + WS_SCL) + (size_t)l * PEER_E, (const float*)(ws + WS_SCL) + (size_t)(DEPTH + l) * PEER_E, SSQB(l), (float*)(ws + WS_WB), (CONV_SITE == 0 && !rep) ? l + 1 : DEPTH, inp(c, 21), inp(c, 22), inp(c, 2), ws, W_PREFETCH && w_stash_ok(c)); break;
            case 6: { const int lg = __builtin_ctz(c.G) - 3, nq = 1 << lg, q = c.vid >> lg, rq = c.vid & (nq - 1);
                gv_wave(c, q, rq * NWAVES + c.wave, nq * NWAVES, eidx, (const float*)(ws + WS_WB), ws + WS_VB + (size_t)l * PEER_E * D, rep ? PROBE_EMASK : -1, hb, nullptr, rep ? nullptr : SSQA(l + 1)); } break;
            }
        }
    }
}
#undef xres
#undef hb
#undef ycat
#undef z
#undef qp
#undef qb
#undef kb
#undef vt
#undef glu
#undef vn
#undef eidx
#undef gate
#undef rope
#undef SSQA
#undef SSQB
}

extern "C" void kernel_launch(void* const* d_in, const int* in_sizes, int n_in, void* d_out, int out_size, void* d_ws, size_t ws_size, hipStream_t stream) {
    static int grid = 0;
    if (grid == 0) {
        if (n_in != 23 || out_size != T * D || ws_size < WS_END) { fprintf(stderr, "kernel_launch: unexpected shapes n_in %d out %d ws %zu (need %zu)\n", n_in, out_size, ws_size, (size_t)WS_END); grid = -1; return; }
        int dev = 0, cus = 0;
        if (hipGetDevice(&dev) != hipSuccess || hipDeviceGetAttribute(&cus, hipDeviceAttributeMultiprocessorCount, dev) != hipSuccess) { grid = -1; return; }
        if (hipFuncSetAttribute((const void*)mk_fwd, hipFuncAttributeMaxDynamicSharedMemorySize, LDS_BYTES) != hipSuccess) { fprintf(stderr, "kernel_launch: hipFuncSetAttribute failed\n"); grid = -1; return; }
        (void)hipGetLastError();
        grid = 8; while (grid * 2 <= cus) grid *= 2;
    }
    if (grid < 0) return;
    (void)hipMemsetAsync((char*)d_ws + WS_CTL, 0, 1 * MiB, stream);
    Args a{};
    for (int i = 0; i < 23; ++i) a.in[i] = (const float*)d_in[i];
    a.out = (float*)d_out; a.ws = (unsigned char*)d_ws;
#if MK_ONE_LAUNCH
    a.ph_lo = 0; a.ph_hi = NPHASES;
    hipLaunchKernelGGL(mk_fwd, dim3(grid), dim3(NT), LDS_BYTES, stream, a);
#else
    for (int p = 0; p < NPHASES; ++p) { a.ph_lo = p; a.ph_hi = p + 1; hipLaunchKernelGGL(mk_fwd, dim3(grid), dim3(NT), LDS_BYTES, stream, a); }
#endif
}
```
